# Optimizing an MI355X kernel written in HIP

```python
import jax, jax.numpy as jnp
from jax import lax
import numpy as np

D_MODEL = 1024
BATCH = 2
SEQ = 8192
DEPTH = 4

MLA_HEADS = 8
MLA_Q_LORA = 256
MLA_KV_LORA = 128
MLA_NOPE = 64
MLA_ROPE = 32
MLA_V = 64
SWA_HEADS = 8
SWA_KV_HEADS = 2
SWA_HEAD_DIM = 64
SWA_WINDOW = 128
SB_HEADS = 8
SB_HEAD_DIM = 64
D_FF = 4 * D_MODEL
BLOCK = 128
ROPE_THETA = 10000.0
EPS = 1e-6
N_BRANCHES = 3
MIX_A = MLA_HEADS * MLA_V
MIX_B = SWA_HEADS * SWA_HEAD_DIM
MIX_C = SB_HEADS * SB_HEAD_DIM

SPLIT_SIZES = (
    MLA_Q_LORA, MLA_KV_LORA, MLA_ROPE,
    SWA_HEADS * SWA_HEAD_DIM, SWA_KV_HEADS * SWA_HEAD_DIM, SWA_KV_HEADS * SWA_HEAD_DIM,
    SB_HEADS * SB_HEAD_DIM, SB_HEADS * SB_HEAD_DIM, SB_HEADS * SB_HEAD_DIM,
    N_BRANCHES * D_MODEL,
)
IN_WIDTH = sum(SPLIT_SIZES)
SPLIT_POINTS = [int(v) for v in np.cumsum(SPLIT_SIZES)[:-1]]

kernel_name = "hybrid_mla_swa_sinks_stickbreak_gated"


def rms_norm(x, g):
    xf = x.astype(jnp.float32)
    y = xf * lax.rsqrt(jnp.mean(xf * xf, axis=-1, keepdims=True) + EPS)
    return (y * g.astype(jnp.float32)).astype(x.dtype)


def rope(x, positions):
    d = x.shape[-1]
    inv = 1.0 / (ROPE_THETA ** (jnp.arange(0, d, 2, dtype=jnp.float32) / d))
    ang = positions.astype(jnp.float32)[..., None] * inv
    cos = jnp.cos(ang)[:, :, None, :]
    sin = jnp.sin(ang)[:, :, None, :]
    xf = x.astype(jnp.float32)
    x1, x2 = xf[..., : d // 2], xf[..., d // 2:]
    return jnp.concatenate([x1 * cos - x2 * sin, x2 * cos + x1 * sin], axis=-1).astype(x.dtype)


def to_blocks(t):
    b, s = t.shape[:2]
    return jnp.moveaxis(t.reshape(b, s // BLOCK, BLOCK, *t.shape[2:]), 1, 0)


def from_blocks(t):
    t = jnp.moveaxis(t, 0, 1)
    return t.reshape(t.shape[0], t.shape[1] * t.shape[2], *t.shape[3:])


def mla_branch(c_q, c_kv, k_rope, positions, g_q_lat, g_kv_lat, w_uq, w_ukv):
    B, S, _ = c_q.shape
    q = (rms_norm(c_q, g_q_lat) @ w_uq).reshape(B, S, MLA_HEADS, MLA_NOPE + MLA_ROPE)
    q_nope = q[..., :MLA_NOPE]
    q_pe = rope(q[..., MLA_NOPE:], positions)
    kv = (rms_norm(c_kv, g_kv_lat) @ w_ukv).reshape(B, S, MLA_HEADS, MLA_NOPE + MLA_V)
    k_nope, v = kv[..., :MLA_NOPE], kv[..., MLA_NOPE:]
    k_pe = rope(k_rope[:, :, None, :], positions)[:, :, 0]
    scale = (MLA_NOPE + MLA_ROPE) ** -0.5
    key_pos = jnp.arange(S)

    def block(args):
        qn, qp, i = args
        s = (jnp.einsum('bqhd,bkhd->bhqk', qn, k_nope, preferred_element_type=jnp.float32)
             + jnp.einsum('bqhd,bkd->bhqk', qp, k_pe, preferred_element_type=jnp.float32)) * scale
        q_pos = i * BLOCK + jnp.arange(BLOCK)
        s = jnp.where(key_pos[None, :] <= q_pos[:, None], s, -jnp.inf)
        p = jax.nn.softmax(s, axis=-1).astype(v.dtype)
        return jnp.einsum('bhqk,bkhd->bqhd', p, v)

    out = lax.map(block, (to_blocks(q_nope), to_blocks(q_pe), jnp.arange(S // BLOCK)))
    return from_blocks(out).reshape(B, S, MIX_A)


def swa_branch(q, k, v, positions, sinks):
    B, S, _ = q.shape
    G = SWA_HEADS // SWA_KV_HEADS
    n = S // BLOCK
    q = rope(q.reshape(B, S, SWA_HEADS, SWA_HEAD_DIM), positions)
    k = rope(k.reshape(B, S, SWA_KV_HEADS, SWA_HEAD_DIM), positions)
    v = v.reshape(B, S, SWA_KV_HEADS, SWA_HEAD_DIM)
    qb = q.reshape(B, n, BLOCK, SWA_KV_HEADS, G, SWA_HEAD_DIM)

    def band(t):
        tb = t.reshape(B, n, BLOCK, *t.shape[2:])
        prev = jnp.pad(tb, ((0, 0), (1, 0), (0, 0), (0, 0), (0, 0)))[:, :-1]
        return jnp.concatenate([prev, tb], axis=2)

    kb, vb = band(k), band(v)
    s = jnp.einsum('bnqkgd,bnskd->bnkgqs', qb, kb, preferred_element_type=jnp.float32) * SWA_HEAD_DIM ** -0.5
    qi = jnp.arange(BLOCK)[:, None] + BLOCK
    si = jnp.arange(2 * BLOCK)[None, :]
    diff = qi - si
    valid = (diff >= 0) & (diff < SWA_WINDOW)
    blk = jnp.arange(n)
    valid = valid[None] & ((blk[:, None, None] > 0) | (si[None] >= BLOCK))
    s = jnp.where(valid[None, :, None, None], s, -jnp.inf)
    sink = sinks.astype(jnp.float32).reshape(SWA_KV_HEADS, G)[None, None, :, :, None, None]
    m = jnp.maximum(jnp.max(s, axis=-1, keepdims=True), sink)
    p = jnp.exp(s - m)
    p = (p / (jnp.sum(p, axis=-1, keepdims=True) + jnp.exp(sink - m))).astype(v.dtype)
    o = jnp.einsum('bnkgqs,bnskd->bnqkgd', p, vb)
    return o.reshape(B, S, MIX_B)


def stick_breaking_branch(q, k, v):
    B, S, _ = q.shape
    q = q.reshape(B, S, SB_HEADS, SB_HEAD_DIM)
    k = k.reshape(B, S, SB_HEADS, SB_HEAD_DIM)
    v = v.reshape(B, S, SB_HEADS, SB_HEAD_DIM)
    scale = SB_HEAD_DIM ** -0.5
    key_pos = jnp.arange(S)

    def block(args):
        qb, i = args
        z = jnp.einsum('bqhd,bkhd->bhqk', qb, k, preferred_element_type=jnp.float32) * scale
        q_pos = i * BLOCK + jnp.arange(BLOCK)
        before = key_pos[None, :] < q_pos[:, None]
        log_1m_beta = jnp.where(before, jax.nn.log_sigmoid(-z), 0.0)
        tail = lax.cumsum(log_1m_beta, axis=3, reverse=True) - log_1m_beta
        a = jnp.where(before, jnp.exp(jax.nn.log_sigmoid(z) + tail), 0.0).astype(v.dtype)
        return jnp.einsum('bhqk,bkhd->bqhd', a, v)

    out = lax.map(block, (to_blocks(q), jnp.arange(S // BLOCK)))
    return from_blocks(out).reshape(B, S, MIX_C)


def hybrid_layer(x, positions, g_mix_pre, w_in, b_gate, g_q_lat, g_kv_lat, w_uq, w_ukv, swa_sinks,
                 w_o_mla, w_o_swa, w_o_sb, w_out, g_mix_post, g_mlp_pre, w_up, w_down, g_mlp_post):
    B, S, D = x.shape
    h = rms_norm(x, g_mix_pre)
    proj = h @ w_in
    (c_q, c_kv, k_rope, q_swa, k_swa, v_swa, q_sb, k_sb, v_sb, gate_logits) = jnp.split(proj, SPLIT_POINTS, axis=-1)
    o_a = mla_branch(c_q, c_kv, k_rope, positions, g_q_lat, g_kv_lat, w_uq, w_ukv) @ w_o_mla
    o_b = swa_branch(q_swa, k_swa, v_swa, positions, swa_sinks) @ w_o_swa
    o_c = stick_breaking_branch(q_sb, k_sb, v_sb) @ w_o_sb
    gates = jax.nn.sigmoid((gate_logits + b_gate).astype(jnp.float32)).astype(x.dtype)
    gates = gates.reshape(B, S, N_BRANCHES, D)
    mixed = gates[:, :, 0] * o_a + gates[:, :, 1] * o_b + gates[:, :, 2] * o_c
    x = x + rms_norm(mixed @ w_out, g_mix_post)
    h = rms_norm(x, g_mlp_pre)
    u = jnp.square(jax.nn.relu(h @ w_up))
    return x + rms_norm(u @ w_down, g_mlp_post)


def setup_inputs(seed: int = 0) -> dict:
    key = jax.random.key(seed)
    ks = jax.random.split(key, 24)
    f32 = jnp.float32

    def dense(k, fan_in, fan_out):
        return jax.random.normal(k, (DEPTH, fan_in, fan_out), f32) * fan_in ** -0.5

    def gain(k, n):
        return 1.0 + 0.05 * jax.random.normal(k, (DEPTH, n), f32)

    x = jax.random.normal(ks[0], (BATCH, SEQ, D_MODEL), f32)
    start = jax.random.randint(ks[1], (BATCH, 1), 0, 1024, dtype=jnp.int32)
    positions = start + jnp.arange(SEQ, dtype=jnp.int32)[None, :]
    return {
        "x": x,
        "positions": positions,
        "g_mix_pre": gain(ks[2], D_MODEL),
        "w_in": dense(ks[3], D_MODEL, IN_WIDTH),
        "b_gate": 0.02 * jax.random.normal(ks[4], (DEPTH, N_BRANCHES * D_MODEL), f32),
        "g_q_lat": gain(ks[5], MLA_Q_LORA),
        "g_kv_lat": gain(ks[6], MLA_KV_LORA),
        "w_uq": dense(ks[7], MLA_Q_LORA, MLA_HEADS * (MLA_NOPE + MLA_ROPE)),
        "w_ukv": dense(ks[8], MLA_KV_LORA, MLA_HEADS * (MLA_NOPE + MLA_V)),
        "swa_sinks": 0.5 * jax.random.normal(ks[9], (DEPTH, SWA_HEADS), f32),
        "w_o_mla": dense(ks[10], MIX_A, D_MODEL),
        "w_o_swa": dense(ks[11], MIX_B, D_MODEL),
        "w_o_sb": dense(ks[12], MIX_C, D_MODEL),
        "w_out": dense(ks[13], D_MODEL, D_MODEL),
        "g_mix_post": gain(ks[14], D_MODEL),
        "g_mlp_pre": gain(ks[15], D_MODEL),
        "w_up": dense(ks[16], D_MODEL, D_FF),
        "w_down": dense(ks[17], D_FF, D_MODEL),
        "g_mlp_post": gain(ks[18], D_MODEL),
    }


def reference(x, positions, g_mix_pre, w_in, b_gate, g_q_lat, g_kv_lat, w_uq, w_ukv, swa_sinks,
              w_o_mla, w_o_swa, w_o_sb, w_out, g_mix_post, g_mlp_pre, w_up, w_down, g_mlp_post):
    for l in range(DEPTH):
        x = hybrid_layer(x, positions, g_mix_pre[l], w_in[l], b_gate[l], g_q_lat[l], g_kv_lat[l],
                         w_uq[l], w_ukv[l], swa_sinks[l], w_o_mla[l], w_o_swa[l], w_o_sb[l], w_out[l],
                         g_mix_post[l], g_mlp_pre[l], w_up[l], w_down[l], g_mlp_post[l])
    return x
```

```cpp
#include <hip/hip_runtime.h>
#include <hip/hip_cooperative_groups.h>
#include <cstdio>
#include <cstdint>
namespace cg = cooperative_groups;
#define ONE_LAUNCH 1
namespace pg8 {
#define PG8_LAS __attribute__((address_space(3)))
typedef unsigned short bf16_t;
typedef short bf16x8 __attribute__((ext_vector_type(8)));
typedef float f32x4 __attribute__((ext_vector_type(4)));
typedef unsigned u32x4 __attribute__((ext_vector_type(4)));
constexpr int BM = 256, BK = 64, HALF = 128, HTB = HALF * BK * 2  , STAGE_BYTES = 8 * HTB, NXCD = 8, WGM = 8;

__host__ __device__ __forceinline__ int lds_byte(int r, int c) { const int st = (r >> 4) * 2 + (c >> 5), rr = r & 15, cc = c & 31, ob = rr * 64 + cc * 2; return st * 1024 + (ob ^ (((ob >> 9) & 1) << 5)); }
__host__ __device__ __forceinline__ void stage_rc(int b, int& R, int& C) { const int st = b / 1024, sb = b % 1024, swz = sb ^ (((sb >> 9) & 1) << 5); R = (st >> 1) * 16 + swz / 64; C = (st & 1) * 32 + (swz % 64) / 2; }
__host__ __device__ __forceinline__ int perm32(int rho) { const int n = rho >> 4, i = rho & 15; return 8 * (i >> 2) + 4 * n + (i & 3); }

struct Unit { int pm, pn; };
struct Gemm { const bf16_t* A; const bf16_t* Bt; int M, N, K; };

struct StaticOrder {
    int nM, nN, nwg, G, c;
    __host__ __device__ void init(int M, int N, int G_, int c_) { nM = M / BM; nN = N / BM; nwg = nM * nN; G = G_; c = c_; }
    __host__ __device__ bool next(int i, Unit& u) const {
        const long L = (long)i * G + c; if (L >= nwg) return false;
        int wgid = (int)L; { const int q = nwg / NXCD, r = nwg % NXCD, xcd = wgid % NXCD, off = wgid / NXCD; wgid = (xcd < r ? xcd * (q + 1) : r * (q + 1) + (xcd - r) * q) + off; }
        const int nig = WGM * nN, gid = wgid / nig, fm = gid * WGM, gsz = (nM - fm) < WGM ? (nM - fm) : WGM;
        u.pm = fm + ((wgid % nig) % gsz); u.pn = (wgid % nig) / gsz; return true;
    }
    __device__ __forceinline__ void a_ready(const Unit&) const {}
    __device__ __forceinline__ void done(const Unit&) const {}
};

__device__ __forceinline__ unsigned cvt_pk_bf16(float lo, float hi) { unsigned r; asm volatile("v_cvt_pk_bf16_f32 %0, %1, %2" : "=v"(r) : "v"(lo), "v"(hi)); return r; }
template <class Epi, class Sched, bool ALIGN_EPI = false, bool SP2 = false>
__device__ __forceinline__ void gemm_phase(PG8_LAS unsigned char* lds, const Gemm g, const Sched& S, const Epi& E, int tid_in) {
    int tid_ = tid_in; asm volatile("" : "+v"(tid_));
    const int tid = tid_, wid = __builtin_amdgcn_readfirstlane(tid >> 6), lane = tid & 63, wr = wid >> 2, wc = wid & 3, fr = lane & 15, fq = lane >> 4;
    const int K = g.K, nt = K / BK;
    unsigned voffA[2], voffB[2];
#pragma unroll
    for (int i = 0; i < 2; ++i) { int R, C; stage_rc(tid * 16 + i * 8192, R, C); const int Rb = Epi::PERM ? ((R & ~31) + perm32(R & 31)) : R;
        voffA[i] = (unsigned)(R * K + C) * 2u; voffB[i] = (unsigned)(Rb * K + C) * 2u; }
    const size_t kstep = (size_t)(BK * 2);
    const size_t hstep = (size_t)HALF * K * 2;
    const size_t tstep = 2 * hstep;
    const unsigned ldsw = (unsigned)wid * 1024u;
    const int aoff = lds_byte(wr * 64 + fr, fq * 8), boff = lds_byte(wc * 32 + fr, fq * 8);
#define PG8_SA(b, h) (((b) * 2 + (h)) * HTB)
#define PG8_SB(b, h) ((4 + (b) * 2 + (h)) * HTB)
#define PG8_STAGE(bufoff, gbase, voff) do { _Pragma("unroll") for (int _i = 0; _i < 2; ++_i) \
        __builtin_amdgcn_global_load_lds((const unsigned*)((const char*)(gbase) + (voff)[_i]), (PG8_LAS unsigned*)(lds + (bufoff) + ldsw + _i * 8192), 16, 0, 0); } while (0)
#define PG8_LDA(dst, b, h) do { _Pragma("unroll") for (int m = 0; m < 4; ++m) _Pragma("unroll") for (int k = 0; k < 2; ++k) dst[m][k] = *(const PG8_LAS bf16x8*)(lds + PG8_SA(b, h) + aoff + m * 2048 + k * 1024); } while (0)
#define PG8_LDB(dst, b, h) do { _Pragma("unroll") for (int n = 0; n < 2; ++n) _Pragma("unroll") for (int k = 0; k < 2; ++k) dst[n][k] = *(const PG8_LAS bf16x8*)(lds + PG8_SB(b, h) + boff + n * 2048 + k * 1024); } while (0)
#define PG8_MMA(ai, bj, At, Bt) do { __builtin_amdgcn_s_setprio(1); _Pragma("unroll") for (int m = 0; m < 4; ++m) _Pragma("unroll") for (int n = 0; n < 2; ++n) _Pragma("unroll") for (int k = 0; k < 2; ++k) \
        acc[ai][bj][m][n] = __builtin_amdgcn_mfma_f32_16x16x32_bf16(Bt[n][k], At[m][k], acc[ai][bj][m][n], 0, 0, 0); __builtin_amdgcn_s_setprio(0); } while (0)
#define PG8_WAIT_V(n) asm volatile("s_waitcnt vmcnt(" #n ")" ::: "memory")
#define PG8_WAIT_L(n) asm volatile("s_waitcnt lgkmcnt(" #n ")" ::: "memory")
#define PG8_BAR __builtin_amdgcn_s_barrier()
#define PG8_SCHED __builtin_amdgcn_sched_barrier(0)
    Unit cur, nxt; int ui = 0;
    if (!S.next(0, cur)) return;
    f32x4 acc[2][2][4][2];
    float z_ = 0.f; asm volatile("" : "+v"(z_));
#pragma unroll
    for (int a = 0; a < 2; ++a)
#pragma unroll
        for (int b = 0; b < 2; ++b)
#pragma unroll
            for (int m = 0; m < 4; ++m)
#pragma unroll
                for (int n = 0; n < 2; ++n) acc[a][b][m][n] = (f32x4){z_, z_, z_, z_};
    bf16x8 At[4][2], B0[2][2], B1[2][2];
    const char* cA = (const char*)g.A + (size_t)cur.pm * tstep; const char* cB = (const char*)g.Bt + (size_t)cur.pn * tstep;
    S.a_ready(cur);
    if constexpr (SP2) {
        PG8_STAGE(PG8_SB(0, 0), cB, voffB); PG8_STAGE(PG8_SB(0, 1), cB + hstep, voffB); PG8_STAGE(PG8_SA(0, 0), cA, voffA); PG8_STAGE(PG8_SA(0, 1), cA + hstep, voffA);
        if (wr == 1) PG8_BAR;
        PG8_WAIT_V(2); PG8_BAR;
        PG8_STAGE(PG8_SB(1, 0), cB + kstep, voffB); PG8_STAGE(PG8_SA(1, 0), cA + kstep, voffA); PG8_STAGE(PG8_SB(1, 1), cB + hstep + kstep, voffB);
        PG8_WAIT_V(6); PG8_BAR;
    } else {
        PG8_STAGE(PG8_SB(0, 0), cB, voffB); PG8_STAGE(PG8_SA(0, 0), cA, voffA); PG8_STAGE(PG8_SB(0, 1), cB + hstep, voffB); PG8_STAGE(PG8_SA(0, 1), cA + hstep, voffA);
        if (wr == 1) PG8_BAR;
        PG8_WAIT_V(4); PG8_BAR;
        PG8_STAGE(PG8_SB(1, 0), cB + kstep, voffB); PG8_STAGE(PG8_SA(1, 0), cA + kstep, voffA); PG8_STAGE(PG8_SB(1, 1), cB + hstep + kstep, voffB);
        PG8_WAIT_V(6); PG8_BAR;
    }
    for (;;) {
        const bool has_next = S.next(ui + 1, nxt);
        const char* nA = has_next ? (const char*)g.A + (size_t)nxt.pm * tstep : cA; const char* nB = has_next ? (const char*)g.Bt + (size_t)nxt.pn * tstep : cB;
        for (int t = 0; t < nt; t += 2) {
            const bool last = (t == nt - 2);
            const char* a1 = cA + (size_t)(t + 1) * kstep;
            const char* a2 = last ? nA : cA + (size_t)(t + 2) * kstep; const char* b2 = last ? nB : cB + (size_t)(t + 2) * kstep;
            const char* a3 = a2 + kstep; const char* b3 = b2 + kstep;
            if (last && has_next) S.a_ready(nxt);
            if constexpr (SP2) {
            PG8_LDB(B0, 0, 0); PG8_LDB(B1, 0, 1); PG8_SCHED; PG8_LDA(At, 0, 0); PG8_STAGE(PG8_SA(1, 1), a1 + hstep, voffA);
            PG8_WAIT_V(8); PG8_WAIT_L(0); PG8_BAR; PG8_MMA(0, 0, At, B0); PG8_MMA(0, 1, At, B1); PG8_BAR; PG8_SCHED;
            PG8_LDA(At, 0, 1); PG8_STAGE(PG8_SB(0, 0), b2, voffB); PG8_STAGE(PG8_SB(0, 1), b2 + hstep, voffB); PG8_STAGE(PG8_SA(0, 0), a2, voffA);
            PG8_WAIT_V(8); PG8_WAIT_L(0); PG8_BAR; PG8_MMA(1, 0, At, B0); PG8_MMA(1, 1, At, B1); PG8_BAR; PG8_SCHED;
            PG8_LDB(B0, 1, 0); PG8_LDB(B1, 1, 1); PG8_SCHED; PG8_LDA(At, 1, 0); PG8_STAGE(PG8_SA(0, 1), a2 + hstep, voffA);
            PG8_WAIT_V(8); PG8_WAIT_L(0); PG8_BAR; PG8_MMA(0, 0, At, B0); PG8_MMA(0, 1, At, B1); PG8_BAR; PG8_SCHED;
            PG8_LDA(At, 1, 1); PG8_STAGE(PG8_SB(1, 0), b3, voffB); PG8_STAGE(PG8_SB(1, 1), b3 + hstep, voffB); PG8_STAGE(PG8_SA(1, 0), a3, voffA);
            PG8_WAIT_V(8); PG8_WAIT_L(0); PG8_BAR; PG8_MMA(1, 0, At, B0); PG8_MMA(1, 1, At, B1); PG8_BAR; PG8_SCHED;
            } else {
            PG8_LDB(B0, 0, 0); PG8_SCHED; PG8_LDA(At, 0, 0); PG8_STAGE(PG8_SA(1, 1), a1 + hstep, voffA);
            PG8_WAIT_L(8); PG8_BAR; PG8_WAIT_L(0); PG8_MMA(0, 0, At, B0); PG8_BAR; PG8_SCHED;
            PG8_LDB(B1, 0, 1); PG8_STAGE(PG8_SB(0, 0), b2, voffB);
            PG8_BAR; PG8_WAIT_L(0); PG8_MMA(0, 1, At, B1); PG8_BAR;
            PG8_LDA(At, 0, 1); PG8_STAGE(PG8_SA(0, 0), a2, voffA);
            PG8_BAR; PG8_WAIT_L(0); PG8_MMA(1, 0, At, B0); PG8_BAR; PG8_SCHED;
            PG8_STAGE(PG8_SB(0, 1), b2 + hstep, voffB);
            PG8_WAIT_V(6); PG8_BAR; PG8_MMA(1, 1, At, B1); PG8_BAR;
            PG8_LDB(B0, 1, 0); PG8_SCHED; PG8_LDA(At, 1, 0); PG8_STAGE(PG8_SA(0, 1), a2 + hstep, voffA);
            PG8_WAIT_L(8); PG8_BAR; PG8_WAIT_L(0); PG8_MMA(0, 0, At, B0); PG8_BAR; PG8_SCHED;
            PG8_LDB(B1, 1, 1); PG8_STAGE(PG8_SB(1, 0), b3, voffB);
            PG8_BAR; PG8_WAIT_L(0); PG8_MMA(0, 1, At, B1); PG8_BAR;
            PG8_LDA(At, 1, 1); PG8_STAGE(PG8_SA(1, 0), a3, voffA);
            PG8_BAR; PG8_WAIT_L(0); PG8_MMA(1, 0, At, B0); PG8_BAR; PG8_SCHED;
            PG8_STAGE(PG8_SB(1, 1), b3 + hstep, voffB);
            PG8_WAIT_V(6); PG8_BAR; PG8_MMA(1, 1, At, B1); PG8_BAR;
            }
        }
        if constexpr (ALIGN_EPI) { if (wr == 0) PG8_BAR; }
        if constexpr (!Epi::AFTER_DRAIN) { E(acc, cur, wr, wc, fr, fq); S.done(cur); }
        if (!has_next) break;
        z_ = 0.f; asm volatile("" : "+v"(z_));
#pragma unroll
        for (int a = 0; a < 2; ++a)
#pragma unroll
            for (int b = 0; b < 2; ++b)
#pragma unroll
                for (int m = 0; m < 4; ++m)
#pragma unroll
                    for (int n = 0; n < 2; ++n) acc[a][b][m][n] = (f32x4){z_, z_, z_, z_};
        cur = nxt; cA = nA; cB = nB; ++ui;
        if constexpr (ALIGN_EPI) { if (wr == 1) PG8_BAR; }
    }
    PG8_WAIT_V(0);
    if constexpr (!ALIGN_EPI) { if (wr == 0) PG8_BAR; }
    PG8_BAR;
    if constexpr (Epi::AFTER_DRAIN) { E.fused(acc, cur, wr, wc, fr, fq, lds, wid, lane); S.done(cur); }
#undef PG8_SA
#undef PG8_SB
#undef PG8_STAGE
#undef PG8_LDA
#undef PG8_LDB
#undef PG8_MMA
#undef PG8_WAIT_V
#undef PG8_WAIT_L
#undef PG8_BAR
#undef PG8_SCHED
}
}
namespace ms {
__device__ __forceinline__ unsigned ld(unsigned* p) { return __hip_atomic_load(p, __ATOMIC_RELAXED, __HIP_MEMORY_SCOPE_AGENT); }
__device__ __forceinline__ unsigned add(unsigned* p, unsigned v) { return __hip_atomic_fetch_add(p, v, __ATOMIC_RELAXED, __HIP_MEMORY_SCOPE_AGENT); }
__device__ __forceinline__ void grid_sync(unsigned* bw, int tid, int bx) {
    asm volatile("s_waitcnt vmcnt(0)" ::: "memory");
    __syncthreads();
    if (tid == 0) {
        __builtin_amdgcn_fence(__ATOMIC_RELEASE, "agent"); asm volatile("s_waitcnt vmcnt(0)" ::: "memory");
        const int g = bx & 7;
        const unsigned old = add(&bw[64 * g], 1u), rnd = old >> 5;
        if ((old & 31u) == 31u) {
            const unsigned o2 = add(&bw[1024], 1u);
            if ((o2 & 7u) == 7u) add(&bw[1088], 1u);
            else { unsigned sp = 0; while (ld(&bw[1088]) == (o2 >> 3) && ++sp < (1u << 24)) __builtin_amdgcn_s_sleep(1); }
            add(&bw[512 + 64 * g], 1u);
        } else { unsigned sp = 0; while (ld(&bw[512 + 64 * g]) == rnd && ++sp < (1u << 24)) __builtin_amdgcn_s_sleep(1); }
        __builtin_amdgcn_fence(__ATOMIC_ACQUIRE, "agent"); asm volatile("s_waitcnt vmcnt(0)" ::: "memory");
    }
    __syncthreads();
}
}

#ifndef PHMASK
#define PHMASK 0x3ff
#endif
#ifndef ONE_LAUNCH
#define ONE_LAUNCH 1
#endif
namespace mk {
using pg8::bf16_t; using pg8::f32x4; using pg8::bf16x8; using pg8::u32x4; using pg8::Unit; using pg8::cvt_pk_bf16;
#define LAS __attribute__((address_space(3)))
typedef float f32x16 __attribute__((ext_vector_type(16)));
typedef unsigned u32x2 __attribute__((ext_vector_type(2)));
typedef short s16x4 __attribute__((ext_vector_type(4)));
#define DI __device__ __forceinline__
#define MFMA32(a, b, c) __builtin_amdgcn_mfma_f32_32x32x16_bf16((a), (b), (c), 0, 0, 0)

constexpr int BATCH = 2, SEQ = 8192, DM = 1024, MTOK = BATCH * SEQ, DEPTH = 4, FF = 4096, NIN = 5888, NGATE = 3072;
constexpr float EPS = 1e-6f, LOG2E = 1.4426950408889634f;
constexpr int NTHR = 512, LDS_BYTES = 147456;
constexpr int NPH_LAYER = 10, NPHASES = 1 + NPH_LAYER * DEPTH;

constexpr size_t MiB = (size_t)1 << 20;
constexpr size_t WS_CTL = 0, WS_TAB = 2 * MiB, WS_W = 6 * MiB, WS_XB = 40 * MiB, WS_AR = 72 * MiB, WS_END = WS_AR + 249 * MiB;
constexpr size_t W_IN = WS_W, W_UQ = W_IN + (size_t)NIN * 1024 * 2, W_UKV = W_UQ + 768 * 256 * 2, W_OA = W_UKV + 1024 * 256 * 2, W_OB = W_OA + 1024 * 512 * 2,
                 W_OC = W_OB + 1024 * 512 * 2, W_OUT = W_OC + 1024 * 512 * 2, W_UP = W_OUT + 1024 * 1024 * 2, W_DN = W_UP + (size_t)4096 * 1024 * 2, W_ENDW = W_DN + (size_t)4096 * 1024 * 2;
static_assert(W_ENDW <= WS_XB, "weights fit");
constexpr size_t A_G = WS_AR, A_QSWA = WS_AR + 96 * MiB, A_QSB = WS_AR + 112 * MiB, A_KSB = WS_AR + 128 * MiB, A_VTSB = WS_AR + 144 * MiB, A_CQ = WS_AR + 160 * MiB,
                 A_CKV = WS_AR + 237 * MiB  , A_KPE = WS_AR + 172 * MiB, A_KSWA = WS_AR + 173 * MiB, A_VTSWA = WS_AR + 177 * MiB, A_QMLA = WS_AR + 181 * MiB,
                 A_KNOPE = WS_AR + 205 * MiB, A_VTMLA = WS_AR + 221 * MiB;
constexpr size_t A_MIXED = WS_AR + 128 * MiB, A_MIXEDB = WS_AR + 128 * MiB  , A_Y = WS_AR, A_U = WS_AR, A_Y2 = WS_AR + 128 * MiB, A_OMLA = WS_XB;
constexpr int SS_X = 0, SS_X1 = MTOK, SS_L0 = 2 * MTOK;
constexpr size_t WS_BAR = WS_CTL + MiB, BAR_BYTES = 16384;
constexpr size_t A_SSP = WS_AR + 245 * MiB;
constexpr int SP_CQ = 0, SP_CKV = 4 * MTOK, SP_Y = 8 * MTOK, SP_Y2 = 24 * MTOK;

__constant__ float ROPE_INV[32] = {1.000000000e+00f, 7.498942018e-01f, 5.623413324e-01f, 4.216965139e-01f, 3.162277639e-01f, 2.371373773e-01f, 1.778279394e-01f, 1.333521456e-01f, 1.000000015e-01f, 7.498942316e-02f, 5.623413250e-02f, 4.216964915e-02f, 3.162277490e-02f, 2.371373773e-02f, 1.778279431e-02f, 1.333521400e-02f, 9.999999776e-03f, 7.498942316e-03f, 5.623413250e-03f, 4.216964822e-03f, 3.162277630e-03f, 2.371373819e-03f, 1.778279431e-03f, 1.333521446e-03f, 1.000000047e-03f, 7.498941850e-04f, 5.623413017e-04f, 4.216965172e-04f, 3.162277571e-04f, 2.371373703e-04f, 1.778279402e-04f, 1.333521504e-04f};
struct Args { const float* in[19]; const int* pos; float* out; unsigned char* ws; int ph_lo, ph_hi; };
typedef const __attribute__((address_space(4))) Args* CArgsP;

DI float shx(float v, int mask, int lane) { return __int_as_float(__builtin_amdgcn_ds_bpermute((lane ^ mask) << 2, __float_as_int(v))); }
DI float wave_sum(float v, int lane) {
#pragma unroll
    for (int o = 1; o < 64; o <<= 1) v += shx(v, o, lane);
    return v;
}
DI float bf2f(unsigned short b) { return __uint_as_float((unsigned)b << 16); }
DI u32x4 pack8(const float* v) { u32x4 w; w.x = cvt_pk_bf16(v[0], v[1]); w.y = cvt_pk_bf16(v[2], v[3]); w.z = cvt_pk_bf16(v[4], v[5]); w.w = cvt_pk_bf16(v[6], v[7]); return w; }
DI u32x2 pack4(float a, float b, float c, float d) { u32x2 w; w.x = cvt_pk_bf16(a, b); w.y = cvt_pk_bf16(c, d); return w; }
DI float fast_rsq(float x) { return __builtin_amdgcn_rsqf(x); }

DI int perm64inv(int d) { return d < 32 ? 8 * (d >> 2) + (d & 3) : 8 * ((d - 32) >> 2) + 4 + (d & 3); }
DI int perm32inv(int d) { return d < 16 ? 8 * (d >> 2) + (d & 3) : 8 * ((d - 16) >> 2) + 4 + (d & 3); }
DI int rowmap(int kind, int n) {
    if (kind == 0) return n;
    if (kind == 1) {
        if (n < 384) return n;
        if (n < 416) return 384 + perm32inv(n - 384);
        if (n < 928) { const int t = n - 416; return 512 + (t & ~63) + perm64inv(t & 63); }
        if (n < 1056) { const int t = n - 928; return 1024 + (t & ~63) + perm64inv(t & 63); }
        return n + 96;
    }
    if (kind == 2) { const int h = n / 96, j = n % 96; return j < 64 ? h * 64 + j : 512 + h * 32 + perm32inv(j - 64); }
    { const int h = n >> 7, j = n & 127; return j < 64 ? h * 64 + j : 512 + h * 64 + (j - 64); }
}
DI void conv_item(const float* W, int K, int N, bf16_t* WT, const float* gk, int kind, LAS float* scr, int item, int lane, int ldw = 0) {
    if (ldw == 0) ldw = K;
    const int nblk = N / 32, kb = item / nblk, nb = item % nblk, k0 = 64 * kb, n0 = 32 * nb;
#pragma unroll 8
    for (int i = 0; i < 32; ++i) { const int kk = 2 * i + (lane >> 5); float v = W[(size_t)(k0 + kk) * N + n0 + (lane & 31)]; if (gk) v *= gk[k0 + kk]; scr[kk * 33 + (lane & 31)] = v; }
    asm volatile("s_waitcnt lgkmcnt(0)" ::: "memory");
    const int c = lane & 7;
#pragma unroll
    for (int j = 0; j < 4; ++j) { const int n = (lane >> 3) + 8 * j; const LAS float* s = scr + (8 * c) * 33 + n;
        u32x4 o; o.x = cvt_pk_bf16(s[0 * 33], s[1 * 33]); o.y = cvt_pk_bf16(s[2 * 33], s[3 * 33]); o.z = cvt_pk_bf16(s[4 * 33], s[5 * 33]); o.w = cvt_pk_bf16(s[6 * 33], s[7 * 33]);
        *(u32x4*)(WT + (size_t)rowmap(kind, n0 + n) * ldw + k0 + 8 * c) = o; }
    asm volatile("s_waitcnt lgkmcnt(0)" ::: "memory");
}
DI void conv_layer(CArgsP a, int l, LAS unsigned char* lds, int gw, int ngw, int wave, int lane) {
    LAS float* scr = (LAS float*)(lds + wave * 16384);
    unsigned char* ws = a->ws;
    constexpr int I_IN = 16 * 181, I_UQ = 4 * 24, I_UKV = 2 * 32, I_O = 8 * 32, I_OUT = 16 * 32, I_UP = 16 * 128, I_DN = 64 * 32;
    constexpr int NITEMS = I_IN + I_UQ + I_UKV + 3 * I_O + I_OUT + I_UP + I_DN;
    for (int it = gw; it < NITEMS; it += ngw) {
        int r = it;
        if (r < I_IN) { conv_item(a->in[3] + (size_t)l * 1024 * 5792, 1024, 5792, (bf16_t*)(ws + W_IN), a->in[2] + l * 1024, 1, scr, r, lane); continue; } r -= I_IN;
        if (r < I_UQ) { conv_item(a->in[7] + (size_t)l * 256 * 768, 256, 768, (bf16_t*)(ws + W_UQ), a->in[5] + l * 256, 2, scr, r, lane); continue; } r -= I_UQ;
        if (r < I_UKV) { conv_item(a->in[8] + (size_t)l * 128 * 1024, 128, 1024, (bf16_t*)(ws + W_UKV), a->in[6] + l * 128, 3, scr, r, lane, 256); continue; } r -= I_UKV;
        if (r < I_O) { conv_item(a->in[10] + (size_t)l * 512 * 1024, 512, 1024, (bf16_t*)(ws + W_OA), nullptr, 0, scr, r, lane); continue; } r -= I_O;
        if (r < I_O) { conv_item(a->in[11] + (size_t)l * 512 * 1024, 512, 1024, (bf16_t*)(ws + W_OB), nullptr, 0, scr, r, lane); continue; } r -= I_O;
        if (r < I_O) { conv_item(a->in[12] + (size_t)l * 512 * 1024, 512, 1024, (bf16_t*)(ws + W_OC), nullptr, 0, scr, r, lane); continue; } r -= I_O;
        if (r < I_OUT) { conv_item(a->in[13] + (size_t)l * 1024 * 1024, 1024, 1024, (bf16_t*)(ws + W_OUT), nullptr, 0, scr, r, lane); continue; } r -= I_OUT;
        if (r < I_UP) { conv_item(a->in[16] + (size_t)l * 1024 * 4096, 1024, 4096, (bf16_t*)(ws + W_UP), a->in[15] + l * 1024, 0, scr, r, lane); continue; } r -= I_UP;
        conv_item(a->in[17] + (size_t)l * 4096 * 1024, 4096, 1024, (bf16_t*)(ws + W_DN), nullptr, 0, scr, r, lane);
    }
}

DI void row_update(const float* xin, float* xout, const float* Y, const float* ssq_y, const float* g, bf16_t* XB, float* ssq_out, int r, int lane) {
    const f32x4* xr = (const f32x4*)(xin + (size_t)r * DM) + lane;
    float ss = 0.f;
    float rs = 0.f;
    if (Y) { float p_ = ssq_y[(unsigned)r * 16 + (lane & 15)]; p_ += shx(p_, 1, lane); p_ += shx(p_, 2, lane); p_ += shx(p_, 4, lane); p_ += shx(p_, 8, lane); rs = fast_rsq(p_ * (1.f / DM) + EPS); }
#pragma unroll
    for (int j = 0; j < 4; ++j) {
        f32x4 v = xr[64 * j];
        if (Y) { const f32x4 y = ((const f32x4*)(Y + (size_t)r * DM) + lane)[64 * j]; const f32x4 gg = ((const f32x4*)g + lane)[64 * j]; v = v + y * rs * gg; ((f32x4*)(xout + (size_t)r * DM) + lane)[64 * j] = v; }
        ss += (v.x * v.x + v.y * v.y) + (v.z * v.z + v.w * v.w);
        ((u32x2*)(XB + (size_t)r * DM) + lane)[64 * j] = pack4(v.x, v.y, v.z, v.w);
    }
    ss = wave_sum(ss, lane);
    if (lane == 0) ssq_out[r] = ss;
}

#define EPI_ROWS _Pragma("unroll") for (int ai = 0; ai < 2; ++ai) _Pragma("unroll") for (int m = 0; m < 4; ++m, ({ asm volatile("" ::: "memory"); }))
#define EPI_GETV(v, sc) float v[8]; { const f32x4 a0_ = acc[ai][bj][m][0], a1_ = acc[ai][bj][m][1]; v[0] = a0_[0] * (sc); v[1] = a0_[1] * (sc); v[2] = a0_[2] * (sc); v[3] = a0_[3] * (sc); v[4] = a1_[0] * (sc); v[5] = a1_[1] * (sc); v[6] = a1_[2] * (sc); v[7] = a1_[3] * (sc); }
DI void rope8(const float* v, const float* tc, const float* ts, int r, int i0, int stride, float* o1, float* o2) {
#pragma unroll
    for (int e = 0; e < 4; ++e) { const float c = tc[(unsigned)(r * 32 + (i0 + e) * stride)], s = ts[(unsigned)(r * 32 + (i0 + e) * stride)]; o1[e] = v[e] * c - v[4 + e] * s; o2[e] = v[4 + e] * c + v[e] * s; }
}
DI void vt_scatter(bf16_t* vt, int nh, int r, int h, int d0, const float* v) {
    const int b = r >> 13, s = r & (SEQ - 1);
    const unsigned off = (unsigned)(((b * nh + h) * 64 + d0) * SEQ + s);
#pragma unroll
    for (int j = 0; j < 8; j += 2) { const unsigned w = cvt_pk_bf16(v[j], v[j + 1]); vt[off + (unsigned)(j * SEQ)] = (bf16_t)(w & 0xffffu); vt[off + (unsigned)((j + 1) * SEQ)] = (bf16_t)(w >> 16); asm volatile("" ::: "memory"); }
}
DI void ssq_row_put(float part, float* dst, int fr, int fq) {
    const int lane = fq * 16 + fr; part += shx(part, 16, lane); part += shx(part, 32, lane);
    if (fq == 0) *dst = part;
}

struct EpiIn {
    static constexpr bool PERM = true, AFTER_DRAIN = false;
    CArgsP a0; int l;
    DI void operator()(const f32x4 (&acc)[2][2][4][2], const Unit& u, int wr, int wc, int fr0, int fq0) const {
        asm volatile("s_waitcnt vmcnt(0)" ::: "memory");     unsigned ones_ = ~0u; asm volatile("" : "+s"(ones_)); const int lane_ = (int)__builtin_amdgcn_mbcnt_hi(ones_, __builtin_amdgcn_mbcnt_lo(ones_, 0u)); const int fr = lane_ & 15, fq = lane_ >> 4; (void)fr0; (void)fq0;
        CArgsP a = a0; asm volatile("" : "+s"(a));
        unsigned char* ws = a->ws; float* ctl = (float*)(ws + WS_CTL);
        const float* ssq_x = ctl + SS_X; float* ssq_cq = (float*)(ws + A_SSP) + SP_CQ; float* ssq_ckv = (float*)(ws + A_SSP) + SP_CKV;
        const float* bgate = a->in[4] + l * NGATE; const float* tc = (const float*)(ws + WS_TAB); const float* ts = tc + (size_t)MTOK * 32;
        bf16_t *cq = (bf16_t*)(ws + A_CQ), *ckv = (bf16_t*)(ws + A_CKV), *kpe = (bf16_t*)(ws + A_KPE), *qswa = (bf16_t*)(ws + A_QSWA), *kswa = (bf16_t*)(ws + A_KSWA), *vtswa = (bf16_t*)(ws + A_VTSWA),
               *qsb = (bf16_t*)(ws + A_QSB), *ksb = (bf16_t*)(ws + A_KSB), *vtsb = (bf16_t*)(ws + A_VTSB), *G = (bf16_t*)(ws + A_G);
        const int pn = u.pn;
        EPI_ROWS {
            const int r = u.pm * 256 + ai * 128 + wr * 64 + m * 16 + fr;
            const float rs = fast_rsq(ssq_x[r] * (1.f / DM) + EPS);
            if (pn == 0) {
                float part = 0.f;
#pragma unroll
                for (int bj = 0; bj < 2; ++bj) { EPI_GETV(v, rs);
#pragma unroll
                    for (int j = 0; j < 8; ++j) part += v[j] * v[j];
                    *(u32x4*)(cq + (unsigned)r * 256 + bj * 128 + wc * 32 + fq * 8) = pack8(v); }
                ssq_row_put(part, ssq_cq + (unsigned)r * 4 + wc, fr, fq);
            } else if (pn == 1) {
                float part = 0.f;
                { constexpr int bj = 0; EPI_GETV(v, rs);
#pragma unroll
                    for (int j = 0; j < 8; ++j) part += v[j] * v[j];
                    *(u32x4*)(ckv + (unsigned)r * 256 + wc * 32 + fq * 8) = pack8(v); *(u32x4*)(ckv + (unsigned)r * 256 + 128 + wc * 32 + fq * 8) = (u32x4){0u, 0u, 0u, 0u}; }
                ssq_row_put(part, ssq_ckv + (unsigned)r * 4 + wc, fr, fq);
                if (wc == 0) { constexpr int bj = 1; EPI_GETV(v, rs); float o1[4], o2[4]; rope8(v, tc, ts, r, 4 * fq, 2, o1, o2);
                    *(u32x2*)(kpe + (unsigned)r * 32 + 4 * fq) = pack4(o1[0], o1[1], o1[2], o1[3]); *(u32x2*)(kpe + (unsigned)r * 32 + 16 + 4 * fq) = pack4(o2[0], o2[1], o2[2], o2[3]); }
            } else if (pn <= 3) {
                const float sc = rs * (0.125f * LOG2E);
#pragma unroll
                for (int bj = 0; bj < 2; ++bj) { EPI_GETV(v, sc); const int head = (pn - 2) * 4 + bj * 2 + (wc >> 1), g = 4 * (wc & 1) + fq; float o1[4], o2[4]; rope8(v, tc, ts, r, 4 * g, 1, o1, o2);
                    bf16_t* p = qswa + (unsigned)r * 512 + head * 64 + 4 * g; *(u32x2*)p = pack4(o1[0], o1[1], o1[2], o1[3]); *(u32x2*)(p + 32) = pack4(o2[0], o2[1], o2[2], o2[3]); }
            } else if (pn == 4) {
                { constexpr int bj = 0; EPI_GETV(v, rs); const int kvh = wc >> 1, g = 4 * (wc & 1) + fq; float o1[4], o2[4]; rope8(v, tc, ts, r, 4 * g, 1, o1, o2);
                    bf16_t* p = kswa + (unsigned)r * 128 + kvh * 64 + 4 * g; *(u32x2*)p = pack4(o1[0], o1[1], o1[2], o1[3]); *(u32x2*)(p + 32) = pack4(o2[0], o2[1], o2[2], o2[3]); }
                { constexpr int bj = 1; EPI_GETV(v, rs); vt_scatter(vtswa, 2, r, wc >> 1, 32 * (wc & 1) + 8 * fq, v); }
            } else if (pn <= 6) {
                const float sc = rs * 0.125f;
#pragma unroll
                for (int bj = 0; bj < 2; ++bj) { EPI_GETV(v, sc); *(u32x4*)(qsb + (unsigned)r * 512 + (pn - 5) * 256 + bj * 128 + wc * 32 + fq * 8) = pack8(v); }
            } else if (pn <= 8) {
#pragma unroll
                for (int bj = 0; bj < 2; ++bj) { EPI_GETV(v, rs); *(u32x4*)(ksb + (unsigned)r * 512 + (pn - 7) * 256 + bj * 128 + wc * 32 + fq * 8) = pack8(v); }
            } else if (pn <= 10) {
#pragma unroll
                for (int bj = 0; bj < 2; ++bj) { EPI_GETV(v, rs); const int c = (pn - 9) * 256 + bj * 128 + wc * 32 + fq * 8; vt_scatter(vtsb, 8, r, c >> 6, c & 63, v); }
            } else {
#pragma unroll
                for (int bj = 0; bj < 2; ++bj) { EPI_GETV(v, rs); const int c = (pn - 11) * 256 + bj * 128 + wc * 32 + fq * 8;
                    const f32x4 b0 = *(const f32x4*)(bgate + c), b1 = *(const f32x4*)(bgate + c + 4); const float bb[8] = {b0[0], b0[1], b0[2], b0[3], b1[0], b1[1], b1[2], b1[3]};
#pragma unroll
                    for (int j = 0; j < 8; ++j) v[j] = __builtin_amdgcn_rcpf(1.f + __expf(-(v[j] + bb[j])));
                    *(u32x4*)(G + (unsigned)r * NGATE + c) = pack8(v); }
            }
        }
    }
};
struct EpiUpQ {
    static constexpr bool PERM = true, AFTER_DRAIN = false;
    CArgsP a0; int l;
    DI void operator()(const f32x4 (&acc)[2][2][4][2], const Unit& u, int wr, int wc, int fr0, int fq0) const {
        asm volatile("s_waitcnt vmcnt(0)" ::: "memory");     unsigned ones_ = ~0u; asm volatile("" : "+s"(ones_)); const int lane_ = (int)__builtin_amdgcn_mbcnt_hi(ones_, __builtin_amdgcn_mbcnt_lo(ones_, 0u)); const int fr = lane_ & 15, fq = lane_ >> 4; (void)fr0; (void)fq0;
        CArgsP a = a0; asm volatile("" : "+s"(a));
        unsigned char* ws = a->ws; const float* ssq_cq = (const float*)(ws + A_SSP) + SP_CQ;
        const float* tc = (const float*)(ws + WS_TAB); const float* ts = tc + (size_t)MTOK * 32; bf16_t* qm = (bf16_t*)(ws + A_QMLA);
        const int pn = u.pn;
        EPI_ROWS {
            const int r = u.pm * 256 + ai * 128 + wr * 64 + m * 16 + fr; const int b = r >> 13, s = r & (SEQ - 1);
            const f32x4 pq_ = *(const f32x4*)(ssq_cq + (unsigned)r * 4); const float sc = fast_rsq(((pq_[0] + pq_[1]) + (pq_[2] + pq_[3])) * (1.f / 256) + EPS) * (0.10206207261596577f * LOG2E);
#pragma unroll
            for (int bj = 0; bj < 2; ++bj) { EPI_GETV(v, sc);
                if (pn < 2) { const int c = pn * 256 + bj * 128 + wc * 32 + fq * 8; *(u32x4*)(qm + (unsigned)(((b * 8 + (c >> 6)) * SEQ + s) * 96 + (c & 63))) = pack8(v); }
                else { const int h = bj * 4 + wc; float o1[4], o2[4]; rope8(v, tc, ts, r, 4 * fq, 2, o1, o2); bf16_t* p = qm + (unsigned)(((b * 8 + h) * SEQ + s) * 96 + 64 + 4 * fq);
                    *(u32x2*)p = pack4(o1[0], o1[1], o1[2], o1[3]); *(u32x2*)(p + 16) = pack4(o2[0], o2[1], o2[2], o2[3]); }
            }
        }
    }
};
struct EpiUpKV {
    static constexpr bool PERM = true, AFTER_DRAIN = false;
    CArgsP a0; int l;
    DI void operator()(const f32x4 (&acc)[2][2][4][2], const Unit& u, int wr, int wc, int fr0, int fq0) const {
        asm volatile("s_waitcnt vmcnt(0)" ::: "memory");     unsigned ones_ = ~0u; asm volatile("" : "+s"(ones_)); const int lane_ = (int)__builtin_amdgcn_mbcnt_hi(ones_, __builtin_amdgcn_mbcnt_lo(ones_, 0u)); const int fr = lane_ & 15, fq = lane_ >> 4; (void)fr0; (void)fq0;
        CArgsP a = a0; asm volatile("" : "+s"(a));
        unsigned char* ws = a->ws; const float* ssq_ckv = (const float*)(ws + A_SSP) + SP_CKV; bf16_t* knope = (bf16_t*)(ws + A_KNOPE); bf16_t* vt = (bf16_t*)(ws + A_VTMLA);
        const int pn = u.pn;
        EPI_ROWS {
            const int r = u.pm * 256 + ai * 128 + wr * 64 + m * 16 + fr;
            const f32x4 pk_ = *(const f32x4*)(ssq_ckv + (unsigned)r * 4); const float rs = fast_rsq(((pk_[0] + pk_[1]) + (pk_[2] + pk_[3])) * (1.f / 128) + EPS);
#pragma unroll
            for (int bj = 0; bj < 2; ++bj) { EPI_GETV(v, rs);
                if (pn < 2) *(u32x4*)(knope + (unsigned)r * 512 + pn * 256 + bj * 128 + wc * 32 + fq * 8) = pack8(v);
                else { const int c = (pn - 2) * 256 + bj * 128 + wc * 32 + fq * 8; vt_scatter(vt, 8, r, c >> 6, c & 63, v); }
            }
        }
    }
};
struct EpiBranch {
    static constexpr bool PERM = true, AFTER_DRAIN = false;
    CArgsP a0; int br;
    DI void operator()(const f32x4 (&acc)[2][2][4][2], const Unit& u, int wr, int wc, int fr0, int fq0) const {
        asm volatile("s_waitcnt vmcnt(0)" ::: "memory");     unsigned ones_ = ~0u; asm volatile("" : "+s"(ones_)); const int lane_ = (int)__builtin_amdgcn_mbcnt_hi(ones_, __builtin_amdgcn_mbcnt_lo(ones_, 0u)); const int fr = lane_ & 15, fq = lane_ >> 4; (void)fr0; (void)fq0;
        CArgsP a = a0; asm volatile("" : "+s"(a));
        bf16_t* R = (bf16_t*)(a->ws + A_MIXED) + (size_t)br * MTOK * DM;
        EPI_ROWS {
            const int r = u.pm * 256 + ai * 128 + wr * 64 + m * 16 + fr;
#pragma unroll
            for (int bj = 0; bj < 2; ++bj) { EPI_GETV(v, 1.f); *(u32x4*)(R + (unsigned)r * DM + u.pn * 256 + bj * 128 + wc * 32 + fq * 8) = pack8(v); }
        }
    }
};
struct EpiY {
    static constexpr bool PERM = true, AFTER_DRAIN = false;
    CArgsP a0; int l, second;
    DI void operator()(const f32x4 (&acc)[2][2][4][2], const Unit& u, int wr, int wc, int fr0, int fq0) const {
        asm volatile("s_waitcnt vmcnt(0)" ::: "memory");     unsigned ones_ = ~0u; asm volatile("" : "+s"(ones_)); const int lane_ = (int)__builtin_amdgcn_mbcnt_hi(ones_, __builtin_amdgcn_mbcnt_lo(ones_, 0u)); const int fr = lane_ & 15, fq = lane_ >> 4; (void)fr0; (void)fq0;
        CArgsP a = a0; asm volatile("" : "+s"(a));
        unsigned char* ws = a->ws; float* Y = (float*)(ws + (second ? A_Y2 : A_Y)); float* ssq = (float*)(ws + A_SSP) + (second ? SP_Y2 : SP_Y);
        EPI_ROWS {
            const int r = u.pm * 256 + ai * 128 + wr * 64 + m * 16 + fr; float part = 0.f;
#pragma unroll
            for (int bj = 0; bj < 2; ++bj) { const int c = u.pn * 256 + bj * 128 + wc * 32 + fq * 8; const f32x4 a0 = acc[ai][bj][m][0], a1 = acc[ai][bj][m][1];
                part += (a0[0] * a0[0] + a0[1] * a0[1]) + (a0[2] * a0[2] + a0[3] * a0[3]) + (a1[0] * a1[0] + a1[1] * a1[1]) + (a1[2] * a1[2] + a1[3] * a1[3]);
                float* yp = Y + (unsigned)r * DM + c; *(f32x4*)yp = a0; *(f32x4*)(yp + 4) = a1; }
            ssq_row_put(part, ssq + (unsigned)r * 16 + u.pn * 4 + wc, fr, fq);
        }
    }
};
struct EpiUp {
    static constexpr bool PERM = true, AFTER_DRAIN = false;
    CArgsP a0;
    DI void operator()(const f32x4 (&acc)[2][2][4][2], const Unit& u, int wr, int wc, int fr0, int fq0) const {
        asm volatile("s_waitcnt vmcnt(0)" ::: "memory");     unsigned ones_ = ~0u; asm volatile("" : "+s"(ones_)); const int lane_ = (int)__builtin_amdgcn_mbcnt_hi(ones_, __builtin_amdgcn_mbcnt_lo(ones_, 0u)); const int fr = lane_ & 15, fq = lane_ >> 4; (void)fr0; (void)fq0;
        CArgsP a = a0; asm volatile("" : "+s"(a));
        unsigned char* ws = a->ws; const float* ssq_x1 = (const float*)(ws + WS_CTL) + SS_X1; bf16_t* U = (bf16_t*)(ws + A_U);
        EPI_ROWS {
            const int r = u.pm * 256 + ai * 128 + wr * 64 + m * 16 + fr;
            const float rs = fast_rsq(ssq_x1[r] * (1.f / DM) + EPS);
#pragma unroll
            for (int bj = 0; bj < 2; ++bj) { EPI_GETV(v, rs);
#pragma unroll
                for (int j = 0; j < 8; ++j) { const float t = fmaxf(v[j], 0.f); v[j] = t * t; }
                *(u32x4*)(U + (unsigned)r * FF + u.pn * 256 + bj * 128 + wc * 32 + fq * 8) = pack8(v); }
        }
    }
};

constexpr int KROW = 208, VROW = 136, KS_BYTES = 64 * KROW, VS_BYTES = 64 * VROW, AT_FLAGS = 2 * KS_BYTES + 2 * VS_BYTES;
DI int crow(int reg, int h) { return (reg & 3) + 8 * (reg >> 2) + 4 * h; }
DI bf16x8 pack_frag(const f32x16& x, int s) {
    u32x4 p; p.x = cvt_pk_bf16(x[8 * s], x[8 * s + 1]); p.y = cvt_pk_bf16(x[8 * s + 2], x[8 * s + 3]); p.z = cvt_pk_bf16(x[8 * s + 4], x[8 * s + 5]); p.w = cvt_pk_bf16(x[8 * s + 6], x[8 * s + 7]);
    return __builtin_bit_cast(bf16x8, p);
}
DI void sb_group(f32x16& s, float& carry, int key_base, int q_abs, int h, int lane) {
    float L[16];
#pragma unroll
    for (int i = 0; i < 16; ++i) { const float z = s[i]; const float sp = fmaxf(z, 0.f) + __logf(1.f + __expf(-fabsf(z))); L[i] = (key_base + crow(i, h) < q_abs) ? -sp : 0.f; }
    float cs[4], pc[4];
#pragma unroll
    for (int c = 0; c < 4; ++c) { cs[c] = (L[4 * c] + L[4 * c + 1]) + (L[4 * c + 2] + L[4 * c + 3]); pc[c] = shx(cs[c], 32, lane); }
    float run = carry;
#pragma unroll
    for (int c = 3; c >= 0; --c) {
        float t = (h == 0) ? run + pc[c] : run;
#pragma unroll
        for (int e = 3; e >= 0; --e) { const int i = 4 * c + e; const bool before = key_base + crow(i, h) < q_abs; const float a = __expf(L[i] + s[i] + t); t += L[i]; s[i] = before ? a : 0.f; }
        run += cs[c] + pc[c];
    }
    carry = run;
}
template <int MODE>
DI void attn_unit(LAS unsigned char* lds, const bf16_t* Qp, int qpitch, const bf16_t* Kp, int kpitch, const bf16_t* Kpe, const bf16_t* Vt, bf16_t* Op, int qb, float sink2, int tid) {
    constexpr int NK = MODE == 0 ? 6 : 4;
    const int lane = tid & 63, wave = tid >> 6, r32 = lane & 31, h = lane >> 5;
    const int row0 = qb * 256 + wave * 32, q_abs = row0 + r32;
    bf16x8 qf[NK];
#pragma unroll
    for (int kk = 0; kk < NK; ++kk) qf[kk] = *(const bf16x8*)(Qp + (size_t)q_abs * qpitch + 16 * kk + 8 * h);
    const int jt_hi = 4 * qb + 3, jt_lo = (MODE == 1) ? (4 * qb - 2 > 0 ? 4 * qb - 2 : 0) : 0, nT = jt_hi - jt_lo + 1;
    f32x16 o0, o1;
#pragma unroll
    for (int i = 0; i < 16; ++i) { o0[i] = 0.f; o1[i] = 0.f; }
    float mrun = (MODE == 1) ? sink2 : -1e30f, lrun = (MODE == 1 && h == 0) ? 1.f : 0.f, carry = 0.f;
    bool wdone = false;
    LAS unsigned* flags = (LAS unsigned*)(lds + AT_FLAGS);
    const int kkey = tid >> 3, kch = tid & 7, pkey = tid >> 2, pch = tid & 3;
    u32x4 kreg, vreg, preg;
    auto issue = [&](int jt) {
        kreg = *(const u32x4*)(Kp + (size_t)(64 * jt + kkey) * kpitch + kch * 8);
        vreg = *(const u32x4*)(Vt + (size_t)kkey * SEQ + 64 * jt + kch * 8);
        if (MODE == 0 && tid < 256) preg = *(const u32x4*)(Kpe + (size_t)(64 * jt + pkey) * 32 + pch * 8);
    };
    auto commit = [&](int buf) {
        *(LAS u32x4*)(lds + buf * KS_BYTES + kkey * KROW + kch * 16) = kreg;
        LAS u32x2* vp = (LAS u32x2*)(lds + 2 * KS_BYTES + buf * VS_BYTES + kkey * VROW + kch * 16); vp[0] = (u32x2){vreg.x, vreg.y}; vp[1] = (u32x2){vreg.z, vreg.w};
        if (MODE == 0 && tid < 256) *(LAS u32x4*)(lds + buf * KS_BYTES + pkey * KROW + 128 + pch * 16) = preg;
    };
    __syncthreads();
    issue(MODE == 2 ? jt_hi : jt_lo); commit(0);
    __syncthreads();
    for (int it = 0; it < nT; ++it) {
        const int jt = (MODE == 2) ? jt_hi - it : jt_lo + it, buf = it & 1;
        const bool more = it + 1 < nT;
        if (more) issue(MODE == 2 ? jt - 1 : jt + 1);
        bool active = (64 * jt <= row0 + 31);
        if (MODE == 1) active = active && (64 * jt + 63 >= row0 - 127);
        if (MODE == 2) active = active && !wdone;
        if (active) {
            const LAS unsigned char* ks = lds + buf * KS_BYTES; const LAS unsigned char* vs = lds + 2 * KS_BYTES + buf * VS_BYTES;
            f32x16 s0, s1;
#pragma unroll
            for (int i = 0; i < 16; ++i) { s0[i] = 0.f; s1[i] = 0.f; }
#pragma unroll
            for (int kk = 0; kk < NK; ++kk) {
                const bf16x8 a0 = *(const LAS bf16x8*)(ks + r32 * KROW + (16 * kk + 8 * h) * 2);
                const bf16x8 a1 = *(const LAS bf16x8*)(ks + (32 + r32) * KROW + (16 * kk + 8 * h) * 2);
                s0 = MFMA32(a0, qf[kk], s0); s1 = MFMA32(a1, qf[kk], s1);
            }
            const int kb0 = 64 * jt;
            if (MODE == 2) {
                sb_group(s1, carry, kb0 + 32, q_abs, h, lane);
                sb_group(s0, carry, kb0, q_abs, h, lane);
            } else {
                const bool need_mask = (MODE == 1) || (kb0 + 63 > row0);
                if (need_mask) {
#pragma unroll
                    for (int i = 0; i < 16; ++i) { const int k0 = kb0 + crow(i, h), k1 = k0 + 32;
                        bool v0 = k0 <= q_abs, v1 = k1 <= q_abs;
                        if (MODE == 1) { v0 = v0 && (q_abs - k0 < 128); v1 = v1 && (q_abs - k1 < 128); }
                        s0[i] = v0 ? s0[i] : -1e30f; s1[i] = v1 ? s1[i] : -1e30f; }
                }
                float mx = -1e30f;
#pragma unroll
                for (int i = 0; i < 16; ++i) mx = fmaxf(mx, fmaxf(s0[i], s1[i]));
                mx = fmaxf(mx, shx(mx, 32, lane));
                const float mnew = fmaxf(mrun, mx);
                if (__any(mx > mrun)) {
                    const float alpha = __builtin_amdgcn_exp2f(mrun - mnew);
                    lrun *= alpha;
#pragma unroll
                    for (int i = 0; i < 16; ++i) { o0[i] *= alpha; o1[i] *= alpha; }
                }
                mrun = mnew;
                float ls = 0.f;
#pragma unroll
                for (int i = 0; i < 16; ++i) { s0[i] = __builtin_amdgcn_exp2f(s0[i] - mnew); s1[i] = __builtin_amdgcn_exp2f(s1[i] - mnew); ls += s0[i] + s1[i]; }
                lrun += ls;
            }
#pragma unroll
            for (int g = 0; g < 2; ++g)
#pragma unroll
                for (int s = 0; s < 2; ++s) {
                    const bf16x8 pf = pack_frag(g == 0 ? s0 : s1, s);
                    const int kofs = (32 * g + 16 * s + 4 * h) * 2;
                    { const s16x4 lo = *(const LAS s16x4*)(vs + r32 * VROW + kofs), hi = *(const LAS s16x4*)(vs + r32 * VROW + kofs + 16);
                      o0 = MFMA32(__builtin_shufflevector(lo, hi, 0, 1, 2, 3, 4, 5, 6, 7), pf, o0); }
                    { const s16x4 lo = *(const LAS s16x4*)(vs + (32 + r32) * VROW + kofs), hi = *(const LAS s16x4*)(vs + (32 + r32) * VROW + kofs + 16);
                      o1 = MFMA32(__builtin_shufflevector(lo, hi, 0, 1, 2, 3, 4, 5, 6, 7), pf, o1); }
                }
            if (MODE == 2) wdone = __all(carry < -88.f);
        }
        if (more) commit(buf ^ 1);
        if (MODE == 2 && lane == 0) flags[(it & 1) * 8 + wave] = wdone ? 1u : 0u;
        __syncthreads();
        if (MODE == 2) { unsigned all = 1u;
#pragma unroll
            for (int w = 0; w < 8; ++w) all &= flags[(it & 1) * 8 + w];
            if (all) break; }
    }
    if (MODE != 2) { const float l = lrun + shx(lrun, 32, lane); const float inv = 1.f / l;
#pragma unroll
        for (int i = 0; i < 16; ++i) { o0[i] *= inv; o1[i] *= inv; } }
    bf16_t* orow = Op + (size_t)q_abs * 512;
#pragma unroll
    for (int c = 0; c < 4; ++c) {
        *(u32x2*)(orow + 8 * c + 4 * h) = pack4(o0[4 * c], o0[4 * c + 1], o0[4 * c + 2], o0[4 * c + 3]);
        *(u32x2*)(orow + 32 + 8 * c + 4 * h) = pack4(o1[4 * c], o1[4 * c + 1], o1[4 * c + 2], o1[4 * c + 3]);
    }
}

struct RoundOrder {
    pg8::StaticOrder S; int rnd;
    DI bool next(int i, Unit& u) const { return i == 0 ? S.next(rnd, u) : false; }
    DI void a_ready(const Unit&) const {}
    DI void done(const Unit&) const {}
};
template <int N, class Epi>
DI void run_gemm_n(LAS unsigned char* lds, int tid, int G, int bx, const bf16_t* A, const bf16_t* Bt, int K, const Epi& E) {
    pg8::Gemm g{A, Bt, MTOK, N, K};
    constexpr int nwg = (MTOK / 256) * (N / 256), NR = (nwg + 255) / 256;
#pragma unroll
    for (int rnd = 0; rnd < NR; ++rnd) { RoundOrder R; R.S.init(MTOK, N, G, bx); R.rnd = rnd; pg8::gemm_phase<Epi, RoundOrder, false, true>(lds, g, R, E, tid); }
}
#define run_gemm(lds, tid, G, bx, A, Bt, N, K, E) run_gemm_n<N>(lds, tid, G, bx, A, Bt, K, E)

template <int PH>
DI void do_phase(LAS unsigned char* lds, int wave_s) {
    constexpr int ph = PH;
    {
        CArgsP a = (CArgsP)__builtin_amdgcn_kernarg_segment_ptr(); asm volatile("" : "+s"(a));
        unsigned char* ws = a->ws;
        float* ctl = (float*)(ws + WS_CTL);
        const float* tc = (const float*)(ws + WS_TAB); const float* ts = tc + (size_t)MTOK * 32;
        bf16_t* XB = (bf16_t*)(ws + WS_XB);
        int G = gridDim.x, bx = blockIdx.x; unsigned ones = ~0u; asm volatile("" : "+s"(G), "+s"(bx), "+s"(ones));
        const int vcu = (G % 8 == 0) ? (bx % 8) * (G / 8) + bx / 8 : bx;
        int tid = wave_s * 64 + (int)__builtin_amdgcn_mbcnt_hi(ones, __builtin_amdgcn_mbcnt_lo(ones, 0u)); asm volatile("" : "+v"(tid));
        const int lane = tid & 63, wave = __builtin_amdgcn_readfirstlane(tid >> 6);
        const int gw = vcu * 8 + wave, ngw = G * 8;
        if (ph == 0) {
#if (PHMASK & 1)
            { u32x4* z = (u32x4*)((bf16_t*)(ws + W_IN) + (size_t)416 * 1024); for (int i = bx * NTHR + tid; i < 96 * 1024 * 2 / 16; i += G * NTHR) z[i] = (u32x4){0u, 0u, 0u, 0u}; }
            { unsigned char* z = ws + W_UKV; for (int i = bx * NTHR + tid; i < 1024 * 16; i += G * NTHR) *(u32x4*)(z + (size_t)(i >> 4) * 512 + 256 + (i & 15) * 16) = (u32x4){0u, 0u, 0u, 0u}; }
            for (int i = bx * NTHR + tid; i < (int)(BAR_BYTES / 4); i += G * NTHR) ((unsigned*)(ws + WS_BAR))[i] = 0u;
            for (int i = bx * NTHR + tid; i < MTOK * 32; i += G * NTHR) {
                const int r = i >> 5, k = i & 31;
                const float inv = ROPE_INV[k];
                const float ang = (float)a->pos[r] * inv;
                double rev = (double)ang * 0.15915494309189535; rev -= floor(rev);
                const float fr = (float)rev;
                ((float*)(ws + WS_TAB))[i] = __builtin_amdgcn_cosf(fr); ((float*)(ws + WS_TAB))[(size_t)MTOK * 32 + i] = __builtin_amdgcn_sinf(fr);
            }
            for (int r = gw; r < MTOK; r += ngw) row_update(a->in[0], nullptr, nullptr, nullptr, nullptr, XB, ctl + SS_X, r, lane);
            conv_layer(a, 0, lds, gw, ngw, wave, lane);
#endif
        } else {
            const int l = (ph - 1) / NPH_LAYER, sp = (ph - 1) % NPH_LAYER;
            const float* ssq_y = (const float*)(ws + A_SSP) + SP_Y; const float* ssq_y2 = (const float*)(ws + A_SSP) + SP_Y2;
            if (sp == 0) {
#if (PHMASK & 2)
                EpiIn E{a, l};
                run_gemm(lds, tid, G, bx, XB, (const bf16_t*)(ws + W_IN), NIN, 1024, E);
#endif
            } else if (sp == 1) {
#if (PHMASK & 4)
                { EpiUpQ E{a, l}; run_gemm(lds, tid, G, bx, (const bf16_t*)(ws + A_CQ), (const bf16_t*)(ws + W_UQ), 768, 256, E); }
                { EpiUpKV E{a, l}; run_gemm(lds, tid, G, bx, (const bf16_t*)(ws + A_CKV), (const bf16_t*)(ws + W_UKV), 1024, 256, E); }
#endif
            } else if (sp == 2) {
#if (PHMASK & 8)
                for (int w = vcu; w < 256; w += G) {
                    const int bh = w >> 4, sx = w & 15, b = bh >> 3, h = bh & 7;
                    const bf16_t* qm = (const bf16_t*)(ws + A_QMLA) + (size_t)bh * SEQ * 96;
                    const bf16_t* kn = (const bf16_t*)(ws + A_KNOPE) + (size_t)b * SEQ * 512 + h * 64;
                    const bf16_t* kp = (const bf16_t*)(ws + A_KPE) + (size_t)b * SEQ * 32;
                    const bf16_t* vm = (const bf16_t*)(ws + A_VTMLA) + (size_t)bh * 64 * SEQ;
                    bf16_t* om = (bf16_t*)(ws + A_OMLA) + (size_t)b * SEQ * 512 + h * 64;
                    attn_unit<0>(lds, qm, 96, kn, 512, kp, vm, om, 31 - sx, 0.f, tid);
                    attn_unit<0>(lds, qm, 96, kn, 512, kp, vm, om, sx, 0.f, tid);
                    bf16_t* qs = (bf16_t*)(ws + A_QSWA) + (size_t)b * SEQ * 512 + h * 64;
                    const bf16_t* ksw = (const bf16_t*)(ws + A_KSWA) + (size_t)b * SEQ * 128 + (h >> 2) * 64;
                    const bf16_t* vsw = (const bf16_t*)(ws + A_VTSWA) + (size_t)(b * 2 + (h >> 2)) * 64 * SEQ;
                    const float sink2 = a->in[9][l * 8 + h] * LOG2E;
                    attn_unit<1>(lds, qs, 512, ksw, 128, nullptr, vsw, qs, 2 * sx, sink2, tid);
                    attn_unit<1>(lds, qs, 512, ksw, 128, nullptr, vsw, qs, 2 * sx + 1, sink2, tid);
                    bf16_t* qb_ = (bf16_t*)(ws + A_QSB) + (size_t)b * SEQ * 512 + h * 64;
                    const bf16_t* kb_ = (const bf16_t*)(ws + A_KSB) + (size_t)b * SEQ * 512 + h * 64;
                    const bf16_t* vb_ = (const bf16_t*)(ws + A_VTSB) + (size_t)bh * 64 * SEQ;
                    attn_unit<2>(lds, qb_, 512, kb_, 512, nullptr, vb_, qb_, 2 * sx, 0.f, tid);
                    attn_unit<2>(lds, qb_, 512, kb_, 512, nullptr, vb_, qb_, 2 * sx + 1, 0.f, tid);
                }
#endif
            } else if (sp == 3) {
#if (PHMASK & 16)
                for (int br = 0; br < 3; ++br) {
                    EpiBranch E{a, br};
                    const bf16_t* A = br == 0 ? (const bf16_t*)(ws + A_OMLA) : br == 1 ? (const bf16_t*)(ws + A_QSWA) : (const bf16_t*)(ws + A_QSB);
                    run_gemm(lds, tid, G, bx, A, (const bf16_t*)(ws + W_OA) + (size_t)br * 1024 * 512, 1024, 512, E);
                }
                {
                    __builtin_amdgcn_fence(__ATOMIC_ACQUIRE, "agent");
                    pg8::StaticOrder S; S.init(MTOK, 1024, G, bx); Unit u;
                    if (S.next(0, u)) {
                        const bf16_t* Gp = (const bf16_t*)(ws + A_G); bf16_t* R = (bf16_t*)(ws + A_MIXED);
                        for (int i = tid; i < 256 * 32; i += NTHR) {
                            const int r = u.pm * 256 + (i >> 5), c = u.pn * 256 + (i & 31) * 8; const unsigned off = (unsigned)r * DM + c;
                            float acc8[8] = {0.f, 0.f, 0.f, 0.f, 0.f, 0.f, 0.f, 0.f};
#pragma unroll
                            for (int b3 = 0; b3 < 3; ++b3) {
                                const u32x4 gw = *(const u32x4*)(Gp + (unsigned)r * NGATE + b3 * 1024 + c), rw = *(const u32x4*)(R + (size_t)b3 * MTOK * DM + off);
                                acc8[0] += __uint_as_float(gw.x << 16) * __uint_as_float(rw.x << 16); acc8[1] += __uint_as_float(gw.x & 0xffff0000u) * __uint_as_float(rw.x & 0xffff0000u);
                                acc8[2] += __uint_as_float(gw.y << 16) * __uint_as_float(rw.y << 16); acc8[3] += __uint_as_float(gw.y & 0xffff0000u) * __uint_as_float(rw.y & 0xffff0000u);
                                acc8[4] += __uint_as_float(gw.z << 16) * __uint_as_float(rw.z << 16); acc8[5] += __uint_as_float(gw.z & 0xffff0000u) * __uint_as_float(rw.z & 0xffff0000u);
                                acc8[6] += __uint_as_float(gw.w << 16) * __uint_as_float(rw.w << 16); acc8[7] += __uint_as_float(gw.w & 0xffff0000u) * __uint_as_float(rw.w & 0xffff0000u);
                            }
                            *(u32x4*)(R + off) = pack8(acc8);
                        }
                    }
                }
#endif
            } else if (sp == 4) {
#if 0
                const bf16_t* Gp = (const bf16_t*)(ws + A_G); bf16_t* R = (bf16_t*)(ws + A_MIXED);
                for (int i = bx * NTHR + tid; i < MTOK * DM / 8; i += G * NTHR) {
                    const int r = i >> 7, c = (i & 127) * 8; const unsigned off = (unsigned)r * DM + c;
                    float acc8[8] = {0.f, 0.f, 0.f, 0.f, 0.f, 0.f, 0.f, 0.f};
#pragma unroll
                    for (int b3 = 0; b3 < 3; ++b3) {
                        const u32x4 gw = *(const u32x4*)(Gp + (unsigned)r * NGATE + b3 * 1024 + c), rw = *(const u32x4*)(R + (size_t)b3 * MTOK * DM + off);
                        acc8[0] += __uint_as_float(gw.x << 16) * __uint_as_float(rw.x << 16); acc8[1] += __uint_as_float(gw.x & 0xffff0000u) * __uint_as_float(rw.x & 0xffff0000u);
                        acc8[2] += __uint_as_float(gw.y << 16) * __uint_as_float(rw.y << 16); acc8[3] += __uint_as_float(gw.y & 0xffff0000u) * __uint_as_float(rw.y & 0xffff0000u);
                        acc8[4] += __uint_as_float(gw.z << 16) * __uint_as_float(rw.z << 16); acc8[5] += __uint_as_float(gw.z & 0xffff0000u) * __uint_as_float(rw.z & 0xffff0000u);
                        acc8[6] += __uint_as_float(gw.w << 16) * __uint_as_float(rw.w << 16); acc8[7] += __uint_as_float(gw.w & 0xffff0000u) * __uint_as_float(rw.w & 0xffff0000u);
                    }
                    *(u32x4*)(R + off) = pack8(acc8);
                }
#endif
            } else if (sp == 5 || sp == 8) {
#if (PHMASK & 32)
                EpiY E{a, l, sp == 5 ? 0 : 1};
                if (sp == 5) run_gemm(lds, tid, G, bx, (const bf16_t*)(ws + A_MIXEDB), (const bf16_t*)(ws + W_OUT), 1024, 1024, E);
                else run_gemm(lds, tid, G, bx, (const bf16_t*)(ws + A_U), (const bf16_t*)(ws + W_DN), 1024, 4096, E);
#endif
            } else if (sp == 6 || sp == 9) {
#if (PHMASK & 64)
                const float* xin = (sp == 6 && l == 0) ? a->in[0] : a->out;
                const float* Y = (const float*)(ws + (sp == 6 ? A_Y : A_Y2));
                const float* gpost = (sp == 6 ? a->in[14] : a->in[18]) + l * DM;
                for (int r = gw; r < MTOK; r += ngw) row_update(xin, a->out, Y, sp == 6 ? ssq_y : ssq_y2, gpost, XB, ctl + (sp == 6 ? SS_X1 : SS_X), r, lane);
                if (sp == 9 && l + 1 < DEPTH) conv_layer(a, l + 1, lds, gw, ngw, wave, lane);
#endif
            } else if (sp == 7) {
#if (PHMASK & 128)
                EpiUp E{a};
                run_gemm(lds, tid, G, bx, XB, (const bf16_t*)(ws + W_UP), FF, 1024, E);
#endif
            }
        }
    }
}

__global__ void __launch_bounds__(NTHR, 2) mk_fwd(Args a_) {
    extern __shared__ __attribute__((aligned(16))) unsigned char lds_raw[];
    LAS unsigned char* lds = (LAS unsigned char*)lds_raw;
    cg::grid_group grid = cg::this_grid();
    const int ph_lo = a_.ph_lo, ph_hi = a_.ph_hi;
    const int wave_s = __builtin_amdgcn_readfirstlane(threadIdx.x >> 6);
    static_assert(NPHASES == 41, "phase list below");
#define SEAM(P) do { if ((P) == 0 || gridDim.x != 256) grid.sync(); else { unsigned o_ = ~0u; int bx_ = blockIdx.x; asm volatile("" : "+s"(o_), "+s"(bx_)); const int t_ = wave_s * 64 + (int)__builtin_amdgcn_mbcnt_hi(o_, __builtin_amdgcn_mbcnt_lo(o_, 0u)); ms::grid_sync((unsigned*)(a_.ws + WS_BAR), t_, bx_); } } while (0)
#define RUN_PH(P) if (!((P) > 0 && ((P) - 1) % NPH_LAYER == 4) && ph_lo <= (P) && (P) < ph_hi) { do_phase<P>(lds, wave_s); if ((P) + 1 < ph_hi) SEAM(P); }
    RUN_PH(0)
    RUN_PH(1)
    RUN_PH(2)
    RUN_PH(3)
    RUN_PH(4)
    RUN_PH(5)
    RUN_PH(6)
    RUN_PH(7)
    RUN_PH(8)
    RUN_PH(9)
    RUN_PH(10)
    RUN_PH(11)
    RUN_PH(12)
    RUN_PH(13)
    RUN_PH(14)
    RUN_PH(15)
    RUN_PH(16)
    RUN_PH(17)
    RUN_PH(18)
    RUN_PH(19)
    RUN_PH(20)
    RUN_PH(21)
    RUN_PH(22)
    RUN_PH(23)
    RUN_PH(24)
    RUN_PH(25)
    RUN_PH(26)
    RUN_PH(27)
    RUN_PH(28)
    RUN_PH(29)
    RUN_PH(30)
    RUN_PH(31)
    RUN_PH(32)
    RUN_PH(33)
    RUN_PH(34)
    RUN_PH(35)
    RUN_PH(36)
    RUN_PH(37)
    RUN_PH(38)
    RUN_PH(39)
    RUN_PH(40)
#undef RUN_PH
#undef SEAM
}

#ifdef DBG_STOP
__global__ void dbg_dump(const unsigned short* ws16, float* out) {
    const size_t i = (size_t)blockIdx.x * blockDim.x + threadIdx.x;
    if (i >= (size_t)MTOK * DM) return;
    float acc = 0.f;
#ifdef DBG_OFF
#ifdef DBG_F32
    acc = ((const float*)ws16)[(size_t)(DBG_OFF) / 4 + i];
#else
    { const unsigned short w = ws16[(size_t)(DBG_OFF) / 2 + i]; acc = __uint_as_float((unsigned)w << 16); }
#endif
#else
    const size_t base = WS_XB / 2, total = (WS_END - WS_XB) / 2;
    for (size_t o = i; o < total; o += (size_t)MTOK * DM) { const unsigned short w = ws16[base + o]; if (((w >> 7) & 0xff) != 0xff) acc += __uint_as_float((unsigned)w << 16); }
#endif
    out[i] = acc;
}
#endif
}

extern "C" void kernel_launch(void* const* d_in, const int* in_sizes, int n_in, void* d_out, int out_size, void* d_ws, size_t ws_size, hipStream_t stream) {
    using namespace mk;
    static int grid = 0;
    if (grid == 0) {
        if (n_in != 19 || out_size != MTOK * DM || ws_size < WS_END) { fprintf(stderr, "kernel_launch: unexpected shapes (n_in %d, out %d, ws %zu < %zu)\n", n_in, out_size, ws_size, (size_t)WS_END); grid = -1; return; }
        int dev = 0, cus = 0, per_cu = 0;
        (void)hipGetDevice(&dev); (void)hipDeviceGetAttribute(&cus, hipDeviceAttributeMultiprocessorCount, dev);
        (void)hipFuncSetAttribute((const void*)mk_fwd, hipFuncAttributeMaxDynamicSharedMemorySize, LDS_BYTES);
        if (hipOccupancyMaxActiveBlocksPerMultiprocessor(&per_cu, (const void*)mk_fwd, NTHR, LDS_BYTES) != hipSuccess || per_cu < 1) { fprintf(stderr, "kernel_launch: occupancy query says %d\n", per_cu); per_cu = 1; }
        (void)hipGetLastError();
        grid = cus * per_cu;
        if (grid < 256) { fprintf(stderr, "kernel_launch: this kernel needs a 256-workgroup resident grid (got %d)\n", grid); grid = -1; return; }
        if (grid > 256) grid = 256;
    }
    if (grid < 0) return;
    Args a{};
    for (int i = 0; i < 19; ++i) a.in[i] = (const float*)d_in[i];
    a.pos = (const int*)d_in[1]; a.out = (float*)d_out; a.ws = (unsigned char*)d_ws;
#if ONE_LAUNCH
    a.ph_lo = 0; a.ph_hi = NPHASES;
    void* args[] = {&a};
    hipError_t e = hipLaunchCooperativeKernel((const void*)mk_fwd, dim3(grid), dim3(NTHR), args, LDS_BYTES, stream);
    if (e != hipSuccess) fprintf(stderr, "cooperative launch failed: %s (grid %d)\n", hipGetErrorString(e), grid);
#else
#ifdef DBG_STOP
    for (int ph = 0; ph <= DBG_STOP; ++ph) { a.ph_lo = ph; a.ph_hi = ph + 1; hipLaunchKernelGGL(mk_fwd, dim3(grid), dim3(NTHR), LDS_BYTES, stream, a); }
#ifndef DBG_NODUMP
    hipLaunchKernelGGL(dbg_dump, dim3(MTOK * DM / 256), dim3(256), 0, stream, (const unsigned short*)d_ws, (float*)d_out);
#endif
#else
    for (int ph = 0; ph < NPHASES; ++ph) { a.ph_lo = ph; a.ph_hi = ph + 1; hipLaunchKernelGGL(mk_fwd, dim3(grid), dim3(NTHR), LDS_BYTES, stream, a); }
#endif
#endif
}
```

```cpp
#include <hip/hip_runtime.h>
#include <hip/hip_cooperative_groups.h>
#include <cstdio>
#include <cstdint>
namespace cg = cooperative_groups;
#define ONE_LAUNCH 1
namespace pg8 {
#define PG8_LAS __attribute__((address_space(3)))
typedef unsigned short bf16_t;
typedef short bf16x8 __attribute__((ext_vector_type(8)));
typedef float f32x4 __attribute__((ext_vector_type(4)));
typedef unsigned u32x4 __attribute__((ext_vector_type(4)));
constexpr int BM = 256, BK = 64, HALF = 128, HTB = HALF * BK * 2  , STAGE_BYTES = 8 * HTB, NXCD = 8, WGM = 8;

__host__ __device__ __forceinline__ int lds_byte(int r, int c) { const int st = (r >> 4) * 2 + (c >> 5), rr = r & 15, cc = c & 31, ob = rr * 64 + cc * 2; return st * 1024 + (ob ^ (((ob >> 9) & 1) << 5)); }
__host__ __device__ __forceinline__ void stage_rc(int b, int& R, int& C) { const int st = b / 1024, sb = b % 1024, swz = sb ^ (((sb >> 9) & 1) << 5); R = (st >> 1) * 16 + swz / 64; C = (st & 1) * 32 + (swz % 64) / 2; }
__host__ __device__ __forceinline__ int perm32(int rho) { const int n = rho >> 4, i = rho & 15; return 8 * (i >> 2) + 4 * n + (i & 3); }

struct Unit { int pm, pn; };
struct Gemm { const bf16_t* A; const bf16_t* Bt; int M, N, K; };

struct StaticOrder {
    int nM, nN, nwg, G, c;
    __host__ __device__ void init(int M, int N, int G_, int c_) { nM = M / BM; nN = N / BM; nwg = nM * nN; G = G_; c = c_; }
    __host__ __device__ bool next(int i, Unit& u) const {
        const long L = (long)i * G + c; if (L >= nwg) return false;
        int wgid = (int)L; { const int q = nwg / NXCD, r = nwg % NXCD, xcd = wgid % NXCD, off = wgid / NXCD; wgid = (xcd < r ? xcd * (q + 1) : r * (q + 1) + (xcd - r) * q) + off; }
        const int nig = WGM * nN, gid = wgid / nig, fm = gid * WGM, gsz = (nM - fm) < WGM ? (nM - fm) : WGM;
        u.pm = fm + ((wgid % nig) % gsz); u.pn = (wgid % nig) / gsz; return true;
    }
    __device__ __forceinline__ void a_ready(const Unit&) const {}
    __device__ __forceinline__ void done(const Unit&) const {}
};

__device__ __forceinline__ unsigned cvt_pk_bf16(float lo, float hi) { unsigned r; asm volatile("v_cvt_pk_bf16_f32 %0, %1, %2" : "=v"(r) : "v"(lo), "v"(hi)); return r; }
template <class Epi, class Sched, bool ALIGN_EPI = false, bool SP2 = false>
__device__ __forceinline__ void gemm_phase(PG8_LAS unsigned char* lds, const Gemm g, const Sched& S, const Epi& E, int tid_in) {
    int tid_ = tid_in; asm volatile("" : "+v"(tid_));
    const int tid = tid_, wid = __builtin_amdgcn_readfirstlane(tid >> 6), lane = tid & 63, wr = wid >> 2, wc = wid & 3, fr = lane & 15, fq = lane >> 4;
    const int K = g.K, nt = K / BK;
    unsigned voffA[2], voffB[2];
#pragma unroll
    for (int i = 0; i < 2; ++i) { int R, C; stage_rc(tid * 16 + i * 8192, R, C); const int Rb = Epi::PERM ? ((R & ~31) + perm32(R & 31)) : R;
        voffA[i] = (unsigned)(R * K + C) * 2u; voffB[i] = (unsigned)(Rb * K + C) * 2u; }
    const size_t kstep = (size_t)(BK * 2);
    const size_t hstep = (size_t)HALF * K * 2;
    const size_t tstep = 2 * hstep;
    const unsigned ldsw = (unsigned)wid * 1024u;
    const int aoff = lds_byte(wr * 64 + fr, fq * 8), boff = lds_byte(wc * 32 + fr, fq * 8);
#define PG8_SA(b, h) (((b) * 2 + (h)) * HTB)
#define PG8_SB(b, h) ((4 + (b) * 2 + (h)) * HTB)
#define PG8_STAGE(bufoff, gbase, voff) do { _Pragma("unroll") for (int _i = 0; _i < 2; ++_i) \
        __builtin_amdgcn_global_load_lds((const unsigned*)((const char*)(gbase) + (voff)[_i]), (PG8_LAS unsigned*)(lds + (bufoff) + ldsw + _i * 8192), 16, 0, 0); } while (0)
#define PG8_LDA(dst, b, h) do { _Pragma("unroll") for (int m = 0; m < 4; ++m) _Pragma("unroll") for (int k = 0; k < 2; ++k) dst[m][k] = *(const PG8_LAS bf16x8*)(lds + PG8_SA(b, h) + aoff + m * 2048 + k * 1024); } while (0)
#define PG8_LDB(dst, b, h) do { _Pragma("unroll") for (int n = 0; n < 2; ++n) _Pragma("unroll") for (int k = 0; k < 2; ++k) dst[n][k] = *(const PG8_LAS bf16x8*)(lds + PG8_SB(b, h) + boff + n * 2048 + k * 1024); } while (0)
#define PG8_MMA(ai, bj, At, Bt) do { __builtin_amdgcn_s_setprio(1); _Pragma("unroll") for (int m = 0; m < 4; ++m) _Pragma("unroll") for (int n = 0; n < 2; ++n) _Pragma("unroll") for (int k = 0; k < 2; ++k) \
        acc[ai][bj][m][n] = __builtin_amdgcn_mfma_f32_16x16x32_bf16(Bt[n][k], At[m][k], acc[ai][bj][m][n], 0, 0, 0); __builtin_amdgcn_s_setprio(0); } while (0)
#define PG8_WAIT_V(n) asm volatile("s_waitcnt vmcnt(" #n ")" ::: "memory")
#define PG8_WAIT_L(n) asm volatile("s_waitcnt lgkmcnt(" #n ")" ::: "memory")
#define PG8_BAR __builtin_amdgcn_s_barrier()
#define PG8_SCHED __builtin_amdgcn_sched_barrier(0)
    Unit cur, nxt; int ui = 0;
    if (!S.next(0, cur)) return;
    f32x4 acc[2][2][4][2];
    float z_ = 0.f; asm volatile("" : "+v"(z_));
#pragma unroll
    for (int a = 0; a < 2; ++a)
#pragma unroll
        for (int b = 0; b < 2; ++b)
#pragma unroll
            for (int m = 0; m < 4; ++m)
#pragma unroll
                for (int n = 0; n < 2; ++n) acc[a][b][m][n] = (f32x4){z_, z_, z_, z_};
    bf16x8 At[4][2], B0[2][2], B1[2][2];
    const char* cA = (const char*)g.A + (size_t)cur.pm * tstep; const char* cB = (const char*)g.Bt + (size_t)cur.pn * tstep;
    S.a_ready(cur);
    if constexpr (SP2) {
        PG8_STAGE(PG8_SB(0, 0), cB, voffB); PG8_STAGE(PG8_SB(0, 1), cB + hstep, voffB); PG8_STAGE(PG8_SA(0, 0), cA, voffA); PG8_STAGE(PG8_SA(0, 1), cA + hstep, voffA);
        if (wr == 1) PG8_BAR;
        PG8_WAIT_V(2); PG8_BAR;
        PG8_STAGE(PG8_SB(1, 0), cB + kstep, voffB); PG8_STAGE(PG8_SA(1, 0), cA + kstep, voffA); PG8_STAGE(PG8_SB(1, 1), cB + hstep + kstep, voffB);
        PG8_WAIT_V(6); PG8_BAR;
    } else {
        PG8_STAGE(PG8_SB(0, 0), cB, voffB); PG8_STAGE(PG8_SA(0, 0), cA, voffA); PG8_STAGE(PG8_SB(0, 1), cB + hstep, voffB); PG8_STAGE(PG8_SA(0, 1), cA + hstep, voffA);
        if (wr == 1) PG8_BAR;
        PG8_WAIT_V(4); PG8_BAR;
        PG8_STAGE(PG8_SB(1, 0), cB + kstep, voffB); PG8_STAGE(PG8_SA(1, 0), cA + kstep, voffA); PG8_STAGE(PG8_SB(1, 1), cB + hstep + kstep, voffB);
        PG8_WAIT_V(6); PG8_BAR;
    }
    for (;;) {
        const bool has_next = S.next(ui + 1, nxt);
        const char* nA = has_next ? (const char*)g.A + (size_t)nxt.pm * tstep : cA; const char* nB = has_next ? (const char*)g.Bt + (size_t)nxt.pn * tstep : cB;
        for (int t = 0; t < nt; t += 2) {
            const bool last = (t == nt - 2);
            const char* a1 = cA + (size_t)(t + 1) * kstep;
            const char* a2 = last ? nA : cA + (size_t)(t + 2) * kstep; const char* b2 = last ? nB : cB + (size_t)(t + 2) * kstep;
            const char* a3 = a2 + kstep; const char* b3 = b2 + kstep;
            if (last && has_next) S.a_ready(nxt);
            if constexpr (SP2) {
            PG8_LDB(B0, 0, 0); PG8_LDB(B1, 0, 1); PG8_SCHED; PG8_LDA(At, 0, 0); PG8_STAGE(PG8_SA(1, 1), a1 + hstep, voffA);
            PG8_WAIT_V(8); PG8_WAIT_L(0); PG8_BAR; PG8_MMA(0, 0, At, B0); PG8_MMA(0, 1, At, B1); PG8_BAR; PG8_SCHED;
            PG8_LDA(At, 0, 1); PG8_STAGE(PG8_SB(0, 0), b2, voffB); PG8_STAGE(PG8_SB(0, 1), b2 + hstep, voffB); PG8_STAGE(PG8_SA(0, 0), a2, voffA);
            PG8_WAIT_V(8); PG8_WAIT_L(0); PG8_BAR; PG8_MMA(1, 0, At, B0); PG8_MMA(1, 1, At, B1); PG8_BAR; PG8_SCHED;
            PG8_LDB(B0, 1, 0); PG8_LDB(B1, 1, 1); PG8_SCHED; PG8_LDA(At, 1, 0); PG8_STAGE(PG8_SA(0, 1), a2 + hstep, voffA);
            PG8_WAIT_V(8); PG8_WAIT_L(0); PG8_BAR; PG8_MMA(0, 0, At, B0); PG8_MMA(0, 1, At, B1); PG8_BAR; PG8_SCHED;
            PG8_LDA(At, 1, 1); PG8_STAGE(PG8_SB(1, 0), b3, voffB); PG8_STAGE(PG8_SB(1, 1), b3 + hstep, voffB); PG8_STAGE(PG8_SA(1, 0), a3, voffA);
            PG8_WAIT_V(8); PG8_WAIT_L(0); PG8_BAR; PG8_MMA(1, 0, At, B0); PG8_MMA(1, 1, At, B1); PG8_BAR; PG8_SCHED;
            } else {
            PG8_LDB(B0, 0, 0); PG8_SCHED; PG8_LDA(At, 0, 0); PG8_STAGE(PG8_SA(1, 1), a1 + hstep, voffA);
            PG8_WAIT_L(8); PG8_BAR; PG8_WAIT_L(0); PG8_MMA(0, 0, At, B0); PG8_BAR; PG8_SCHED;
            PG8_LDB(B1, 0, 1); PG8_STAGE(PG8_SB(0, 0), b2, voffB);
            PG8_BAR; PG8_WAIT_L(0); PG8_MMA(0, 1, At, B1); PG8_BAR;
            PG8_LDA(At, 0, 1); PG8_STAGE(PG8_SA(0, 0), a2, voffA);
            PG8_BAR; PG8_WAIT_L(0); PG8_MMA(1, 0, At, B0); PG8_BAR; PG8_SCHED;
            PG8_STAGE(PG8_SB(0, 1), b2 + hstep, voffB);
            PG8_WAIT_V(6); PG8_BAR; PG8_MMA(1, 1, At, B1); PG8_BAR;
            PG8_LDB(B0, 1, 0); PG8_SCHED; PG8_LDA(At, 1, 0); PG8_STAGE(PG8_SA(0, 1), a2 + hstep, voffA);
            PG8_WAIT_L(8); PG8_BAR; PG8_WAIT_L(0); PG8_MMA(0, 0, At, B0); PG8_BAR; PG8_SCHED;
            PG8_LDB(B1, 1, 1); PG8_STAGE(PG8_SB(1, 0), b3, voffB);
            PG8_BAR; PG8_WAIT_L(0); PG8_MMA(0, 1, At, B1); PG8_BAR;
            PG8_LDA(At, 1, 1); PG8_STAGE(PG8_SA(1, 0), a3, voffA);
            PG8_BAR; PG8_WAIT_L(0); PG8_MMA(1, 0, At, B0); PG8_BAR; PG8_SCHED;
            PG8_STAGE(PG8_SB(1, 1), b3 + hstep, voffB);
            PG8_WAIT_V(6); PG8_BAR; PG8_MMA(1, 1, At, B1); PG8_BAR;
            }
        }
        if constexpr (ALIGN_EPI) { if (wr == 0) PG8_BAR; }
        if constexpr (!Epi::AFTER_DRAIN) { E(acc, cur, wr, wc, fr, fq); S.done(cur); }
        if (!has_next) break;
        z_ = 0.f; asm volatile("" : "+v"(z_));
#pragma unroll
        for (int a = 0; a < 2; ++a)
#pragma unroll
            for (int b = 0; b < 2; ++b)
#pragma unroll
                for (int m = 0; m < 4; ++m)
#pragma unroll
                    for (int n = 0; n < 2; ++n) acc[a][b][m][n] = (f32x4){z_, z_, z_, z_};
        cur = nxt; cA = nA; cB = nB; ++ui;
        if constexpr (ALIGN_EPI) { if (wr == 1) PG8_BAR; }
    }
    PG8_WAIT_V(0);
    if constexpr (!ALIGN_EPI) { if (wr == 0) PG8_BAR; }
    PG8_BAR;
    if constexpr (Epi::AFTER_DRAIN) { E.fused(acc, cur, wr, wc, fr, fq, lds, wid, lane); S.done(cur); }
#undef PG8_SA
#undef PG8_SB
#undef PG8_STAGE
#undef PG8_LDA
#undef PG8_LDB
#undef PG8_MMA
#undef PG8_WAIT_V
#undef PG8_WAIT_L
#undef PG8_BAR
#undef PG8_SCHED
}
}
namespace ms {
__device__ __forceinline__ unsigned ld(const unsigned* p) { return __hip_atomic_load(p, __ATOMIC_RELAXED, __HIP_MEMORY_SCOPE_AGENT); }
__device__ __forceinline__ void st(unsigned* p, unsigned v) { __hip_atomic_store(p, v, __ATOMIC_RELAXED, __HIP_MEMORY_SCOPE_AGENT); }
constexpr int W_ARR = 0, W_GF = 512, W_REL = 1024;
__device__ __forceinline__ void grid_sync(unsigned* bw, int tid, int bx, unsigned seam) {
    asm volatile("s_waitcnt vmcnt(0)" ::: "memory");
    __syncthreads();
    if (tid < 64) {
        if (tid == 0) { __builtin_amdgcn_fence(__ATOMIC_RELEASE, "agent"); asm volatile("s_waitcnt vmcnt(0)" ::: "memory"); st(&bw[W_ARR + bx], seam); }
        if ((bx & 31) == 0) {
            const int g = bx >> 5;
            for (unsigned sp = 0; sp < (1u << 22); ++sp) { const unsigned v = (tid < 32) ? ld(&bw[W_ARR + g * 32 + tid]) : seam; if (__all(v == seam)) break; __builtin_amdgcn_s_sleep(1); }
            if (tid == 0) st(&bw[W_GF + 32 * g], seam);
            if (bx == 0) {
                for (unsigned sp = 0; sp < (1u << 22); ++sp) { const unsigned v = (tid < 8) ? ld(&bw[W_GF + 32 * tid]) : seam; if (__all(v == seam)) break; __builtin_amdgcn_s_sleep(1); }
                if (tid == 0) st(&bw[W_REL], seam);
            }
        }
        for (unsigned sp = 0; sp < (1u << 22); ++sp) { const unsigned v = ld(&bw[W_REL]); if (__all(v == seam)) break; __builtin_amdgcn_s_sleep(1); }
        if (tid == 0) { __builtin_amdgcn_fence(__ATOMIC_ACQUIRE, "agent"); asm volatile("s_waitcnt vmcnt(0)" ::: "memory"); }
    }
    __syncthreads();
}
}

#ifndef PHMASK
#define PHMASK 0x3ff
#endif
#ifndef ONE_LAUNCH
#define ONE_LAUNCH 1
#endif
namespace mk {
using pg8::bf16_t; using pg8::f32x4; using pg8::bf16x8; using pg8::u32x4; using pg8::Unit; using pg8::cvt_pk_bf16;
#define LAS __attribute__((address_space(3)))
typedef float f32x16 __attribute__((ext_vector_type(16)));
typedef unsigned u32x2 __attribute__((ext_vector_type(2)));
typedef short s16x4 __attribute__((ext_vector_type(4)));
#define DI __device__ __forceinline__
#define MFMA32(a, b, c) __builtin_amdgcn_mfma_f32_32x32x16_bf16((a), (b), (c), 0, 0, 0)

constexpr int BATCH = 2, SEQ = 8192, DM = 1024, MTOK = BATCH * SEQ, DEPTH = 4, FF = 4096, NIN = 5888, NGATE = 3072;
constexpr float EPS = 1e-6f, LOG2E = 1.4426950408889634f;
constexpr int NTHR = 512, LDS_BYTES = 147456;
constexpr int NPH_LAYER = 10, NPHASES = 1 + NPH_LAYER * DEPTH;

constexpr size_t MiB = (size_t)1 << 20;
constexpr size_t WS_CTL = 0, WS_TAB = 2 * MiB, WS_W = 6 * MiB, WS_XB = 40 * MiB, WS_AR = 72 * MiB, WS_END = WS_AR + 249 * MiB;
constexpr size_t W_IN = WS_W, W_UQ = W_IN + (size_t)NIN * 1024 * 2, W_UKV = W_UQ + 768 * 256 * 2, W_OA = W_UKV + 1024 * 256 * 2, W_OB = W_OA + 1024 * 512 * 2,
                 W_OC = W_OB + 1024 * 512 * 2, W_OUT = W_OC + 1024 * 512 * 2, W_UP = W_OUT + 1024 * 1024 * 2, W_DN = W_UP + (size_t)4096 * 1024 * 2, W_ENDW = W_DN + (size_t)4096 * 1024 * 2;
static_assert(W_ENDW <= WS_XB, "weights fit");
constexpr size_t A_G = WS_AR, A_QSWA = WS_AR + 96 * MiB, A_QSB = WS_AR + 112 * MiB, A_KSB = WS_AR + 128 * MiB, A_VTSB = WS_AR + 144 * MiB, A_CQ = WS_AR + 160 * MiB,
                 A_CKV = WS_AR + 237 * MiB  , A_KPE = WS_AR + 172 * MiB, A_KSWA = WS_AR + 173 * MiB, A_VTSWA = WS_AR + 177 * MiB, A_QMLA = WS_AR + 181 * MiB,
                 A_KNOPE = WS_AR + 205 * MiB, A_VTMLA = WS_AR + 221 * MiB;
constexpr size_t A_MIXED = WS_AR + 128 * MiB, A_MIXEDB = WS_AR + 128 * MiB  , A_Y = WS_AR, A_U = WS_AR, A_Y2 = WS_AR + 128 * MiB, A_OMLA = WS_XB;
constexpr int SS_X = 0, SS_X1 = MTOK, SS_L0 = 2 * MTOK;
constexpr size_t WS_BAR = WS_CTL + MiB, BAR_BYTES = 16384;
constexpr size_t A_SSP = WS_AR + 245 * MiB;
constexpr int SP_CQ = 0, SP_CKV = 4 * MTOK, SP_Y = 8 * MTOK, SP_Y2 = 24 * MTOK;

__constant__ float ROPE_INV[32] = {1.000000000e+00f, 7.498942018e-01f, 5.623413324e-01f, 4.216965139e-01f, 3.162277639e-01f, 2.371373773e-01f, 1.778279394e-01f, 1.333521456e-01f, 1.000000015e-01f, 7.498942316e-02f, 5.623413250e-02f, 4.216964915e-02f, 3.162277490e-02f, 2.371373773e-02f, 1.778279431e-02f, 1.333521400e-02f, 9.999999776e-03f, 7.498942316e-03f, 5.623413250e-03f, 4.216964822e-03f, 3.162277630e-03f, 2.371373819e-03f, 1.778279431e-03f, 1.333521446e-03f, 1.000000047e-03f, 7.498941850e-04f, 5.623413017e-04f, 4.216965172e-04f, 3.162277571e-04f, 2.371373703e-04f, 1.778279402e-04f, 1.333521504e-04f};
struct Args { const float* in[19]; const int* pos; float* out; unsigned char* ws; int ph_lo, ph_hi; };
typedef const __attribute__((address_space(4))) Args* CArgsP;

DI float shx(float v, int mask, int lane) { return __int_as_float(__builtin_amdgcn_ds_bpermute((lane ^ mask) << 2, __float_as_int(v))); }
DI float wave_sum(float v, int lane) {
#pragma unroll
    for (int o = 1; o < 64; o <<= 1) v += shx(v, o, lane);
    return v;
}
DI float bf2f(unsigned short b) { return __uint_as_float((unsigned)b << 16); }
DI u32x4 pack8(const float* v) { u32x4 w; w.x = cvt_pk_bf16(v[0], v[1]); w.y = cvt_pk_bf16(v[2], v[3]); w.z = cvt_pk_bf16(v[4], v[5]); w.w = cvt_pk_bf16(v[6], v[7]); return w; }
DI u32x2 pack4(float a, float b, float c, float d) { u32x2 w; w.x = cvt_pk_bf16(a, b); w.y = cvt_pk_bf16(c, d); return w; }
DI float fast_rsq(float x) { return __builtin_amdgcn_rsqf(x); }

DI int perm64inv(int d) { return d < 32 ? 8 * (d >> 2) + (d & 3) : 8 * ((d - 32) >> 2) + 4 + (d & 3); }
DI int perm32inv(int d) { return d < 16 ? 8 * (d >> 2) + (d & 3) : 8 * ((d - 16) >> 2) + 4 + (d & 3); }
DI int rowmap(int kind, int n) {
    if (kind == 0) return n;
    if (kind == 1) {
        if (n < 384) return n;
        if (n < 416) return 384 + perm32inv(n - 384);
        if (n < 928) { const int t = n - 416; return 512 + (t & ~63) + perm64inv(t & 63); }
        if (n < 1056) { const int t = n - 928; return 1024 + (t & ~63) + perm64inv(t & 63); }
        return n + 96;
    }
    if (kind == 2) { const int h = n / 96, j = n % 96; return j < 64 ? h * 64 + j : 512 + h * 32 + perm32inv(j - 64); }
    { const int h = n >> 7, j = n & 127; return j < 64 ? h * 64 + j : 512 + h * 64 + (j - 64); }
}
DI void conv_item(const float* W, int K, int N, bf16_t* WT, const float* gk, int kind, LAS float* scr, int item, int lane, int ldw = 0) {
    if (ldw == 0) ldw = K;
    const int nblk = N / 32, kb = item / nblk, nb = item % nblk, k0 = 64 * kb, n0 = 32 * nb;
#pragma unroll 8
    for (int i = 0; i < 32; ++i) { const int kk = 2 * i + (lane >> 5); float v = W[(size_t)(k0 + kk) * N + n0 + (lane & 31)]; if (gk) v *= gk[k0 + kk]; scr[kk * 33 + (lane & 31)] = v; }
    asm volatile("s_waitcnt lgkmcnt(0)" ::: "memory");
    const int c = lane & 7;
#pragma unroll
    for (int j = 0; j < 4; ++j) { const int n = (lane >> 3) + 8 * j; const LAS float* s = scr + (8 * c) * 33 + n;
        u32x4 o; o.x = cvt_pk_bf16(s[0 * 33], s[1 * 33]); o.y = cvt_pk_bf16(s[2 * 33], s[3 * 33]); o.z = cvt_pk_bf16(s[4 * 33], s[5 * 33]); o.w = cvt_pk_bf16(s[6 * 33], s[7 * 33]);
        *(u32x4*)(WT + (size_t)rowmap(kind, n0 + n) * ldw + k0 + 8 * c) = o; }
    asm volatile("s_waitcnt lgkmcnt(0)" ::: "memory");
}
DI void conv_layer(CArgsP a, int l, LAS unsigned char* lds, int gw, int ngw, int wave, int lane) {
    LAS float* scr = (LAS float*)(lds + wave * 16384);
    unsigned char* ws = a->ws;
    constexpr int I_IN = 16 * 181, I_UQ = 4 * 24, I_UKV = 2 * 32, I_O = 8 * 32, I_OUT = 16 * 32, I_UP = 16 * 128, I_DN = 64 * 32;
    constexpr int NITEMS = I_IN + I_UQ + I_UKV + 3 * I_O + I_OUT + I_UP + I_DN;
    for (int it = gw; it < NITEMS; it += ngw) {
        int r = it;
        if (r < I_IN) { conv_item(a->in[3] + (size_t)l * 1024 * 5792, 1024, 5792, (bf16_t*)(ws + W_IN), a->in[2] + l * 1024, 1, scr, r, lane); continue; } r -= I_IN;
        if (r < I_UQ) { conv_item(a->in[7] + (size_t)l * 256 * 768, 256, 768, (bf16_t*)(ws + W_UQ), a->in[5] + l * 256, 2, scr, r, lane); continue; } r -= I_UQ;
        if (r < I_UKV) { conv_item(a->in[8] + (size_t)l * 128 * 1024, 128, 1024, (bf16_t*)(ws + W_UKV), a->in[6] + l * 128, 3, scr, r, lane, 256); continue; } r -= I_UKV;
        if (r < I_O) { conv_item(a->in[10] + (size_t)l * 512 * 1024, 512, 1024, (bf16_t*)(ws + W_OA), nullptr, 0, scr, r, lane); continue; } r -= I_O;
        if (r < I_O) { conv_item(a->in[11] + (size_t)l * 512 * 1024, 512, 1024, (bf16_t*)(ws + W_OB), nullptr, 0, scr, r, lane); continue; } r -= I_O;
        if (r < I_O) { conv_item(a->in[12] + (size_t)l * 512 * 1024, 512, 1024, (bf16_t*)(ws + W_OC), nullptr, 0, scr, r, lane); continue; } r -= I_O;
        if (r < I_OUT) { conv_item(a->in[13] + (size_t)l * 1024 * 1024, 1024, 1024, (bf16_t*)(ws + W_OUT), nullptr, 0, scr, r, lane); continue; } r -= I_OUT;
        if (r < I_UP) { conv_item(a->in[16] + (size_t)l * 1024 * 4096, 1024, 4096, (bf16_t*)(ws + W_UP), a->in[15] + l * 1024, 0, scr, r, lane); continue; } r -= I_UP;
        conv_item(a->in[17] + (size_t)l * 4096 * 1024, 4096, 1024, (bf16_t*)(ws + W_DN), nullptr, 0, scr, r, lane);
    }
}

DI void row_update(const float* xin, float* xout, const float* Y, const float* ssq_y, const float* g, bf16_t* XB, float* ssq_out, int r, int lane) {
    const f32x4* xr = (const f32x4*)(xin + (size_t)r * DM) + lane;
    float ss = 0.f;
    float rs = 0.f;
    if (Y) { float p_ = ssq_y[(unsigned)r * 16 + (lane & 15)]; p_ += shx(p_, 1, lane); p_ += shx(p_, 2, lane); p_ += shx(p_, 4, lane); p_ += shx(p_, 8, lane); rs = fast_rsq(p_ * (1.f / DM) + EPS); }
#pragma unroll
    for (int j = 0; j < 4; ++j) {
        f32x4 v = xr[64 * j];
        if (Y) { const f32x4 y = ((const f32x4*)(Y + (size_t)r * DM) + lane)[64 * j]; const f32x4 gg = ((const f32x4*)g + lane)[64 * j]; v = v + y * rs * gg; ((f32x4*)(xout + (size_t)r * DM) + lane)[64 * j] = v; }
        ss += (v.x * v.x + v.y * v.y) + (v.z * v.z + v.w * v.w);
        ((u32x2*)(XB + (size_t)r * DM) + lane)[64 * j] = pack4(v.x, v.y, v.z, v.w);
    }
    ss = wave_sum(ss, lane);
    if (lane == 0) ssq_out[r] = ss;
}

#define EPI_ROWS _Pragma("unroll") for (int ai = 0; ai < 2; ++ai) _Pragma("unroll") for (int m = 0; m < 4; ++m, ({ asm volatile("" ::: "memory"); }))
#define EPI_GETV(v, sc) float v[8]; { const f32x4 a0_ = acc[ai][bj][m][0], a1_ = acc[ai][bj][m][1]; v[0] = a0_[0] * (sc); v[1] = a0_[1] * (sc); v[2] = a0_[2] * (sc); v[3] = a0_[3] * (sc); v[4] = a1_[0] * (sc); v[5] = a1_[1] * (sc); v[6] = a1_[2] * (sc); v[7] = a1_[3] * (sc); }
DI void rope8(const float* v, const float* tc, const float* ts, int r, int i0, int stride, float* o1, float* o2) {
#pragma unroll
    for (int e = 0; e < 4; ++e) { const float c = tc[(unsigned)(r * 32 + (i0 + e) * stride)], s = ts[(unsigned)(r * 32 + (i0 + e) * stride)]; o1[e] = v[e] * c - v[4 + e] * s; o2[e] = v[4 + e] * c + v[e] * s; }
}
DI void vt_scatter(bf16_t* vt, int nh, int r, int h, int d0, const float* v) {
    const int b = r >> 13, s = r & (SEQ - 1);
    const unsigned off = (unsigned)(((b * nh + h) * 64 + d0) * SEQ + s);
#pragma unroll
    for (int j = 0; j < 8; j += 2) { const unsigned w = cvt_pk_bf16(v[j], v[j + 1]); vt[off + (unsigned)(j * SEQ)] = (bf16_t)(w & 0xffffu); vt[off + (unsigned)((j + 1) * SEQ)] = (bf16_t)(w >> 16); asm volatile("" ::: "memory"); }
}
DI void ssq_row_put(float part, float* dst, int fr, int fq) {
    const int lane = fq * 16 + fr; part += shx(part, 16, lane); part += shx(part, 32, lane);
    if (fq == 0) *dst = part;
}

struct EpiIn {
    static constexpr bool PERM = true, AFTER_DRAIN = false;
    CArgsP a0; int l;
    DI void operator()(const f32x4 (&acc)[2][2][4][2], const Unit& u, int wr, int wc, int fr0, int fq0) const {
        asm volatile("s_waitcnt vmcnt(0)" ::: "memory");     unsigned ones_ = ~0u; asm volatile("" : "+s"(ones_)); const int lane_ = (int)__builtin_amdgcn_mbcnt_hi(ones_, __builtin_amdgcn_mbcnt_lo(ones_, 0u)); const int fr = lane_ & 15, fq = lane_ >> 4; (void)fr0; (void)fq0;
        CArgsP a = a0; asm volatile("" : "+s"(a));
        unsigned char* ws = a->ws; float* ctl = (float*)(ws + WS_CTL);
        const float* ssq_x = ctl + SS_X; float* ssq_cq = (float*)(ws + A_SSP) + SP_CQ; float* ssq_ckv = (float*)(ws + A_SSP) + SP_CKV;
        const float* bgate = a->in[4] + l * NGATE; const float* tc = (const float*)(ws + WS_TAB); const float* ts = tc + (size_t)MTOK * 32;
        bf16_t *cq = (bf16_t*)(ws + A_CQ), *ckv = (bf16_t*)(ws + A_CKV), *kpe = (bf16_t*)(ws + A_KPE), *qswa = (bf16_t*)(ws + A_QSWA), *kswa = (bf16_t*)(ws + A_KSWA), *vtswa = (bf16_t*)(ws + A_VTSWA),
               *qsb = (bf16_t*)(ws + A_QSB), *ksb = (bf16_t*)(ws + A_KSB), *vtsb = (bf16_t*)(ws + A_VTSB), *G = (bf16_t*)(ws + A_G);
        const int pn = u.pn;
        EPI_ROWS {
            const int r = u.pm * 256 + ai * 128 + wr * 64 + m * 16 + fr;
            const float rs = fast_rsq(ssq_x[r] * (1.f / DM) + EPS);
            if (pn == 0) {
                float part = 0.f;
#pragma unroll
                for (int bj = 0; bj < 2; ++bj) { EPI_GETV(v, rs);
#pragma unroll
                    for (int j = 0; j < 8; ++j) part += v[j] * v[j];
                    *(u32x4*)(cq + (unsigned)r * 256 + bj * 128 + wc * 32 + fq * 8) = pack8(v); }
                ssq_row_put(part, ssq_cq + (unsigned)r * 4 + wc, fr, fq);
            } else if (pn == 1) {
                float part = 0.f;
                { constexpr int bj = 0; EPI_GETV(v, rs);
#pragma unroll
                    for (int j = 0; j < 8; ++j) part += v[j] * v[j];
                    *(u32x4*)(ckv + (unsigned)r * 256 + wc * 32 + fq * 8) = pack8(v); *(u32x4*)(ckv + (unsigned)r * 256 + 128 + wc * 32 + fq * 8) = (u32x4){0u, 0u, 0u, 0u}; }
                ssq_row_put(part, ssq_ckv + (unsigned)r * 4 + wc, fr, fq);
                if (wc == 0) { constexpr int bj = 1; EPI_GETV(v, rs); float o1[4], o2[4]; rope8(v, tc, ts, r, 4 * fq, 2, o1, o2);
                    *(u32x2*)(kpe + (unsigned)r * 32 + 4 * fq) = pack4(o1[0], o1[1], o1[2], o1[3]); *(u32x2*)(kpe + (unsigned)r * 32 + 16 + 4 * fq) = pack4(o2[0], o2[1], o2[2], o2[3]); }
            } else if (pn <= 3) {
                const float sc = rs * (0.125f * LOG2E);
#pragma unroll
                for (int bj = 0; bj < 2; ++bj) { EPI_GETV(v, sc); const int head = (pn - 2) * 4 + bj * 2 + (wc >> 1), g = 4 * (wc & 1) + fq; float o1[4], o2[4]; rope8(v, tc, ts, r, 4 * g, 1, o1, o2);
                    bf16_t* p = qswa + (unsigned)r * 512 + head * 64 + 4 * g; *(u32x2*)p = pack4(o1[0], o1[1], o1[2], o1[3]); *(u32x2*)(p + 32) = pack4(o2[0], o2[1], o2[2], o2[3]); }
            } else if (pn == 4) {
                { constexpr int bj = 0; EPI_GETV(v, rs); const int kvh = wc >> 1, g = 4 * (wc & 1) + fq; float o1[4], o2[4]; rope8(v, tc, ts, r, 4 * g, 1, o1, o2);
                    bf16_t* p = kswa + (unsigned)r * 128 + kvh * 64 + 4 * g; *(u32x2*)p = pack4(o1[0], o1[1], o1[2], o1[3]); *(u32x2*)(p + 32) = pack4(o2[0], o2[1], o2[2], o2[3]); }
                { constexpr int bj = 1; EPI_GETV(v, rs); vt_scatter(vtswa, 2, r, wc >> 1, 32 * (wc & 1) + 8 * fq, v); }
            } else if (pn <= 6) {
                const float sc = rs * 0.125f;
#pragma unroll
                for (int bj = 0; bj < 2; ++bj) { EPI_GETV(v, sc); *(u32x4*)(qsb + (unsigned)r * 512 + (pn - 5) * 256 + bj * 128 + wc * 32 + fq * 8) = pack8(v); }
            } else if (pn <= 8) {
#pragma unroll
                for (int bj = 0; bj < 2; ++bj) { EPI_GETV(v, rs); *(u32x4*)(ksb + (unsigned)r * 512 + (pn - 7) * 256 + bj * 128 + wc * 32 + fq * 8) = pack8(v); }
            } else if (pn <= 10) {
#pragma unroll
                for (int bj = 0; bj < 2; ++bj) { EPI_GETV(v, rs); const int c = (pn - 9) * 256 + bj * 128 + wc * 32 + fq * 8; vt_scatter(vtsb, 8, r, c >> 6, c & 63, v); }
            } else {
#pragma unroll
                for (int bj = 0; bj < 2; ++bj) { EPI_GETV(v, rs); const int c = (pn - 11) * 256 + bj * 128 + wc * 32 + fq * 8;
                    const f32x4 b0 = *(const f32x4*)(bgate + c), b1 = *(const f32x4*)(bgate + c + 4); const float bb[8] = {b0[0], b0[1], b0[2], b0[3], b1[0], b1[1], b1[2], b1[3]};
#pragma unroll
                    for (int j = 0; j < 8; ++j) v[j] = __builtin_amdgcn_rcpf(1.f + __expf(-(v[j] + bb[j])));
                    *(u32x4*)(G + (unsigned)r * NGATE + c) = pack8(v); }
            }
        }
    }
};
struct EpiUpQ {
    static constexpr bool PERM = true, AFTER_DRAIN = false;
    CArgsP a0; int l;
    DI void operator()(const f32x4 (&acc)[2][2][4][2], const Unit& u, int wr, int wc, int fr0, int fq0) const {
        asm volatile("s_waitcnt vmcnt(0)" ::: "memory");     unsigned ones_ = ~0u; asm volatile("" : "+s"(ones_)); const int lane_ = (int)__builtin_amdgcn_mbcnt_hi(ones_, __builtin_amdgcn_mbcnt_lo(ones_, 0u)); const int fr = lane_ & 15, fq = lane_ >> 4; (void)fr0; (void)fq0;
        CArgsP a = a0; asm volatile("" : "+s"(a));
        unsigned char* ws = a->ws; const float* ssq_cq = (const float*)(ws + A_SSP) + SP_CQ;
        const float* tc = (const float*)(ws + WS_TAB); const float* ts = tc + (size_t)MTOK * 32; bf16_t* qm = (bf16_t*)(ws + A_QMLA);
        const int pn = u.pn;
        EPI_ROWS {
            const int r = u.pm * 256 + ai * 128 + wr * 64 + m * 16 + fr; const int b = r >> 13, s = r & (SEQ - 1);
            const f32x4 pq_ = *(const f32x4*)(ssq_cq + (unsigned)r * 4); const float sc = fast_rsq(((pq_[0] + pq_[1]) + (pq_[2] + pq_[3])) * (1.f / 256) + EPS) * (0.10206207261596577f * LOG2E);
#pragma unroll
            for (int bj = 0; bj < 2; ++bj) { EPI_GETV(v, sc);
                if (pn < 2) { const int c = pn * 256 + bj * 128 + wc * 32 + fq * 8; *(u32x4*)(qm + (unsigned)(((b * 8 + (c >> 6)) * SEQ + s) * 96 + (c & 63))) = pack8(v); }
                else { const int h = bj * 4 + wc; float o1[4], o2[4]; rope8(v, tc, ts, r, 4 * fq, 2, o1, o2); bf16_t* p = qm + (unsigned)(((b * 8 + h) * SEQ + s) * 96 + 64 + 4 * fq);
                    *(u32x2*)p = pack4(o1[0], o1[1], o1[2], o1[3]); *(u32x2*)(p + 16) = pack4(o2[0], o2[1], o2[2], o2[3]); }
            }
        }
    }
};
struct EpiUpKV {
    static constexpr bool PERM = true, AFTER_DRAIN = false;
    CArgsP a0; int l;
    DI void operator()(const f32x4 (&acc)[2][2][4][2], const Unit& u, int wr, int wc, int fr0, int fq0) const {
        asm volatile("s_waitcnt vmcnt(0)" ::: "memory");     unsigned ones_ = ~0u; asm volatile("" : "+s"(ones_)); const int lane_ = (int)__builtin_amdgcn_mbcnt_hi(ones_, __builtin_amdgcn_mbcnt_lo(ones_, 0u)); const int fr = lane_ & 15, fq = lane_ >> 4; (void)fr0; (void)fq0;
        CArgsP a = a0; asm volatile("" : "+s"(a));
        unsigned char* ws = a->ws; const float* ssq_ckv = (const float*)(ws + A_SSP) + SP_CKV; bf16_t* knope = (bf16_t*)(ws + A_KNOPE); bf16_t* vt = (bf16_t*)(ws + A_VTMLA);
        const int pn = u.pn;
        EPI_ROWS {
            const int r = u.pm * 256 + ai * 128 + wr * 64 + m * 16 + fr;
            const f32x4 pk_ = *(const f32x4*)(ssq_ckv + (unsigned)r * 4); const float rs = fast_rsq(((pk_[0] + pk_[1]) + (pk_[2] + pk_[3])) * (1.f / 128) + EPS);
#pragma unroll
            for (int bj = 0; bj < 2; ++bj) { EPI_GETV(v, rs);
                if (pn < 2) *(u32x4*)(knope + (unsigned)r * 512 + pn * 256 + bj * 128 + wc * 32 + fq * 8) = pack8(v);
                else { const int c = (pn - 2) * 256 + bj * 128 + wc * 32 + fq * 8; vt_scatter(vt, 8, r, c >> 6, c & 63, v); }
            }
        }
    }
};
struct EpiBranch {
    static constexpr bool PERM = true, AFTER_DRAIN = false;
    CArgsP a0; int br;
    DI void operator()(const f32x4 (&acc)[2][2][4][2], const Unit& u, int wr, int wc, int fr0, int fq0) const {
        asm volatile("s_waitcnt vmcnt(0)" ::: "memory");     unsigned ones_ = ~0u; asm volatile("" : "+s"(ones_)); const int lane_ = (int)__builtin_amdgcn_mbcnt_hi(ones_, __builtin_amdgcn_mbcnt_lo(ones_, 0u)); const int fr = lane_ & 15, fq = lane_ >> 4; (void)fr0; (void)fq0;
        CArgsP a = a0; asm volatile("" : "+s"(a));
        bf16_t* R = (bf16_t*)(a->ws + A_MIXED) + (size_t)br * MTOK * DM;
        EPI_ROWS {
            const int r = u.pm * 256 + ai * 128 + wr * 64 + m * 16 + fr;
#pragma unroll
            for (int bj = 0; bj < 2; ++bj) { EPI_GETV(v, 1.f); *(u32x4*)(R + (unsigned)r * DM + u.pn * 256 + bj * 128 + wc * 32 + fq * 8) = pack8(v); }
        }
    }
};
struct EpiY {
    static constexpr bool PERM = true, AFTER_DRAIN = false;
    CArgsP a0; int l, second;
    DI void operator()(const f32x4 (&acc)[2][2][4][2], const Unit& u, int wr, int wc, int fr0, int fq0) const {
        asm volatile("s_waitcnt vmcnt(0)" ::: "memory");     unsigned ones_ = ~0u; asm volatile("" : "+s"(ones_)); const int lane_ = (int)__builtin_amdgcn_mbcnt_hi(ones_, __builtin_amdgcn_mbcnt_lo(ones_, 0u)); const int fr = lane_ & 15, fq = lane_ >> 4; (void)fr0; (void)fq0;
        CArgsP a = a0; asm volatile("" : "+s"(a));
        unsigned char* ws = a->ws; float* Y = (float*)(ws + (second ? A_Y2 : A_Y)); float* ssq = (float*)(ws + A_SSP) + (second ? SP_Y2 : SP_Y);
        EPI_ROWS {
            const int r = u.pm * 256 + ai * 128 + wr * 64 + m * 16 + fr; float part = 0.f;
#pragma unroll
            for (int bj = 0; bj < 2; ++bj) { const int c = u.pn * 256 + bj * 128 + wc * 32 + fq * 8; const f32x4 a0 = acc[ai][bj][m][0], a1 = acc[ai][bj][m][1];
                part += (a0[0] * a0[0] + a0[1] * a0[1]) + (a0[2] * a0[2] + a0[3] * a0[3]) + (a1[0] * a1[0] + a1[1] * a1[1]) + (a1[2] * a1[2] + a1[3] * a1[3]);
                float* yp = Y + (unsigned)r * DM + c; *(f32x4*)yp = a0; *(f32x4*)(yp + 4) = a1; }
            ssq_row_put(part, ssq + (unsigned)r * 16 + u.pn * 4 + wc, fr, fq);
        }
    }
};
struct EpiUp {
    static constexpr bool PERM = true, AFTER_DRAIN = false;
    CArgsP a0;
    DI void operator()(const f32x4 (&acc)[2][2][4][2], const Unit& u, int wr, int wc, int fr0, int fq0) const {
        asm volatile("s_waitcnt vmcnt(0)" ::: "memory");     unsigned ones_ = ~0u; asm volatile("" : "+s"(ones_)); const int lane_ = (int)__builtin_amdgcn_mbcnt_hi(ones_, __builtin_amdgcn_mbcnt_lo(ones_, 0u)); const int fr = lane_ & 15, fq = lane_ >> 4; (void)fr0; (void)fq0;
        CArgsP a = a0; asm volatile("" : "+s"(a));
        unsigned char* ws = a->ws; const float* ssq_x1 = (const float*)(ws + WS_CTL) + SS_X1; bf16_t* U = (bf16_t*)(ws + A_U);
        EPI_ROWS {
            const int r = u.pm * 256 + ai * 128 + wr * 64 + m * 16 + fr;
            const float rs = fast_rsq(ssq_x1[r] * (1.f / DM) + EPS);
#pragma unroll
            for (int bj = 0; bj < 2; ++bj) { EPI_GETV(v, rs);
#pragma unroll
                for (int j = 0; j < 8; ++j) { const float t = fmaxf(v[j], 0.f); v[j] = t * t; }
                *(u32x4*)(U + (unsigned)r * FF + u.pn * 256 + bj * 128 + wc * 32 + fq * 8) = pack8(v); }
        }
    }
};

constexpr int KROW = 208, VROW = 136, KS_BYTES = 64 * KROW, VS_BYTES = 64 * VROW, AT_FLAGS = 2 * KS_BYTES + 2 * VS_BYTES;
DI int crow(int reg, int h) { return (reg & 3) + 8 * (reg >> 2) + 4 * h; }
DI bf16x8 pack_frag(const f32x16& x, int s) {
    u32x4 p; p.x = cvt_pk_bf16(x[8 * s], x[8 * s + 1]); p.y = cvt_pk_bf16(x[8 * s + 2], x[8 * s + 3]); p.z = cvt_pk_bf16(x[8 * s + 4], x[8 * s + 5]); p.w = cvt_pk_bf16(x[8 * s + 6], x[8 * s + 7]);
    return __builtin_bit_cast(bf16x8, p);
}
DI void sb_group(f32x16& s, float& carry, int key_base, int q_abs, int h, int lane) {
    float L[16];
#pragma unroll
    for (int i = 0; i < 16; ++i) { const float z = s[i]; const float sp = fmaxf(z, 0.f) + __logf(1.f + __expf(-fabsf(z))); L[i] = (key_base + crow(i, h) < q_abs) ? -sp : 0.f; }
    float cs[4], pc[4];
#pragma unroll
    for (int c = 0; c < 4; ++c) { cs[c] = (L[4 * c] + L[4 * c + 1]) + (L[4 * c + 2] + L[4 * c + 3]); pc[c] = shx(cs[c], 32, lane); }
    float run = carry;
#pragma unroll
    for (int c = 3; c >= 0; --c) {
        float t = (h == 0) ? run + pc[c] : run;
#pragma unroll
        for (int e = 3; e >= 0; --e) { const int i = 4 * c + e; const bool before = key_base + crow(i, h) < q_abs; const float a = __expf(L[i] + s[i] + t); t += L[i]; s[i] = before ? a : 0.f; }
        run += cs[c] + pc[c];
    }
    carry = run;
}
template <int MODE>
DI void attn_unit(LAS unsigned char* lds, const bf16_t* Qp, int qpitch, const bf16_t* Kp, int kpitch, const bf16_t* Kpe, const bf16_t* Vt, bf16_t* Op, int qb, float sink2, int tid) {
    constexpr int NK = MODE == 0 ? 6 : 4;
    const int lane = tid & 63, wave = tid >> 6, r32 = lane & 31, h = lane >> 5;
    const int row0 = qb * 256 + wave * 32, q_abs = row0 + r32;
    bf16x8 qf[NK];
#pragma unroll
    for (int kk = 0; kk < NK; ++kk) qf[kk] = *(const bf16x8*)(Qp + (size_t)q_abs * qpitch + 16 * kk + 8 * h);
    const int jt_hi = 4 * qb + 3, jt_lo = (MODE == 1) ? (4 * qb - 2 > 0 ? 4 * qb - 2 : 0) : 0, nT = jt_hi - jt_lo + 1;
    f32x16 o0, o1;
#pragma unroll
    for (int i = 0; i < 16; ++i) { o0[i] = 0.f; o1[i] = 0.f; }
    float mrun = (MODE == 1) ? sink2 : -1e30f, lrun = (MODE == 1 && h == 0) ? 1.f : 0.f, carry = 0.f;
    bool wdone = false;
    LAS unsigned* flags = (LAS unsigned*)(lds + AT_FLAGS);
    const int kkey = tid >> 3, kch = tid & 7, pkey = tid >> 2, pch = tid & 3;
    u32x4 kreg, vreg, preg;
    auto issue = [&](int jt) {
        kreg = *(const u32x4*)(Kp + (size_t)(64 * jt + kkey) * kpitch + kch * 8);
        vreg = *(const u32x4*)(Vt + (size_t)kkey * SEQ + 64 * jt + kch * 8);
        if (MODE == 0 && tid < 256) preg = *(const u32x4*)(Kpe + (size_t)(64 * jt + pkey) * 32 + pch * 8);
    };
    auto commit = [&](int buf) {
        *(LAS u32x4*)(lds + buf * KS_BYTES + kkey * KROW + kch * 16) = kreg;
        LAS u32x2* vp = (LAS u32x2*)(lds + 2 * KS_BYTES + buf * VS_BYTES + kkey * VROW + kch * 16); vp[0] = (u32x2){vreg.x, vreg.y}; vp[1] = (u32x2){vreg.z, vreg.w};
        if (MODE == 0 && tid < 256) *(LAS u32x4*)(lds + buf * KS_BYTES + pkey * KROW + 128 + pch * 16) = preg;
    };
    __syncthreads();
    issue(MODE == 2 ? jt_hi : jt_lo); commit(0);
    __syncthreads();
    for (int it = 0; it < nT; ++it) {
        const int jt = (MODE == 2) ? jt_hi - it : jt_lo + it, buf = it & 1;
        const bool more = it + 1 < nT;
        if (more) issue(MODE == 2 ? jt - 1 : jt + 1);
        bool active = (64 * jt <= row0 + 31);
        if (MODE == 1) active = active && (64 * jt + 63 >= row0 - 127);
        if (MODE == 2) active = active && !wdone;
        if (active) {
            const LAS unsigned char* ks = lds + buf * KS_BYTES; const LAS unsigned char* vs = lds + 2 * KS_BYTES + buf * VS_BYTES;
            f32x16 s0, s1;
#pragma unroll
            for (int i = 0; i < 16; ++i) { s0[i] = 0.f; s1[i] = 0.f; }
#pragma unroll
            for (int kk = 0; kk < NK; ++kk) {
                const bf16x8 a0 = *(const LAS bf16x8*)(ks + r32 * KROW + (16 * kk + 8 * h) * 2);
                const bf16x8 a1 = *(const LAS bf16x8*)(ks + (32 + r32) * KROW + (16 * kk + 8 * h) * 2);
                s0 = MFMA32(a0, qf[kk], s0); s1 = MFMA32(a1, qf[kk], s1);
            }
            const int kb0 = 64 * jt;
            if (MODE == 2) {
                sb_group(s1, carry, kb0 + 32, q_abs, h, lane);
                sb_group(s0, carry, kb0, q_abs, h, lane);
            } else {
                const bool need_mask = (MODE == 1) || (kb0 + 63 > row0);
                if (need_mask) {
#pragma unroll
                    for (int i = 0; i < 16; ++i) { const int k0 = kb0 + crow(i, h), k1 = k0 + 32;
                        bool v0 = k0 <= q_abs, v1 = k1 <= q_abs;
                        if (MODE == 1) { v0 = v0 && (q_abs - k0 < 128); v1 = v1 && (q_abs - k1 < 128); }
                        s0[i] = v0 ? s0[i] : -1e30f; s1[i] = v1 ? s1[i] : -1e30f; }
                }
                float mx = -1e30f;
#pragma unroll
                for (int i = 0; i < 16; ++i) mx = fmaxf(mx, fmaxf(s0[i], s1[i]));
                mx = fmaxf(mx, shx(mx, 32, lane));
                const float mnew = fmaxf(mrun, mx), alpha = __builtin_amdgcn_exp2f(mrun - mnew);
                float ls = 0.f;
#pragma unroll
                for (int i = 0; i < 16; ++i) { s0[i] = __builtin_amdgcn_exp2f(s0[i] - mnew); s1[i] = __builtin_amdgcn_exp2f(s1[i] - mnew); ls += s0[i] + s1[i]; }
                lrun = lrun * alpha + ls; mrun = mnew;
#pragma unroll
                for (int i = 0; i < 16; ++i) { o0[i] *= alpha; o1[i] *= alpha; }
            }
#pragma unroll
            for (int g = 0; g < 2; ++g)
#pragma unroll
                for (int s = 0; s < 2; ++s) {
                    const bf16x8 pf = pack_frag(g == 0 ? s0 : s1, s);
                    const int kofs = (32 * g + 16 * s + 4 * h) * 2;
                    { const s16x4 lo = *(const LAS s16x4*)(vs + r32 * VROW + kofs), hi = *(const LAS s16x4*)(vs + r32 * VROW + kofs + 16);
                      o0 = MFMA32(__builtin_shufflevector(lo, hi, 0, 1, 2, 3, 4, 5, 6, 7), pf, o0); }
                    { const s16x4 lo = *(const LAS s16x4*)(vs + (32 + r32) * VROW + kofs), hi = *(const LAS s16x4*)(vs + (32 + r32) * VROW + kofs + 16);
                      o1 = MFMA32(__builtin_shufflevector(lo, hi, 0, 1, 2, 3, 4, 5, 6, 7), pf, o1); }
                }
            if (MODE == 2) wdone = __all(carry < -88.f);
        }
        if (more) commit(buf ^ 1);
        if (MODE == 2 && lane == 0) flags[(it & 1) * 8 + wave] = wdone ? 1u : 0u;
        __syncthreads();
        if (MODE == 2) { unsigned all = 1u;
#pragma unroll
            for (int w = 0; w < 8; ++w) all &= flags[(it & 1) * 8 + w];
            if (all) break; }
    }
    if (MODE != 2) { const float l = lrun + shx(lrun, 32, lane); const float inv = 1.f / l;
#pragma unroll
        for (int i = 0; i < 16; ++i) { o0[i] *= inv; o1[i] *= inv; } }
    bf16_t* orow = Op + (size_t)q_abs * 512;
#pragma unroll
    for (int c = 0; c < 4; ++c) {
        *(u32x2*)(orow + 8 * c + 4 * h) = pack4(o0[4 * c], o0[4 * c + 1], o0[4 * c + 2], o0[4 * c + 3]);
        *(u32x2*)(orow + 32 + 8 * c + 4 * h) = pack4(o1[4 * c], o1[4 * c + 1], o1[4 * c + 2], o1[4 * c + 3]);
    }
}

struct RoundOrder {
    pg8::StaticOrder S; int rnd;
    DI bool next(int i, Unit& u) const { return i == 0 ? S.next(rnd, u) : false; }
    DI void a_ready(const Unit&) const {}
    DI void done(const Unit&) const {}
};
template <int N, class Epi>
DI void run_gemm_n(LAS unsigned char* lds, int tid, int G, int bx, const bf16_t* A, const bf16_t* Bt, int K, const Epi& E) {
    pg8::Gemm g{A, Bt, MTOK, N, K};
    constexpr int nwg = (MTOK / 256) * (N / 256), NR = (nwg + 255) / 256;
#pragma unroll
    for (int rnd = 0; rnd < NR; ++rnd) { RoundOrder R; R.S.init(MTOK, N, G, bx); R.rnd = rnd; pg8::gemm_phase<Epi, RoundOrder, false, true>(lds, g, R, E, tid); }
}
#define run_gemm(lds, tid, G, bx, A, Bt, N, K, E) run_gemm_n<N>(lds, tid, G, bx, A, Bt, K, E)

template <int PH>
DI void do_phase(LAS unsigned char* lds, int wave_s) {
    constexpr int ph = PH;
    {
        CArgsP a = (CArgsP)__builtin_amdgcn_kernarg_segment_ptr(); asm volatile("" : "+s"(a));
        unsigned char* ws = a->ws;
        float* ctl = (float*)(ws + WS_CTL);
        const float* tc = (const float*)(ws + WS_TAB); const float* ts = tc + (size_t)MTOK * 32;
        bf16_t* XB = (bf16_t*)(ws + WS_XB);
        int G = gridDim.x, bx = blockIdx.x; unsigned ones = ~0u; asm volatile("" : "+s"(G), "+s"(bx), "+s"(ones));
        const int vcu = (G % 8 == 0) ? (bx % 8) * (G / 8) + bx / 8 : bx;
        int tid = wave_s * 64 + (int)__builtin_amdgcn_mbcnt_hi(ones, __builtin_amdgcn_mbcnt_lo(ones, 0u)); asm volatile("" : "+v"(tid));
        const int lane = tid & 63, wave = __builtin_amdgcn_readfirstlane(tid >> 6);
        const int gw = vcu * 8 + wave, ngw = G * 8;
        if (ph == 0) {
#if (PHMASK & 1)
            { u32x4* z = (u32x4*)((bf16_t*)(ws + W_IN) + (size_t)416 * 1024); for (int i = bx * NTHR + tid; i < 96 * 1024 * 2 / 16; i += G * NTHR) z[i] = (u32x4){0u, 0u, 0u, 0u}; }
            { unsigned char* z = ws + W_UKV; for (int i = bx * NTHR + tid; i < 1024 * 16; i += G * NTHR) *(u32x4*)(z + (size_t)(i >> 4) * 512 + 256 + (i & 15) * 16) = (u32x4){0u, 0u, 0u, 0u}; }
            for (int i = bx * NTHR + tid; i < (int)(BAR_BYTES / 4); i += G * NTHR) ((unsigned*)(ws + WS_BAR))[i] = 0u;
            for (int i = bx * NTHR + tid; i < MTOK * 32; i += G * NTHR) {
                const int r = i >> 5, k = i & 31;
                const float inv = ROPE_INV[k];
                const float ang = (float)a->pos[r] * inv;
                double rev = (double)ang * 0.15915494309189535; rev -= floor(rev);
                const float fr = (float)rev;
                ((float*)(ws + WS_TAB))[i] = __builtin_amdgcn_cosf(fr); ((float*)(ws + WS_TAB))[(size_t)MTOK * 32 + i] = __builtin_amdgcn_sinf(fr);
            }
            for (int r = gw; r < MTOK; r += ngw) row_update(a->in[0], nullptr, nullptr, nullptr, nullptr, XB, ctl + SS_X, r, lane);
            conv_layer(a, 0, lds, gw, ngw, wave, lane);
#endif
        } else {
            const int l = (ph - 1) / NPH_LAYER, sp = (ph - 1) % NPH_LAYER;
            const float* ssq_y = (const float*)(ws + A_SSP) + SP_Y; const float* ssq_y2 = (const float*)(ws + A_SSP) + SP_Y2;
            if (sp == 0) {
#if (PHMASK & 2)
                EpiIn E{a, l};
                run_gemm(lds, tid, G, bx, XB, (const bf16_t*)(ws + W_IN), NIN, 1024, E);
#endif
            } else if (sp == 1) {
#if (PHMASK & 4)
                { EpiUpQ E{a, l}; run_gemm(lds, tid, G, bx, (const bf16_t*)(ws + A_CQ), (const bf16_t*)(ws + W_UQ), 768, 256, E); }
                { EpiUpKV E{a, l}; run_gemm(lds, tid, G, bx, (const bf16_t*)(ws + A_CKV), (const bf16_t*)(ws + W_UKV), 1024, 256, E); }
#endif
            } else if (sp == 2) {
#if (PHMASK & 8)
                for (int w = vcu; w < 256; w += G) {
                    const int bh = w >> 4, sx = w & 15, b = bh >> 3, h = bh & 7;
                    const bf16_t* qm = (const bf16_t*)(ws + A_QMLA) + (size_t)bh * SEQ * 96;
                    const bf16_t* kn = (const bf16_t*)(ws + A_KNOPE) + (size_t)b * SEQ * 512 + h * 64;
                    const bf16_t* kp = (const bf16_t*)(ws + A_KPE) + (size_t)b * SEQ * 32;
                    const bf16_t* vm = (const bf16_t*)(ws + A_VTMLA) + (size_t)bh * 64 * SEQ;
                    bf16_t* om = (bf16_t*)(ws + A_OMLA) + (size_t)b * SEQ * 512 + h * 64;
                    attn_unit<0>(lds, qm, 96, kn, 512, kp, vm, om, 31 - sx, 0.f, tid);
                    attn_unit<0>(lds, qm, 96, kn, 512, kp, vm, om, sx, 0.f, tid);
                    bf16_t* qs = (bf16_t*)(ws + A_QSWA) + (size_t)b * SEQ * 512 + h * 64;
                    const bf16_t* ksw = (const bf16_t*)(ws + A_KSWA) + (size_t)b * SEQ * 128 + (h >> 2) * 64;
                    const bf16_t* vsw = (const bf16_t*)(ws + A_VTSWA) + (size_t)(b * 2 + (h >> 2)) * 64 * SEQ;
                    const float sink2 = a->in[9][l * 8 + h] * LOG2E;
                    attn_unit<1>(lds, qs, 512, ksw, 128, nullptr, vsw, qs, 2 * sx, sink2, tid);
                    attn_unit<1>(lds, qs, 512, ksw, 128, nullptr, vsw, qs, 2 * sx + 1, sink2, tid);
                    bf16_t* qb_ = (bf16_t*)(ws + A_QSB) + (size_t)b * SEQ * 512 + h * 64;
                    const bf16_t* kb_ = (const bf16_t*)(ws + A_KSB) + (size_t)b * SEQ * 512 + h * 64;
                    const bf16_t* vb_ = (const bf16_t*)(ws + A_VTSB) + (size_t)bh * 64 * SEQ;
                    attn_unit<2>(lds, qb_, 512, kb_, 512, nullptr, vb_, qb_, 2 * sx, 0.f, tid);
                    attn_unit<2>(lds, qb_, 512, kb_, 512, nullptr, vb_, qb_, 2 * sx + 1, 0.f, tid);
                }
#endif
            } else if (sp == 3) {
#if (PHMASK & 16)
                for (int br = 0; br < 3; ++br) {
                    EpiBranch E{a, br};
                    const bf16_t* A = br == 0 ? (const bf16_t*)(ws + A_OMLA) : br == 1 ? (const bf16_t*)(ws + A_QSWA) : (const bf16_t*)(ws + A_QSB);
                    run_gemm(lds, tid, G, bx, A, (const bf16_t*)(ws + W_OA) + (size_t)br * 1024 * 512, 1024, 512, E);
                }
                {
                    __builtin_amdgcn_fence(__ATOMIC_ACQUIRE, "agent");
                    pg8::StaticOrder S; S.init(MTOK, 1024, G, bx); Unit u;
                    if (S.next(0, u)) {
                        const bf16_t* Gp = (const bf16_t*)(ws + A_G); bf16_t* R = (bf16_t*)(ws + A_MIXED);
                        for (int i = tid; i < 256 * 32; i += NTHR) {
                            const int r = u.pm * 256 + (i >> 5), c = u.pn * 256 + (i & 31) * 8; const unsigned off = (unsigned)r * DM + c;
                            float acc8[8] = {0.f, 0.f, 0.f, 0.f, 0.f, 0.f, 0.f, 0.f};
#pragma unroll
                            for (int b3 = 0; b3 < 3; ++b3) {
                                const u32x4 gw = *(const u32x4*)(Gp + (unsigned)r * NGATE + b3 * 1024 + c), rw = *(const u32x4*)(R + (size_t)b3 * MTOK * DM + off);
                                acc8[0] += __uint_as_float(gw.x << 16) * __uint_as_float(rw.x << 16); acc8[1] += __uint_as_float(gw.x & 0xffff0000u) * __uint_as_float(rw.x & 0xffff0000u);
                                acc8[2] += __uint_as_float(gw.y << 16) * __uint_as_float(rw.y << 16); acc8[3] += __uint_as_float(gw.y & 0xffff0000u) * __uint_as_float(rw.y & 0xffff0000u);
                                acc8[4] += __uint_as_float(gw.z << 16) * __uint_as_float(rw.z << 16); acc8[5] += __uint_as_float(gw.z & 0xffff0000u) * __uint_as_float(rw.z & 0xffff0000u);
                                acc8[6] += __uint_as_float(gw.w << 16) * __uint_as_float(rw.w << 16); acc8[7] += __uint_as_float(gw.w & 0xffff0000u) * __uint_as_float(rw.w & 0xffff0000u);
                            }
                            *(u32x4*)(R + off) = pack8(acc8);
                        }
                    }
                }
#endif
            } else if (sp == 4) {
#if 0
                const bf16_t* Gp = (const bf16_t*)(ws + A_G); bf16_t* R = (bf16_t*)(ws + A_MIXED);
                for (int i = bx * NTHR + tid; i < MTOK * DM / 8; i += G * NTHR) {
                    const int r = i >> 7, c = (i & 127) * 8; const unsigned off = (unsigned)r * DM + c;
                    float acc8[8] = {0.f, 0.f, 0.f, 0.f, 0.f, 0.f, 0.f, 0.f};
#pragma unroll
                    for (int b3 = 0; b3 < 3; ++b3) {
                        const u32x4 gw = *(const u32x4*)(Gp + (unsigned)r * NGATE + b3 * 1024 + c), rw = *(const u32x4*)(R + (size_t)b3 * MTOK * DM + off);
                        acc8[0] += __uint_as_float(gw.x << 16) * __uint_as_float(rw.x << 16); acc8[1] += __uint_as_float(gw.x & 0xffff0000u) * __uint_as_float(rw.x & 0xffff0000u);
                        acc8[2] += __uint_as_float(gw.y << 16) * __uint_as_float(rw.y << 16); acc8[3] += __uint_as_float(gw.y & 0xffff0000u) * __uint_as_float(rw.y & 0xffff0000u);
                        acc8[4] += __uint_as_float(gw.z << 16) * __uint_as_float(rw.z << 16); acc8[5] += __uint_as_float(gw.z & 0xffff0000u) * __uint_as_float(rw.z & 0xffff0000u);
                        acc8[6] += __uint_as_float(gw.w << 16) * __uint_as_float(rw.w << 16); acc8[7] += __uint_as_float(gw.w & 0xffff0000u) * __uint_as_float(rw.w & 0xffff0000u);
                    }
                    *(u32x4*)(R + off) = pack8(acc8);
                }
#endif
            } else if (sp == 5 || sp == 8) {
#if (PHMASK & 32)
                EpiY E{a, l, sp == 5 ? 0 : 1};
                if (sp == 5) run_gemm(lds, tid, G, bx, (const bf16_t*)(ws + A_MIXEDB), (const bf16_t*)(ws + W_OUT), 1024, 1024, E);
                else run_gemm(lds, tid, G, bx, (const bf16_t*)(ws + A_U), (const bf16_t*)(ws + W_DN), 1024, 4096, E);
#endif
            } else if (sp == 6 || sp == 9) {
#if (PHMASK & 64)
                const float* xin = (sp == 6 && l == 0) ? a->in[0] : a->out;
                const float* Y = (const float*)(ws + (sp == 6 ? A_Y : A_Y2));
                const float* gpost = (sp == 6 ? a->in[14] : a->in[18]) + l * DM;
                for (int r = gw; r < MTOK; r += ngw) row_update(xin, a->out, Y, sp == 6 ? ssq_y : ssq_y2, gpost, XB, ctl + (sp == 6 ? SS_X1 : SS_X), r, lane);
                if (sp == 9 && l + 1 < DEPTH) conv_layer(a, l + 1, lds, gw, ngw, wave, lane);
#endif
            } else if (sp == 7) {
#if (PHMASK & 128)
                EpiUp E{a};
                run_gemm(lds, tid, G, bx, XB, (const bf16_t*)(ws + W_UP), FF, 1024, E);
#endif
            }
        }
    }
}

__global__ void __launch_bounds__(NTHR, 2) mk_fwd(Args a_) {
    extern __shared__ __attribute__((aligned(16))) unsigned char lds_raw[];
    LAS unsigned char* lds = (LAS unsigned char*)lds_raw;
    cg::grid_group grid = cg::this_grid();
    const int ph_lo = a_.ph_lo, ph_hi = a_.ph_hi;
    const int wave_s = __builtin_amdgcn_readfirstlane(threadIdx.x >> 6);
    static_assert(NPHASES == 41, "phase list below");
#define SEAM(P) do { if ((P) == 0 || gridDim.x != 256) grid.sync(); else { unsigned o_ = ~0u; int bx_ = blockIdx.x; asm volatile("" : "+s"(o_), "+s"(bx_)); const int t_ = wave_s * 64 + (int)__builtin_amdgcn_mbcnt_hi(o_, __builtin_amdgcn_mbcnt_lo(o_, 0u)); ms::grid_sync((unsigned*)(a_.ws + WS_BAR), t_, bx_, (unsigned)(P) + 1u); } } while (0)
#define RUN_PH(P) if (!((P) > 0 && ((P) - 1) % NPH_LAYER == 4) && ph_lo <= (P) && (P) < ph_hi) { do_phase<P>(lds, wave_s); if ((P) + 1 < ph_hi) SEAM(P); }
    RUN_PH(0)
    RUN_PH(1)
    RUN_PH(2)
    RUN_PH(3)
    RUN_PH(4)
    RUN_PH(5)
    RUN_PH(6)
    RUN_PH(7)
    RUN_PH(8)
    RUN_PH(9)
    RUN_PH(10)
    RUN_PH(11)
    RUN_PH(12)
    RUN_PH(13)
    RUN_PH(14)
    RUN_PH(15)
    RUN_PH(16)
    RUN_PH(17)
    RUN_PH(18)
    RUN_PH(19)
    RUN_PH(20)
    RUN_PH(21)
    RUN_PH(22)
    RUN_PH(23)
    RUN_PH(24)
    RUN_PH(25)
    RUN_PH(26)
    RUN_PH(27)
    RUN_PH(28)
    RUN_PH(29)
    RUN_PH(30)
    RUN_PH(31)
    RUN_PH(32)
    RUN_PH(33)
    RUN_PH(34)
    RUN_PH(35)
    RUN_PH(36)
    RUN_PH(37)
    RUN_PH(38)
    RUN_PH(39)
    RUN_PH(40)
#undef RUN_PH
#undef SEAM
}

#ifdef DBG_STOP
__global__ void dbg_dump(const unsigned short* ws16, float* out) {
    const size_t i = (size_t)blockIdx.x * blockDim.x + threadIdx.x;
    if (i >= (size_t)MTOK * DM) return;
    float acc = 0.f;
#ifdef DBG_OFF
#ifdef DBG_F32
    acc = ((const float*)ws16)[(size_t)(DBG_OFF) / 4 + i];
#else
    { const unsigned short w = ws16[(size_t)(DBG_OFF) / 2 + i]; acc = __uint_as_float((unsigned)w << 16); }
#endif
#else
    const size_t base = WS_XB / 2, total = (WS_END - WS_XB) / 2;
    for (size_t o = i; o < total; o += (size_t)MTOK * DM) { const unsigned short w = ws16[base + o]; if (((w >> 7) & 0xff) != 0xff) acc += __uint_as_float((unsigned)w << 16); }
#endif
    out[i] = acc;
}
#endif
}

extern "C" void kernel_launch(void* const* d_in, const int* in_sizes, int n_in, void* d_out, int out_size, void* d_ws, size_t ws_size, hipStream_t stream) {
    using namespace mk;
    static int grid = 0;
    if (grid == 0) {
        if (n_in != 19 || out_size != MTOK * DM || ws_size < WS_END) { fprintf(stderr, "kernel_launch: unexpected shapes (n_in %d, out %d, ws %zu < %zu)\n", n_in, out_size, ws_size, (size_t)WS_END); grid = -1; return; }
        int dev = 0, cus = 0, per_cu = 0;
        (void)hipGetDevice(&dev); (void)hipDeviceGetAttribute(&cus, hipDeviceAttributeMultiprocessorCount, dev);
        (void)hipFuncSetAttribute((const void*)mk_fwd, hipFuncAttributeMaxDynamicSharedMemorySize, LDS_BYTES);
        if (hipOccupancyMaxActiveBlocksPerMultiprocessor(&per_cu, (const void*)mk_fwd, NTHR, LDS_BYTES) != hipSuccess || per_cu < 1) { fprintf(stderr, "kernel_launch: occupancy query says %d\n", per_cu); per_cu = 1; }
        (void)hipGetLastError();
        grid = cus * per_cu;
        if (grid < 256) { fprintf(stderr, "kernel_launch: this kernel needs a 256-workgroup resident grid (got %d)\n", grid); grid = -1; return; }
        if (grid > 256) grid = 256;
    }
    if (grid < 0) return;
    Args a{};
    for (int i = 0; i < 19; ++i) a.in[i] = (const float*)d_in[i];
    a.pos = (const int*)d_in[1]; a.out = (float*)d_out; a.ws = (unsigned char*)d_ws;
#if ONE_LAUNCH
    a.ph_lo = 0; a.ph_hi = NPHASES;
    void* args[] = {&a};
    hipError_t e = hipLaunchCooperativeKernel((const void*)mk_fwd, dim3(grid), dim3(NTHR), args, LDS_BYTES, stream);
    if (e != hipSuccess) fprintf(stderr, "cooperative launch failed: %s (grid %d)\n", hipGetErrorString(e), grid);
#else
#ifdef DBG_STOP
    for (int ph = 0; ph <= DBG_STOP; ++ph) { a.ph_lo = ph; a.ph_hi = ph + 1; hipLaunchKernelGGL(mk_fwd, dim3(grid), dim3(NTHR), LDS_BYTES, stream, a); }
#ifndef DBG_NODUMP
    hipLaunchKernelGGL(dbg_dump, dim3(MTOK * DM / 256), dim3(256), 0, stream, (const unsigned short*)d_ws, (float*)d_out);
#endif
#else
    for (int ph = 0; ph < NPHASES; ++ph) { a.ph_lo = ph; a.ph_hi = ph + 1; hipLaunchKernelGGL(mk_fwd, dim3(grid), dim3(NTHR), LDS_BYTES, stream, a); }
#endif
#endif
}
```

```cpp
#include <hip/hip_runtime.h>
#include <hip/hip_cooperative_groups.h>
#include <cstdio>
#include <cstdint>
namespace cg = cooperative_groups;
#define ONE_LAUNCH 1
namespace pg8 {
#define PG8_LAS __attribute__((address_space(3)))
typedef unsigned short bf16_t;
typedef short bf16x8 __attribute__((ext_vector_type(8)));
typedef float f32x4 __attribute__((ext_vector_type(4)));
typedef unsigned u32x4 __attribute__((ext_vector_type(4)));
constexpr int BM = 256, BK = 64, HALF = 128, HTB = HALF * BK * 2  , STAGE_BYTES = 8 * HTB, NXCD = 8, WGM = 8;

__host__ __device__ __forceinline__ int lds_byte(int r, int c) { const int st = (r >> 4) * 2 + (c >> 5), rr = r & 15, cc = c & 31, ob = rr * 64 + cc * 2; return st * 1024 + (ob ^ (((ob >> 9) & 1) << 5)); }
__host__ __device__ __forceinline__ void stage_rc(int b, int& R, int& C) { const int st = b / 1024, sb = b % 1024, swz = sb ^ (((sb >> 9) & 1) << 5); R = (st >> 1) * 16 + swz / 64; C = (st & 1) * 32 + (swz % 64) / 2; }
__host__ __device__ __forceinline__ int perm32(int rho) { const int n = rho >> 4, i = rho & 15; return 8 * (i >> 2) + 4 * n + (i & 3); }

struct Unit { int pm, pn; };
struct Gemm { const bf16_t* A; const bf16_t* Bt; int M, N, K; };

struct StaticOrder {
    int nM, nN, nwg, G, c;
    __host__ __device__ void init(int M, int N, int G_, int c_) { nM = M / BM; nN = N / BM; nwg = nM * nN; G = G_; c = c_; }
    __host__ __device__ bool next(int i, Unit& u) const {
        const long L = (long)i * G + c; if (L >= nwg) return false;
        int wgid = (int)L; { const int q = nwg / NXCD, r = nwg % NXCD, xcd = wgid % NXCD, off = wgid / NXCD; wgid = (xcd < r ? xcd * (q + 1) : r * (q + 1) + (xcd - r) * q) + off; }
        const int nig = WGM * nN, gid = wgid / nig, fm = gid * WGM, gsz = (nM - fm) < WGM ? (nM - fm) : WGM;
        u.pm = fm + ((wgid % nig) % gsz); u.pn = (wgid % nig) / gsz; return true;
    }
    __device__ __forceinline__ void a_ready(const Unit&) const {}
    __device__ __forceinline__ void done(const Unit&) const {}
};

__device__ __forceinline__ unsigned cvt_pk_bf16(float lo, float hi) { unsigned r; asm volatile("v_cvt_pk_bf16_f32 %0, %1, %2" : "=v"(r) : "v"(lo), "v"(hi)); return r; }
template <class Epi, class Sched, bool ALIGN_EPI = false, bool SP2 = false>
__device__ __forceinline__ void gemm_phase(PG8_LAS unsigned char* lds, const Gemm g, const Sched& S, const Epi& E, int tid_in) {
    int tid_ = tid_in; asm volatile("" : "+v"(tid_));
    const int tid = tid_, wid = __builtin_amdgcn_readfirstlane(tid >> 6), lane = tid & 63, wr = wid >> 2, wc = wid & 3, fr = lane & 15, fq = lane >> 4;
    const int K = g.K, nt = K / BK;
    unsigned voffA[2], voffB[2];
#pragma unroll
    for (int i = 0; i < 2; ++i) { int R, C; stage_rc(tid * 16 + i * 8192, R, C); const int Rb = Epi::PERM ? ((R & ~31) + perm32(R & 31)) : R;
        voffA[i] = (unsigned)(R * K + C) * 2u; voffB[i] = (unsigned)(Rb * K + C) * 2u; }
    const size_t kstep = (size_t)(BK * 2);
    const size_t hstep = (size_t)HALF * K * 2;
    const size_t tstep = 2 * hstep;
    const unsigned ldsw = (unsigned)wid * 1024u;
    const int aoff = lds_byte(wr * 64 + fr, fq * 8), boff = lds_byte(wc * 32 + fr, fq * 8);
#define PG8_SA(b, h) (((b) * 2 + (h)) * HTB)
#define PG8_SB(b, h) ((4 + (b) * 2 + (h)) * HTB)
#define PG8_STAGE(bufoff, gbase, voff) do { _Pragma("unroll") for (int _i = 0; _i < 2; ++_i) \
        __builtin_amdgcn_global_load_lds((const unsigned*)((const char*)(gbase) + (voff)[_i]), (PG8_LAS unsigned*)(lds + (bufoff) + ldsw + _i * 8192), 16, 0, 0); } while (0)
#define PG8_LDA(dst, b, h) do { _Pragma("unroll") for (int m = 0; m < 4; ++m) _Pragma("unroll") for (int k = 0; k < 2; ++k) dst[m][k] = *(const PG8_LAS bf16x8*)(lds + PG8_SA(b, h) + aoff + m * 2048 + k * 1024); } while (0)
#define PG8_LDB(dst, b, h) do { _Pragma("unroll") for (int n = 0; n < 2; ++n) _Pragma("unroll") for (int k = 0; k < 2; ++k) dst[n][k] = *(const PG8_LAS bf16x8*)(lds + PG8_SB(b, h) + boff + n * 2048 + k * 1024); } while (0)
#define PG8_MMA(ai, bj, At, Bt) do { __builtin_amdgcn_s_setprio(1); _Pragma("unroll") for (int m = 0; m < 4; ++m) _Pragma("unroll") for (int n = 0; n < 2; ++n) _Pragma("unroll") for (int k = 0; k < 2; ++k) \
        acc[ai][bj][m][n] = __builtin_amdgcn_mfma_f32_16x16x32_bf16(Bt[n][k], At[m][k], acc[ai][bj][m][n], 0, 0, 0); __builtin_amdgcn_s_setprio(0); } while (0)
#define PG8_WAIT_V(n) asm volatile("s_waitcnt vmcnt(" #n ")" ::: "memory")
#define PG8_WAIT_L(n) asm volatile("s_waitcnt lgkmcnt(" #n ")" ::: "memory")
#define PG8_BAR __builtin_amdgcn_s_barrier()
#define PG8_SCHED __builtin_amdgcn_sched_barrier(0)
    Unit cur, nxt; int ui = 0;
    if (!S.next(0, cur)) return;
    f32x4 acc[2][2][4][2];
    float z_ = 0.f; asm volatile("" : "+v"(z_));
#pragma unroll
    for (int a = 0; a < 2; ++a)
#pragma unroll
        for (int b = 0; b < 2; ++b)
#pragma unroll
            for (int m = 0; m < 4; ++m)
#pragma unroll
                for (int n = 0; n < 2; ++n) acc[a][b][m][n] = (f32x4){z_, z_, z_, z_};
    bf16x8 At[4][2], B0[2][2], B1[2][2];
    const char* cA = (const char*)g.A + (size_t)cur.pm * tstep; const char* cB = (const char*)g.Bt + (size_t)cur.pn * tstep;
    S.a_ready(cur);
    if constexpr (SP2) {
        PG8_STAGE(PG8_SB(0, 0), cB, voffB); PG8_STAGE(PG8_SB(0, 1), cB + hstep, voffB); PG8_STAGE(PG8_SA(0, 0), cA, voffA); PG8_STAGE(PG8_SA(0, 1), cA + hstep, voffA);
        if (wr == 1) PG8_BAR;
        PG8_WAIT_V(2); PG8_BAR;
        PG8_STAGE(PG8_SB(1, 0), cB + kstep, voffB); PG8_STAGE(PG8_SA(1, 0), cA + kstep, voffA); PG8_STAGE(PG8_SB(1, 1), cB + hstep + kstep, voffB);
        PG8_WAIT_V(6); PG8_BAR;
    } else {
        PG8_STAGE(PG8_SB(0, 0), cB, voffB); PG8_STAGE(PG8_SA(0, 0), cA, voffA); PG8_STAGE(PG8_SB(0, 1), cB + hstep, voffB); PG8_STAGE(PG8_SA(0, 1), cA + hstep, voffA);
        if (wr == 1) PG8_BAR;
        PG8_WAIT_V(4); PG8_BAR;
        PG8_STAGE(PG8_SB(1, 0), cB + kstep, voffB); PG8_STAGE(PG8_SA(1, 0), cA + kstep, voffA); PG8_STAGE(PG8_SB(1, 1), cB + hstep + kstep, voffB);
        PG8_WAIT_V(6); PG8_BAR;
    }
    for (;;) {
        const bool has_next = S.next(ui + 1, nxt);
        const char* nA = has_next ? (const char*)g.A + (size_t)nxt.pm * tstep : cA; const char* nB = has_next ? (const char*)g.Bt + (size_t)nxt.pn * tstep : cB;
        for (int t = 0; t < nt; t += 2) {
            const bool last = (t == nt - 2);
            const char* a1 = cA + (size_t)(t + 1) * kstep;
            const char* a2 = last ? nA : cA + (size_t)(t + 2) * kstep; const char* b2 = last ? nB : cB + (size_t)(t + 2) * kstep;
            const char* a3 = a2 + kstep; const char* b3 = b2 + kstep;
            if (last && has_next) S.a_ready(nxt);
            if constexpr (SP2) {
            PG8_LDB(B0, 0, 0); PG8_LDB(B1, 0, 1); PG8_SCHED; PG8_LDA(At, 0, 0); PG8_STAGE(PG8_SA(1, 1), a1 + hstep, voffA);
            PG8_WAIT_V(8); PG8_WAIT_L(0); PG8_BAR; PG8_MMA(0, 0, At, B0); PG8_MMA(0, 1, At, B1); PG8_BAR; PG8_SCHED;
            PG8_LDA(At, 0, 1); PG8_STAGE(PG8_SB(0, 0), b2, voffB); PG8_STAGE(PG8_SB(0, 1), b2 + hstep, voffB); PG8_STAGE(PG8_SA(0, 0), a2, voffA);
            PG8_WAIT_V(8); PG8_WAIT_L(0); PG8_BAR; PG8_MMA(1, 0, At, B0); PG8_MMA(1, 1, At, B1); PG8_BAR; PG8_SCHED;
            PG8_LDB(B0, 1, 0); PG8_LDB(B1, 1, 1); PG8_SCHED; PG8_LDA(At, 1, 0); PG8_STAGE(PG8_SA(0, 1), a2 + hstep, voffA);
            PG8_WAIT_V(8); PG8_WAIT_L(0); PG8_BAR; PG8_MMA(0, 0, At, B0); PG8_MMA(0, 1, At, B1); PG8_BAR; PG8_SCHED;
            PG8_LDA(At, 1, 1); PG8_STAGE(PG8_SB(1, 0), b3, voffB); PG8_STAGE(PG8_SB(1, 1), b3 + hstep, voffB); PG8_STAGE(PG8_SA(1, 0), a3, voffA);
            PG8_WAIT_V(8); PG8_WAIT_L(0); PG8_BAR; PG8_MMA(1, 0, At, B0); PG8_MMA(1, 1, At, B1); PG8_BAR; PG8_SCHED;
            } else {
            PG8_LDB(B0, 0, 0); PG8_SCHED; PG8_LDA(At, 0, 0); PG8_STAGE(PG8_SA(1, 1), a1 + hstep, voffA);
            PG8_WAIT_L(8); PG8_BAR; PG8_WAIT_L(0); PG8_MMA(0, 0, At, B0); PG8_BAR; PG8_SCHED;
            PG8_LDB(B1, 0, 1); PG8_STAGE(PG8_SB(0, 0), b2, voffB);
            PG8_BAR; PG8_WAIT_L(0); PG8_MMA(0, 1, At, B1); PG8_BAR;
            PG8_LDA(At, 0, 1); PG8_STAGE(PG8_SA(0, 0), a2, voffA);
            PG8_BAR; PG8_WAIT_L(0); PG8_MMA(1, 0, At, B0); PG8_BAR; PG8_SCHED;
            PG8_STAGE(PG8_SB(0, 1), b2 + hstep, voffB);
            PG8_WAIT_V(6); PG8_BAR; PG8_MMA(1, 1, At, B1); PG8_BAR;
            PG8_LDB(B0, 1, 0); PG8_SCHED; PG8_LDA(At, 1, 0); PG8_STAGE(PG8_SA(0, 1), a2 + hstep, voffA);
            PG8_WAIT_L(8); PG8_BAR; PG8_WAIT_L(0); PG8_MMA(0, 0, At, B0); PG8_BAR; PG8_SCHED;
            PG8_LDB(B1, 1, 1); PG8_STAGE(PG8_SB(1, 0), b3, voffB);
            PG8_BAR; PG8_WAIT_L(0); PG8_MMA(0, 1, At, B1); PG8_BAR;
            PG8_LDA(At, 1, 1); PG8_STAGE(PG8_SA(1, 0), a3, voffA);
            PG8_BAR; PG8_WAIT_L(0); PG8_MMA(1, 0, At, B0); PG8_BAR; PG8_SCHED;
            PG8_STAGE(PG8_SB(1, 1), b3 + hstep, voffB);
            PG8_WAIT_V(6); PG8_BAR; PG8_MMA(1, 1, At, B1); PG8_BAR;
            }
        }
        if constexpr (ALIGN_EPI) { if (wr == 0) PG8_BAR; }
        if constexpr (!Epi::AFTER_DRAIN) { E(acc, cur, wr, wc, fr, fq); S.done(cur); }
        if (!has_next) break;
        z_ = 0.f; asm volatile("" : "+v"(z_));
#pragma unroll
        for (int a = 0; a < 2; ++a)
#pragma unroll
            for (int b = 0; b < 2; ++b)
#pragma unroll
                for (int m = 0; m < 4; ++m)
#pragma unroll
                    for (int n = 0; n < 2; ++n) acc[a][b][m][n] = (f32x4){z_, z_, z_, z_};
        cur = nxt; cA = nA; cB = nB; ++ui;
        if constexpr (ALIGN_EPI) { if (wr == 1) PG8_BAR; }
    }
    PG8_WAIT_V(0);
    if constexpr (!ALIGN_EPI) { if (wr == 0) PG8_BAR; }
    PG8_BAR;
    if constexpr (Epi::AFTER_DRAIN) { E.fused(acc, cur, wr, wc, fr, fq, lds, wid, lane); S.done(cur); }
#undef PG8_SA
#undef PG8_SB
#undef PG8_STAGE
#undef PG8_LDA
#undef PG8_LDB
#undef PG8_MMA
#undef PG8_WAIT_V
#undef PG8_WAIT_L
#undef PG8_BAR
#undef PG8_SCHED
}
}
namespace ms {
__device__ __forceinline__ unsigned ld(const unsigned* p) { return __hip_atomic_load(p, __ATOMIC_RELAXED, __HIP_MEMORY_SCOPE_AGENT); }
__device__ __forceinline__ void st(unsigned* p, unsigned v) { __hip_atomic_store(p, v, __ATOMIC_RELAXED, __HIP_MEMORY_SCOPE_AGENT); }
constexpr int W_ARR = 0, W_GF = 512, W_REL = 1024;
__device__ __forceinline__ void grid_sync(unsigned* bw, int tid, int bx, unsigned seam) {
    asm volatile("s_waitcnt vmcnt(0)" ::: "memory");
    __syncthreads();
    if (tid < 64) {
        if (tid == 0) { __builtin_amdgcn_fence(__ATOMIC_RELEASE, "agent"); asm volatile("s_waitcnt vmcnt(0)" ::: "memory"); st(&bw[W_ARR + bx], seam); }
        if ((bx & 31) == 0) {
            const int g = bx >> 5;
            for (unsigned sp = 0; sp < (1u << 22); ++sp) { const unsigned v = (tid < 32) ? ld(&bw[W_ARR + g * 32 + tid]) : seam; if (__all(v == seam)) break; __builtin_amdgcn_s_sleep(1); }
            if (tid == 0) st(&bw[W_GF + 32 * g], seam);
            if (bx == 0) {
                for (unsigned sp = 0; sp < (1u << 22); ++sp) { const unsigned v = (tid < 8) ? ld(&bw[W_GF + 32 * tid]) : seam; if (__all(v == seam)) break; __builtin_amdgcn_s_sleep(1); }
                if (tid == 0) st(&bw[W_REL], seam);
            }
        }
        for (unsigned sp = 0; sp < (1u << 22); ++sp) { const unsigned v = ld(&bw[W_REL]); if (__all(v == seam)) break; __builtin_amdgcn_s_sleep(1); }
        if (tid == 0) { __builtin_amdgcn_fence(__ATOMIC_ACQUIRE, "agent"); asm volatile("s_waitcnt vmcnt(0)" ::: "memory"); }
    }
    __syncthreads();
}
}

#ifndef PHMASK
#define PHMASK 0x3ff
#endif
#ifndef ONE_LAUNCH
#define ONE_LAUNCH 1
#endif
namespace mk {
using pg8::bf16_t; using pg8::f32x4; using pg8::bf16x8; using pg8::u32x4; using pg8::Unit; using pg8::cvt_pk_bf16;
#define LAS __attribute__((address_space(3)))
typedef float f32x16 __attribute__((ext_vector_type(16)));
typedef unsigned u32x2 __attribute__((ext_vector_type(2)));
typedef short s16x4 __attribute__((ext_vector_type(4)));
#define DI __device__ __forceinline__
#define MFMA32(a, b, c) __builtin_amdgcn_mfma_f32_32x32x16_bf16((a), (b), (c), 0, 0, 0)

constexpr int BATCH = 2, SEQ = 8192, DM = 1024, MTOK = BATCH * SEQ, DEPTH = 4, FF = 4096, NIN = 5888, NGATE = 3072;
constexpr float EPS = 1e-6f, LOG2E = 1.4426950408889634f;
constexpr int NTHR = 512, LDS_BYTES = 147456;
constexpr int NPH_LAYER = 10, NPHASES = 1 + NPH_LAYER * DEPTH;

constexpr size_t MiB = (size_t)1 << 20;
constexpr size_t WS_CTL = 0, WS_TAB = 2 * MiB, WS_W = 6 * MiB, WS_XB = 40 * MiB, WS_AR = 72 * MiB, WS_END = WS_AR + 249 * MiB;
constexpr size_t W_IN = WS_W, W_UQ = W_IN + (size_t)NIN * 1024 * 2, W_UKV = W_UQ + 768 * 256 * 2, W_OA = W_UKV + 1024 * 256 * 2, W_OB = W_OA + 1024 * 512 * 2,
                 W_OC = W_OB + 1024 * 512 * 2, W_OUT = W_OC + 1024 * 512 * 2, W_UP = W_OUT + 1024 * 1024 * 2, W_DN = W_UP + (size_t)4096 * 1024 * 2, W_ENDW = W_DN + (size_t)4096 * 1024 * 2;
static_assert(W_ENDW <= WS_XB, "weights fit");
constexpr size_t A_G = WS_AR, A_QSWA = WS_AR + 96 * MiB, A_QSB = WS_AR + 112 * MiB, A_KSB = WS_AR + 128 * MiB, A_VTSB = WS_AR + 144 * MiB, A_CQ = WS_AR + 160 * MiB,
                 A_CKV = WS_AR + 237 * MiB  , A_KPE = WS_AR + 172 * MiB, A_KSWA = WS_AR + 173 * MiB, A_VTSWA = WS_AR + 177 * MiB, A_QMLA = WS_AR + 181 * MiB,
                 A_KNOPE = WS_AR + 205 * MiB, A_VTMLA = WS_AR + 221 * MiB;
constexpr size_t A_MIXED = WS_AR + 128 * MiB, A_MIXEDB = WS_AR + 128 * MiB  , A_Y = WS_AR, A_U = WS_AR, A_Y2 = WS_AR + 128 * MiB, A_OMLA = WS_XB;
constexpr int SS_X = 0, SS_X1 = MTOK, SS_L0 = 2 * MTOK;
constexpr size_t WS_BAR = WS_CTL + MiB, BAR_BYTES = 16384;
constexpr size_t A_SSP = WS_AR + 245 * MiB;
constexpr int SP_CQ = 0, SP_CKV = 4 * MTOK, SP_Y = 8 * MTOK, SP_Y2 = 24 * MTOK;

__constant__ float ROPE_INV[32] = {1.000000000e+00f, 7.498942018e-01f, 5.623413324e-01f, 4.216965139e-01f, 3.162277639e-01f, 2.371373773e-01f, 1.778279394e-01f, 1.333521456e-01f, 1.000000015e-01f, 7.498942316e-02f, 5.623413250e-02f, 4.216964915e-02f, 3.162277490e-02f, 2.371373773e-02f, 1.778279431e-02f, 1.333521400e-02f, 9.999999776e-03f, 7.498942316e-03f, 5.623413250e-03f, 4.216964822e-03f, 3.162277630e-03f, 2.371373819e-03f, 1.778279431e-03f, 1.333521446e-03f, 1.000000047e-03f, 7.498941850e-04f, 5.623413017e-04f, 4.216965172e-04f, 3.162277571e-04f, 2.371373703e-04f, 1.778279402e-04f, 1.333521504e-04f};
struct Args { const float* in[19]; const int* pos; float* out; unsigned char* ws; int ph_lo, ph_hi; };
typedef const __attribute__((address_space(4))) Args* CArgsP;

DI float shx(float v, int mask, int lane) { return __int_as_float(__builtin_amdgcn_ds_bpermute((lane ^ mask) << 2, __float_as_int(v))); }
DI float wave_sum(float v, int lane) {
#pragma unroll
    for (int o = 1; o < 64; o <<= 1) v += shx(v, o, lane);
    return v;
}
DI float bf2f(unsigned short b) { return __uint_as_float((unsigned)b << 16); }
DI u32x4 pack8(const float* v) { u32x4 w; w.x = cvt_pk_bf16(v[0], v[1]); w.y = cvt_pk_bf16(v[2], v[3]); w.z = cvt_pk_bf16(v[4], v[5]); w.w = cvt_pk_bf16(v[6], v[7]); return w; }
DI u32x2 pack4(float a, float b, float c, float d) { u32x2 w; w.x = cvt_pk_bf16(a, b); w.y = cvt_pk_bf16(c, d); return w; }
DI float fast_rsq(float x) { return __builtin_amdgcn_rsqf(x); }

DI int perm64inv(int d) { return d < 32 ? 8 * (d >> 2) + (d & 3) : 8 * ((d - 32) >> 2) + 4 + (d & 3); }
DI int perm32inv(int d) { return d < 16 ? 8 * (d >> 2) + (d & 3) : 8 * ((d - 16) >> 2) + 4 + (d & 3); }
DI int rowmap(int kind, int n) {
    if (kind == 0) return n;
    if (kind == 1) {
        if (n < 384) return n;
        if (n < 416) return 384 + perm32inv(n - 384);
        if (n < 928) { const int t = n - 416; return 512 + (t & ~63) + perm64inv(t & 63); }
        if (n < 1056) { const int t = n - 928; return 1024 + (t & ~63) + perm64inv(t & 63); }
        return n + 96;
    }
    if (kind == 2) { const int h = n / 96, j = n % 96; return j < 64 ? h * 64 + j : 512 + h * 32 + perm32inv(j - 64); }
    { const int h = n >> 7, j = n & 127; return j < 64 ? h * 64 + j : 512 + h * 64 + (j - 64); }
}
DI void conv_item(const float* W, int K, int N, bf16_t* WT, const float* gk, int kind, LAS float* scr, int item, int lane, int ldw = 0) {
    if (ldw == 0) ldw = K;
    const int nblk = N / 32, kb = item / nblk, nb = item % nblk, k0 = 64 * kb, n0 = 32 * nb;
#pragma unroll 8
    for (int i = 0; i < 32; ++i) { const int kk = 2 * i + (lane >> 5); float v = W[(size_t)(k0 + kk) * N + n0 + (lane & 31)]; if (gk) v *= gk[k0 + kk]; scr[kk * 33 + (lane & 31)] = v; }
    asm volatile("s_waitcnt lgkmcnt(0)" ::: "memory");
    const int c = lane & 7;
#pragma unroll
    for (int j = 0; j < 4; ++j) { const int n = (lane >> 3) + 8 * j; const LAS float* s = scr + (8 * c) * 33 + n;
        u32x4 o; o.x = cvt_pk_bf16(s[0 * 33], s[1 * 33]); o.y = cvt_pk_bf16(s[2 * 33], s[3 * 33]); o.z = cvt_pk_bf16(s[4 * 33], s[5 * 33]); o.w = cvt_pk_bf16(s[6 * 33], s[7 * 33]);
        *(u32x4*)(WT + (size_t)rowmap(kind, n0 + n) * ldw + k0 + 8 * c) = o; }
    asm volatile("s_waitcnt lgkmcnt(0)" ::: "memory");
}
DI void conv_layer(CArgsP a, int l, LAS unsigned char* lds, int gw, int ngw, int wave, int lane) {
    LAS float* scr = (LAS float*)(lds + wave * 16384);
    unsigned char* ws = a->ws;
    constexpr int I_IN = 16 * 181, I_UQ = 4 * 24, I_UKV = 2 * 32, I_O = 8 * 32, I_OUT = 16 * 32, I_UP = 16 * 128, I_DN = 64 * 32;
    constexpr int NITEMS = I_IN + I_UQ + I_UKV + 3 * I_O + I_OUT + I_UP + I_DN;
    for (int it = gw; it < NITEMS; it += ngw) {
        int r = it;
        if (r < I_IN) { conv_item(a->in[3] + (size_t)l * 1024 * 5792, 1024, 5792, (bf16_t*)(ws + W_IN), a->in[2] + l * 1024, 1, scr, r, lane); continue; } r -= I_IN;
        if (r < I_UQ) { conv_item(a->in[7] + (size_t)l * 256 * 768, 256, 768, (bf16_t*)(ws + W_UQ), a->in[5] + l * 256, 2, scr, r, lane); continue; } r -= I_UQ;
        if (r < I_UKV) { conv_item(a->in[8] + (size_t)l * 128 * 1024, 128, 1024, (bf16_t*)(ws + W_UKV), a->in[6] + l * 128, 3, scr, r, lane, 256); continue; } r -= I_UKV;
        if (r < I_O) { conv_item(a->in[10] + (size_t)l * 512 * 1024, 512, 1024, (bf16_t*)(ws + W_OA), nullptr, 0, scr, r, lane); continue; } r -= I_O;
        if (r < I_O) { conv_item(a->in[11] + (size_t)l * 512 * 1024, 512, 1024, (bf16_t*)(ws + W_OB), nullptr, 0, scr, r, lane); continue; } r -= I_O;
        if (r < I_O) { conv_item(a->in[12] + (size_t)l * 512 * 1024, 512, 1024, (bf16_t*)(ws + W_OC), nullptr, 0, scr, r, lane); continue; } r -= I_O;
        if (r < I_OUT) { conv_item(a->in[13] + (size_t)l * 1024 * 1024, 1024, 1024, (bf16_t*)(ws + W_OUT), nullptr, 0, scr, r, lane); continue; } r -= I_OUT;
        if (r < I_UP) { conv_item(a->in[16] + (size_t)l * 1024 * 4096, 1024, 4096, (bf16_t*)(ws + W_UP), a->in[15] + l * 1024, 0, scr, r, lane); continue; } r -= I_UP;
        conv_item(a->in[17] + (size_t)l * 4096 * 1024, 4096, 1024, (bf16_t*)(ws + W_DN), nullptr, 0, scr, r, lane);
    }
}

DI void row_update(const float* xin, float* xout, const float* Y, const float* ssq_y, const float* g, bf16_t* XB, float* ssq_out, int r, int lane) {
    const f32x4* xr = (const f32x4*)(xin + (size_t)r * DM) + lane;
    float ss = 0.f;
    float rs = 0.f;
    if (Y) { float p_ = ssq_y[(unsigned)r * 16 + (lane & 15)]; p_ += shx(p_, 1, lane); p_ += shx(p_, 2, lane); p_ += shx(p_, 4, lane); p_ += shx(p_, 8, lane); rs = fast_rsq(p_ * (1.f / DM) + EPS); }
#pragma unroll
    for (int j = 0; j < 4; ++j) {
        f32x4 v = xr[64 * j];
        if (Y) { const f32x4 y = ((const f32x4*)(Y + (size_t)r * DM) + lane)[64 * j]; const f32x4 gg = ((const f32x4*)g + lane)[64 * j]; v = v + y * rs * gg; ((f32x4*)(xout + (size_t)r * DM) + lane)[64 * j] = v; }
        ss += (v.x * v.x + v.y * v.y) + (v.z * v.z + v.w * v.w);
        ((u32x2*)(XB + (size_t)r * DM) + lane)[64 * j] = pack4(v.x, v.y, v.z, v.w);
    }
    ss = wave_sum(ss, lane);
    if (lane == 0) ssq_out[r] = ss;
}

#define EPI_ROWS _Pragma("unroll") for (int ai = 0; ai < 2; ++ai) _Pragma("unroll") for (int m = 0; m < 4; ++m, ({ asm volatile("" ::: "memory"); }))
#define EPI_GETV(v, sc) float v[8]; { const f32x4 a0_ = acc[ai][bj][m][0], a1_ = acc[ai][bj][m][1]; v[0] = a0_[0] * (sc); v[1] = a0_[1] * (sc); v[2] = a0_[2] * (sc); v[3] = a0_[3] * (sc); v[4] = a1_[0] * (sc); v[5] = a1_[1] * (sc); v[6] = a1_[2] * (sc); v[7] = a1_[3] * (sc); }
DI void rope8(const float* v, const float* tc, const float* ts, int r, int i0, int stride, float* o1, float* o2) {
#pragma unroll
    for (int e = 0; e < 4; ++e) { const float c = tc[(unsigned)(r * 32 + (i0 + e) * stride)], s = ts[(unsigned)(r * 32 + (i0 + e) * stride)]; o1[e] = v[e] * c - v[4 + e] * s; o2[e] = v[4 + e] * c + v[e] * s; }
}
DI void vt_scatter(bf16_t* vt, int nh, int r, int h, int d0, const float* v) {
    const int b = r >> 13, s = r & (SEQ - 1);
    const unsigned off = (unsigned)(((b * nh + h) * 64 + d0) * SEQ + s);
#pragma unroll
    for (int j = 0; j < 8; j += 2) { const unsigned w = cvt_pk_bf16(v[j], v[j + 1]); vt[off + (unsigned)(j * SEQ)] = (bf16_t)(w & 0xffffu); vt[off + (unsigned)((j + 1) * SEQ)] = (bf16_t)(w >> 16); asm volatile("" ::: "memory"); }
}
DI void ssq_row_put(float part, float* dst, int fr, int fq) {
    const int lane = fq * 16 + fr; part += shx(part, 16, lane); part += shx(part, 32, lane);
    if (fq == 0) *dst = part;
}

struct EpiIn {
    static constexpr bool PERM = true, AFTER_DRAIN = false;
    CArgsP a0; int l;
    DI void operator()(const f32x4 (&acc)[2][2][4][2], const Unit& u, int wr, int wc, int fr0, int fq0) const {
        asm volatile("s_waitcnt vmcnt(0)" ::: "memory");     unsigned ones_ = ~0u; asm volatile("" : "+s"(ones_)); const int lane_ = (int)__builtin_amdgcn_mbcnt_hi(ones_, __builtin_amdgcn_mbcnt_lo(ones_, 0u)); const int fr = lane_ & 15, fq = lane_ >> 4; (void)fr0; (void)fq0;
        CArgsP a = a0; asm volatile("" : "+s"(a));
        unsigned char* ws = a->ws; float* ctl = (float*)(ws + WS_CTL);
        const float* ssq_x = ctl + SS_X; float* ssq_cq = (float*)(ws + A_SSP) + SP_CQ; float* ssq_ckv = (float*)(ws + A_SSP) + SP_CKV;
        const float* bgate = a->in[4] + l * NGATE; const float* tc = (const float*)(ws + WS_TAB); const float* ts = tc + (size_t)MTOK * 32;
        bf16_t *cq = (bf16_t*)(ws + A_CQ), *ckv = (bf16_t*)(ws + A_CKV), *kpe = (bf16_t*)(ws + A_KPE), *qswa = (bf16_t*)(ws + A_QSWA), *kswa = (bf16_t*)(ws + A_KSWA), *vtswa = (bf16_t*)(ws + A_VTSWA),
               *qsb = (bf16_t*)(ws + A_QSB), *ksb = (bf16_t*)(ws + A_KSB), *vtsb = (bf16_t*)(ws + A_VTSB), *G = (bf16_t*)(ws + A_G);
        const int pn = u.pn;
        EPI_ROWS {
            const int r = u.pm * 256 + ai * 128 + wr * 64 + m * 16 + fr;
            const float rs = fast_rsq(ssq_x[r] * (1.f / DM) + EPS);
            if (pn == 0) {
                float part = 0.f;
#pragma unroll
                for (int bj = 0; bj < 2; ++bj) { EPI_GETV(v, rs);
#pragma unroll
                    for (int j = 0; j < 8; ++j) part += v[j] * v[j];
                    *(u32x4*)(cq + (unsigned)r * 256 + bj * 128 + wc * 32 + fq * 8) = pack8(v); }
                ssq_row_put(part, ssq_cq + (unsigned)r * 4 + wc, fr, fq);
            } else if (pn == 1) {
                float part = 0.f;
                { constexpr int bj = 0; EPI_GETV(v, rs);
#pragma unroll
                    for (int j = 0; j < 8; ++j) part += v[j] * v[j];
                    *(u32x4*)(ckv + (unsigned)r * 256 + wc * 32 + fq * 8) = pack8(v); *(u32x4*)(ckv + (unsigned)r * 256 + 128 + wc * 32 + fq * 8) = (u32x4){0u, 0u, 0u, 0u}; }
                ssq_row_put(part, ssq_ckv + (unsigned)r * 4 + wc, fr, fq);
                if (wc == 0) { constexpr int bj = 1; EPI_GETV(v, rs); float o1[4], o2[4]; rope8(v, tc, ts, r, 4 * fq, 2, o1, o2);
                    *(u32x2*)(kpe + (unsigned)r * 32 + 4 * fq) = pack4(o1[0], o1[1], o1[2], o1[3]); *(u32x2*)(kpe + (unsigned)r * 32 + 16 + 4 * fq) = pack4(o2[0], o2[1], o2[2], o2[3]); }
            } else if (pn <= 3) {
                const float sc = rs * (0.125f * LOG2E);
#pragma unroll
                for (int bj = 0; bj < 2; ++bj) { EPI_GETV(v, sc); const int head = (pn - 2) * 4 + bj * 2 + (wc >> 1), g = 4 * (wc & 1) + fq; float o1[4], o2[4]; rope8(v, tc, ts, r, 4 * g, 1, o1, o2);
                    bf16_t* p = qswa + (unsigned)r * 512 + head * 64 + 4 * g; *(u32x2*)p = pack4(o1[0], o1[1], o1[2], o1[3]); *(u32x2*)(p + 32) = pack4(o2[0], o2[1], o2[2], o2[3]); }
            } else if (pn == 4) {
                { constexpr int bj = 0; EPI_GETV(v, rs); const int kvh = wc >> 1, g = 4 * (wc & 1) + fq; float o1[4], o2[4]; rope8(v, tc, ts, r, 4 * g, 1, o1, o2);
                    bf16_t* p = kswa + (unsigned)r * 128 + kvh * 64 + 4 * g; *(u32x2*)p = pack4(o1[0], o1[1], o1[2], o1[3]); *(u32x2*)(p + 32) = pack4(o2[0], o2[1], o2[2], o2[3]); }
                { constexpr int bj = 1; EPI_GETV(v, rs); vt_scatter(vtswa, 2, r, wc >> 1, 32 * (wc & 1) + 8 * fq, v); }
            } else if (pn <= 6) {
                const float sc = rs * 0.125f;
#pragma unroll
                for (int bj = 0; bj < 2; ++bj) { EPI_GETV(v, sc); *(u32x4*)(qsb + (unsigned)r * 512 + (pn - 5) * 256 + bj * 128 + wc * 32 + fq * 8) = pack8(v); }
            } else if (pn <= 8) {
#pragma unroll
                for (int bj = 0; bj < 2; ++bj) { EPI_GETV(v, rs); *(u32x4*)(ksb + (unsigned)r * 512 + (pn - 7) * 256 + bj * 128 + wc * 32 + fq * 8) = pack8(v); }
            } else if (pn <= 10) {
#pragma unroll
                for (int bj = 0; bj < 2; ++bj) { EPI_GETV(v, rs); const int c = (pn - 9) * 256 + bj * 128 + wc * 32 + fq * 8; vt_scatter(vtsb, 8, r, c >> 6, c & 63, v); }
            } else {
#pragma unroll
                for (int bj = 0; bj < 2; ++bj) { EPI_GETV(v, rs); const int c = (pn - 11) * 256 + bj * 128 + wc * 32 + fq * 8;
                    const f32x4 b0 = *(const f32x4*)(bgate + c), b1 = *(const f32x4*)(bgate + c + 4); const float bb[8] = {b0[0], b0[1], b0[2], b0[3], b1[0], b1[1], b1[2], b1[3]};
#pragma unroll
                    for (int j = 0; j < 8; ++j) v[j] = __builtin_amdgcn_rcpf(1.f + __expf(-(v[j] + bb[j])));
                    *(u32x4*)(G + (unsigned)r * NGATE + c) = pack8(v); }
            }
        }
    }
};
struct EpiUpQ {
    static constexpr bool PERM = true, AFTER_DRAIN = false;
    CArgsP a0; int l;
    DI void operator()(const f32x4 (&acc)[2][2][4][2], const Unit& u, int wr, int wc, int fr0, int fq0) const {
        asm volatile("s_waitcnt vmcnt(0)" ::: "memory");     unsigned ones_ = ~0u; asm volatile("" : "+s"(ones_)); const int lane_ = (int)__builtin_amdgcn_mbcnt_hi(ones_, __builtin_amdgcn_mbcnt_lo(ones_, 0u)); const int fr = lane_ & 15, fq = lane_ >> 4; (void)fr0; (void)fq0;
        CArgsP a = a0; asm volatile("" : "+s"(a));
        unsigned char* ws = a->ws; const float* ssq_cq = (const float*)(ws + A_SSP) + SP_CQ;
        const float* tc = (const float*)(ws + WS_TAB); const float* ts = tc + (size_t)MTOK * 32; bf16_t* qm = (bf16_t*)(ws + A_QMLA);
        const int pn = u.pn;
        EPI_ROWS {
            const int r = u.pm * 256 + ai * 128 + wr * 64 + m * 16 + fr; const int b = r >> 13, s = r & (SEQ - 1);
            const f32x4 pq_ = *(const f32x4*)(ssq_cq + (unsigned)r * 4); const float sc = fast_rsq(((pq_[0] + pq_[1]) + (pq_[2] + pq_[3])) * (1.f / 256) + EPS) * (0.10206207261596577f * LOG2E);
#pragma unroll
            for (int bj = 0; bj < 2; ++bj) { EPI_GETV(v, sc);
                if (pn < 2) { const int c = pn * 256 + bj * 128 + wc * 32 + fq * 8; *(u32x4*)(qm + (unsigned)(((b * 8 + (c >> 6)) * SEQ + s) * 96 + (c & 63))) = pack8(v); }
                else { const int h = bj * 4 + wc; float o1[4], o2[4]; rope8(v, tc, ts, r, 4 * fq, 2, o1, o2); bf16_t* p = qm + (unsigned)(((b * 8 + h) * SEQ + s) * 96 + 64 + 4 * fq);
                    *(u32x2*)p = pack4(o1[0], o1[1], o1[2], o1[3]); *(u32x2*)(p + 16) = pack4(o2[0], o2[1], o2[2], o2[3]); }
            }
        }
    }
};
struct EpiUpKV {
    static constexpr bool PERM = true, AFTER_DRAIN = false;
    CArgsP a0; int l;
    DI void operator()(const f32x4 (&acc)[2][2][4][2], const Unit& u, int wr, int wc, int fr0, int fq0) const {
        asm volatile("s_waitcnt vmcnt(0)" ::: "memory");     unsigned ones_ = ~0u; asm volatile("" : "+s"(ones_)); const int lane_ = (int)__builtin_amdgcn_mbcnt_hi(ones_, __builtin_amdgcn_mbcnt_lo(ones_, 0u)); const int fr = lane_ & 15, fq = lane_ >> 4; (void)fr0; (void)fq0;
        CArgsP a = a0; asm volatile("" : "+s"(a));
        unsigned char* ws = a->ws; const float* ssq_ckv = (const float*)(ws + A_SSP) + SP_CKV; bf16_t* knope = (bf16_t*)(ws + A_KNOPE); bf16_t* vt = (bf16_t*)(ws + A_VTMLA);
        const int pn = u.pn;
        EPI_ROWS {
            const int r = u.pm * 256 + ai * 128 + wr * 64 + m * 16 + fr;
            const f32x4 pk_ = *(const f32x4*)(ssq_ckv + (unsigned)r * 4); const float rs = fast_rsq(((pk_[0] + pk_[1]) + (pk_[2] + pk_[3])) * (1.f / 128) + EPS);
#pragma unroll
            for (int bj = 0; bj < 2; ++bj) { EPI_GETV(v, rs);
                if (pn < 2) *(u32x4*)(knope + (unsigned)r * 512 + pn * 256 + bj * 128 + wc * 32 + fq * 8) = pack8(v);
                else { const int c = (pn - 2) * 256 + bj * 128 + wc * 32 + fq * 8; vt_scatter(vt, 8, r, c >> 6, c & 63, v); }
            }
        }
    }
};
struct EpiBranch {
    static constexpr bool PERM = true, AFTER_DRAIN = false;
    CArgsP a0; int br;
    DI void operator()(const f32x4 (&acc)[2][2][4][2], const Unit& u, int wr, int wc, int fr0, int fq0) const {
        asm volatile("s_waitcnt vmcnt(0)" ::: "memory");     unsigned ones_ = ~0u; asm volatile("" : "+s"(ones_)); const int lane_ = (int)__builtin_amdgcn_mbcnt_hi(ones_, __builtin_amdgcn_mbcnt_lo(ones_, 0u)); const int fr = lane_ & 15, fq = lane_ >> 4; (void)fr0; (void)fq0;
        CArgsP a = a0; asm volatile("" : "+s"(a));
        bf16_t* R = (bf16_t*)(a->ws + A_MIXED) + (size_t)br * MTOK * DM;
        EPI_ROWS {
            const int r = u.pm * 256 + ai * 128 + wr * 64 + m * 16 + fr;
#pragma unroll
            for (int bj = 0; bj < 2; ++bj) { EPI_GETV(v, 1.f); *(u32x4*)(R + (unsigned)r * DM + u.pn * 256 + bj * 128 + wc * 32 + fq * 8) = pack8(v); }
        }
    }
};
struct EpiY {
    static constexpr bool PERM = true, AFTER_DRAIN = false;
    CArgsP a0; int l, second;
    DI void operator()(const f32x4 (&acc)[2][2][4][2], const Unit& u, int wr, int wc, int fr0, int fq0) const {
        asm volatile("s_waitcnt vmcnt(0)" ::: "memory");     unsigned ones_ = ~0u; asm volatile("" : "+s"(ones_)); const int lane_ = (int)__builtin_amdgcn_mbcnt_hi(ones_, __builtin_amdgcn_mbcnt_lo(ones_, 0u)); const int fr = lane_ & 15, fq = lane_ >> 4; (void)fr0; (void)fq0;
        CArgsP a = a0; asm volatile("" : "+s"(a));
        unsigned char* ws = a->ws; float* Y = (float*)(ws + (second ? A_Y2 : A_Y)); float* ssq = (float*)(ws + A_SSP) + (second ? SP_Y2 : SP_Y);
        EPI_ROWS {
            const int r = u.pm * 256 + ai * 128 + wr * 64 + m * 16 + fr; float part = 0.f;
#pragma unroll
            for (int bj = 0; bj < 2; ++bj) { const int c = u.pn * 256 + bj * 128 + wc * 32 + fq * 8; const f32x4 a0 = acc[ai][bj][m][0], a1 = acc[ai][bj][m][1];
                part += (a0[0] * a0[0] + a0[1] * a0[1]) + (a0[2] * a0[2] + a0[3] * a0[3]) + (a1[0] * a1[0] + a1[1] * a1[1]) + (a1[2] * a1[2] + a1[3] * a1[3]);
                float* yp = Y + (unsigned)r * DM + c; *(f32x4*)yp = a0; *(f32x4*)(yp + 4) = a1; }
            ssq_row_put(part, ssq + (unsigned)r * 16 + u.pn * 4 + wc, fr, fq);
        }
    }
};
struct EpiUp {
    static constexpr bool PERM = true, AFTER_DRAIN = false;
    CArgsP a0;
    DI void operator()(const f32x4 (&acc)[2][2][4][2], const Unit& u, int wr, int wc, int fr0, int fq0) const {
        asm volatile("s_waitcnt vmcnt(0)" ::: "memory");     unsigned ones_ = ~0u; asm volatile("" : "+s"(ones_)); const int lane_ = (int)__builtin_amdgcn_mbcnt_hi(ones_, __builtin_amdgcn_mbcnt_lo(ones_, 0u)); const int fr = lane_ & 15, fq = lane_ >> 4; (void)fr0; (void)fq0;
        CArgsP a = a0; asm volatile("" : "+s"(a));
        unsigned char* ws = a->ws; const float* ssq_x1 = (const float*)(ws + WS_CTL) + SS_X1; bf16_t* U = (bf16_t*)(ws + A_U);
        EPI_ROWS {
            const int r = u.pm * 256 + ai * 128 + wr * 64 + m * 16 + fr;
            const float rs = fast_rsq(ssq_x1[r] * (1.f / DM) + EPS);
#pragma unroll
            for (int bj = 0; bj < 2; ++bj) { EPI_GETV(v, rs);
#pragma unroll
                for (int j = 0; j < 8; ++j) { const float t = fmaxf(v[j], 0.f); v[j] = t * t; }
                *(u32x4*)(U + (unsigned)r * FF + u.pn * 256 + bj * 128 + wc * 32 + fq * 8) = pack8(v); }
        }
    }
};

constexpr int KROW = 208, VROW = 136, KS_BYTES = 64 * KROW, VS_BYTES = 64 * VROW, AT_FLAGS = 2 * KS_BYTES + 2 * VS_BYTES;
DI int crow(int reg, int h) { return (reg & 3) + 8 * (reg >> 2) + 4 * h; }
DI bf16x8 pack_frag(const f32x16& x, int s) {
    u32x4 p; p.x = cvt_pk_bf16(x[8 * s], x[8 * s + 1]); p.y = cvt_pk_bf16(x[8 * s + 2], x[8 * s + 3]); p.z = cvt_pk_bf16(x[8 * s + 4], x[8 * s + 5]); p.w = cvt_pk_bf16(x[8 * s + 6], x[8 * s + 7]);
    return __builtin_bit_cast(bf16x8, p);
}
DI void sb_group(f32x16& s, float& carry, int key_base, int q_abs, int h, int lane) {
    float L[16];
#pragma unroll
    for (int i = 0; i < 16; ++i) { const float z = s[i]; const float sp = fmaxf(z, 0.f) + __logf(1.f + __expf(-fabsf(z))); L[i] = (key_base + crow(i, h) < q_abs) ? -sp : 0.f; }
    float cs[4], pc[4];
#pragma unroll
    for (int c = 0; c < 4; ++c) { cs[c] = (L[4 * c] + L[4 * c + 1]) + (L[4 * c + 2] + L[4 * c + 3]); pc[c] = shx(cs[c], 32, lane); }
    float run = carry;
#pragma unroll
    for (int c = 3; c >= 0; --c) {
        float t = (h == 0) ? run + pc[c] : run;
#pragma unroll
        for (int e = 3; e >= 0; --e) { const int i = 4 * c + e; const bool before = key_base + crow(i, h) < q_abs; const float a = __expf(L[i] + s[i] + t); t += L[i]; s[i] = before ? a : 0.f; }
        run += cs[c] + pc[c];
    }
    carry = run;
}
template <int MODE>
DI void attn_unit(LAS unsigned char* lds, const bf16_t* Qp, int qpitch, const bf16_t* Kp, int kpitch, const bf16_t* Kpe, const bf16_t* Vt, bf16_t* Op, int qb, float sink2, int tid) {
    constexpr int NK = MODE == 0 ? 6 : 4;
    const int lane = tid & 63, wave = tid >> 6, r32 = lane & 31, h = lane >> 5;
    const int row0 = qb * 256 + wave * 32, q_abs = row0 + r32;
    bf16x8 qf[NK];
#pragma unroll
    for (int kk = 0; kk < NK; ++kk) qf[kk] = *(const bf16x8*)(Qp + (size_t)q_abs * qpitch + 16 * kk + 8 * h);
    const int jt_hi = 4 * qb + 3, jt_lo = (MODE == 1) ? (4 * qb - 2 > 0 ? 4 * qb - 2 : 0) : 0, nT = jt_hi - jt_lo + 1;
    f32x16 o0, o1;
#pragma unroll
    for (int i = 0; i < 16; ++i) { o0[i] = 0.f; o1[i] = 0.f; }
    float mrun = (MODE == 1) ? sink2 : -1e30f, lrun = (MODE == 1 && h == 0) ? 1.f : 0.f, carry = 0.f;
    bool wdone = false;
    LAS unsigned* flags = (LAS unsigned*)(lds + AT_FLAGS);
    const int kkey = tid >> 3, kch = tid & 7, pkey = tid >> 2, pch = tid & 3;
    u32x4 kreg, vreg, preg;
    auto issue = [&](int jt) {
        kreg = *(const u32x4*)(Kp + (size_t)(64 * jt + kkey) * kpitch + kch * 8);
        vreg = *(const u32x4*)(Vt + (size_t)kkey * SEQ + 64 * jt + kch * 8);
        if (MODE == 0 && tid < 256) preg = *(const u32x4*)(Kpe + (size_t)(64 * jt + pkey) * 32 + pch * 8);
    };
    auto commit = [&](int buf) {
        *(LAS u32x4*)(lds + buf * KS_BYTES + kkey * KROW + kch * 16) = kreg;
        LAS u32x2* vp = (LAS u32x2*)(lds + 2 * KS_BYTES + buf * VS_BYTES + kkey * VROW + kch * 16); vp[0] = (u32x2){vreg.x, vreg.y}; vp[1] = (u32x2){vreg.z, vreg.w};
        if (MODE == 0 && tid < 256) *(LAS u32x4*)(lds + buf * KS_BYTES + pkey * KROW + 128 + pch * 16) = preg;
    };
    __syncthreads();
    issue(MODE == 2 ? jt_hi : jt_lo); commit(0);
    __syncthreads();
    for (int it = 0; it < nT; ++it) {
        const int jt = (MODE == 2) ? jt_hi - it : jt_lo + it, buf = it & 1;
        const bool more = it + 1 < nT;
        if (more) issue(MODE == 2 ? jt - 1 : jt + 1);
        bool active = (64 * jt <= row0 + 31);
        if (MODE == 1) active = active && (64 * jt + 63 >= row0 - 127);
        if (MODE == 2) active = active && !wdone;
        if (active) {
            const LAS unsigned char* ks = lds + buf * KS_BYTES; const LAS unsigned char* vs = lds + 2 * KS_BYTES + buf * VS_BYTES;
            f32x16 s0, s1;
#pragma unroll
            for (int i = 0; i < 16; ++i) { s0[i] = 0.f; s1[i] = 0.f; }
#pragma unroll
            for (int kk = 0; kk < NK; ++kk) {
                const bf16x8 a0 = *(const LAS bf16x8*)(ks + r32 * KROW + (16 * kk + 8 * h) * 2);
                const bf16x8 a1 = *(const LAS bf16x8*)(ks + (32 + r32) * KROW + (16 * kk + 8 * h) * 2);
                s0 = MFMA32(a0, qf[kk], s0); s1 = MFMA32(a1, qf[kk], s1);
            }
            const int kb0 = 64 * jt;
            if (MODE == 2) {
                sb_group(s1, carry, kb0 + 32, q_abs, h, lane);
                sb_group(s0, carry, kb0, q_abs, h, lane);
            } else {
                const bool need_mask = (MODE == 1) || (kb0 + 63 > row0);
                if (need_mask) {
#pragma unroll
                    for (int i = 0; i < 16; ++i) { const int k0 = kb0 + crow(i, h), k1 = k0 + 32;
                        bool v0 = k0 <= q_abs, v1 = k1 <= q_abs;
                        if (MODE == 1) { v0 = v0 && (q_abs - k0 < 128); v1 = v1 && (q_abs - k1 < 128); }
                        s0[i] = v0 ? s0[i] : -1e30f; s1[i] = v1 ? s1[i] : -1e30f; }
                }
                float mx = -1e30f;
#pragma unroll
                for (int i = 0; i < 16; ++i) mx = fmaxf(mx, fmaxf(s0[i], s1[i]));
                mx = fmaxf(mx, shx(mx, 32, lane));
                const float mnew = fmaxf(mrun, mx), alpha = __builtin_amdgcn_exp2f(mrun - mnew);
                float ls = 0.f;
#pragma unroll
                for (int i = 0; i < 16; ++i) { s0[i] = __builtin_amdgcn_exp2f(s0[i] - mnew); s1[i] = __builtin_amdgcn_exp2f(s1[i] - mnew); ls += s0[i] + s1[i]; }
                lrun = lrun * alpha + ls; mrun = mnew;
#pragma unroll
                for (int i = 0; i < 16; ++i) { o0[i] *= alpha; o1[i] *= alpha; }
            }
#pragma unroll
            for (int g = 0; g < 2; ++g)
#pragma unroll
                for (int s = 0; s < 2; ++s) {
                    const bf16x8 pf = pack_frag(g == 0 ? s0 : s1, s);
                    const int kofs = (32 * g + 16 * s + 4 * h) * 2;
                    { const s16x4 lo = *(const LAS s16x4*)(vs + r32 * VROW + kofs), hi = *(const LAS s16x4*)(vs + r32 * VROW + kofs + 16);
                      o0 = MFMA32(__builtin_shufflevector(lo, hi, 0, 1, 2, 3, 4, 5, 6, 7), pf, o0); }
                    { const s16x4 lo = *(const LAS s16x4*)(vs + (32 + r32) * VROW + kofs), hi = *(const LAS s16x4*)(vs + (32 + r32) * VROW + kofs + 16);
                      o1 = MFMA32(__builtin_shufflevector(lo, hi, 0, 1, 2, 3, 4, 5, 6, 7), pf, o1); }
                }
            if (MODE == 2) wdone = __all(carry < -88.f);
        }
        if (more) commit(buf ^ 1);
        if (MODE == 2 && lane == 0) flags[(it & 1) * 8 + wave] = wdone ? 1u : 0u;
        __syncthreads();
        if (MODE == 2) { unsigned all = 1u;
#pragma unroll
            for (int w = 0; w < 8; ++w) all &= flags[(it & 1) * 8 + w];
            if (all) break; }
    }
    if (MODE != 2) { const float l = lrun + shx(lrun, 32, lane); const float inv = 1.f / l;
#pragma unroll
        for (int i = 0; i < 16; ++i) { o0[i] *= inv; o1[i] *= inv; } }
    bf16_t* orow = Op + (size_t)q_abs * 512;
#pragma unroll
    for (int c = 0; c < 4; ++c) {
        *(u32x2*)(orow + 8 * c + 4 * h) = pack4(o0[4 * c], o0[4 * c + 1], o0[4 * c + 2], o0[4 * c + 3]);
        *(u32x2*)(orow + 32 + 8 * c + 4 * h) = pack4(o1[4 * c], o1[4 * c + 1], o1[4 * c + 2], o1[4 * c + 3]);
    }
}

struct RoundOrder {
    pg8::StaticOrder S; int rnd;
    DI bool next(int i, Unit& u) const { return i == 0 ? S.next(rnd, u) : false; }
    DI void a_ready(const Unit&) const {}
    DI void done(const Unit&) const {}
};
template <int N, class Epi>
DI void run_gemm_n(LAS unsigned char* lds, int tid, int G, int bx, const bf16_t* A, const bf16_t* Bt, int K, const Epi& E) {
    pg8::Gemm g{A, Bt, MTOK, N, K};
    constexpr int nwg = (MTOK / 256) * (N / 256), NR = (nwg + 255) / 256;
    if constexpr (N == FF) {
        pg8::StaticOrder S; S.init(MTOK, N, G, bx);
        pg8::gemm_phase<Epi, pg8::StaticOrder, true, true>(lds, g, S, E, tid);
    } else {
#pragma unroll
        for (int rnd = 0; rnd < NR; ++rnd) { RoundOrder R; R.S.init(MTOK, N, G, bx); R.rnd = rnd; pg8::gemm_phase<Epi, RoundOrder, false, true>(lds, g, R, E, tid); }
    }
}
#define run_gemm(lds, tid, G, bx, A, Bt, N, K, E) run_gemm_n<N>(lds, tid, G, bx, A, Bt, K, E)

template <int PH>
DI void do_phase(LAS unsigned char* lds, int wave_s) {
    constexpr int ph = PH;
    {
        CArgsP a = (CArgsP)__builtin_amdgcn_kernarg_segment_ptr(); asm volatile("" : "+s"(a));
        unsigned char* ws = a->ws;
        float* ctl = (float*)(ws + WS_CTL);
        const float* tc = (const float*)(ws + WS_TAB); const float* ts = tc + (size_t)MTOK * 32;
        bf16_t* XB = (bf16_t*)(ws + WS_XB);
        int G = gridDim.x, bx = blockIdx.x; unsigned ones = ~0u; asm volatile("" : "+s"(G), "+s"(bx), "+s"(ones));
        const int vcu = (G % 8 == 0) ? (bx % 8) * (G / 8) + bx / 8 : bx;
        int tid = wave_s * 64 + (int)__builtin_amdgcn_mbcnt_hi(ones, __builtin_amdgcn_mbcnt_lo(ones, 0u)); asm volatile("" : "+v"(tid));
        const int lane = tid & 63, wave = __builtin_amdgcn_readfirstlane(tid >> 6);
        const int gw = vcu * 8 + wave, ngw = G * 8;
        if (ph == 0) {
#if (PHMASK & 1)
            { u32x4* z = (u32x4*)((bf16_t*)(ws + W_IN) + (size_t)416 * 1024); for (int i = bx * NTHR + tid; i < 96 * 1024 * 2 / 16; i += G * NTHR) z[i] = (u32x4){0u, 0u, 0u, 0u}; }
            { unsigned char* z = ws + W_UKV; for (int i = bx * NTHR + tid; i < 1024 * 16; i += G * NTHR) *(u32x4*)(z + (size_t)(i >> 4) * 512 + 256 + (i & 15) * 16) = (u32x4){0u, 0u, 0u, 0u}; }
            for (int i = bx * NTHR + tid; i < (int)(BAR_BYTES / 4); i += G * NTHR) ((unsigned*)(ws + WS_BAR))[i] = 0u;
            for (int i = bx * NTHR + tid; i < MTOK * 32; i += G * NTHR) {
                const int r = i >> 5, k = i & 31;
                const float inv = ROPE_INV[k];
                const float ang = (float)a->pos[r] * inv;
                double rev = (double)ang * 0.15915494309189535; rev -= floor(rev);
                const float fr = (float)rev;
                ((float*)(ws + WS_TAB))[i] = __builtin_amdgcn_cosf(fr); ((float*)(ws + WS_TAB))[(size_t)MTOK * 32 + i] = __builtin_amdgcn_sinf(fr);
            }
            for (int r = gw; r < MTOK; r += ngw) row_update(a->in[0], nullptr, nullptr, nullptr, nullptr, XB, ctl + SS_X, r, lane);
            conv_layer(a, 0, lds, gw, ngw, wave, lane);
#endif
        } else {
            const int l = (ph - 1) / NPH_LAYER, sp = (ph - 1) % NPH_LAYER;
            const float* ssq_y = (const float*)(ws + A_SSP) + SP_Y; const float* ssq_y2 = (const float*)(ws + A_SSP) + SP_Y2;
            if (sp == 0) {
#if (PHMASK & 2)
                EpiIn E{a, l};
                run_gemm(lds, tid, G, bx, XB, (const bf16_t*)(ws + W_IN), NIN, 1024, E);
#endif
            } else if (sp == 1) {
#if (PHMASK & 4)
                { EpiUpQ E{a, l}; run_gemm(lds, tid, G, bx, (const bf16_t*)(ws + A_CQ), (const bf16_t*)(ws + W_UQ), 768, 256, E); }
                { EpiUpKV E{a, l}; run_gemm(lds, tid, G, bx, (const bf16_t*)(ws + A_CKV), (const bf16_t*)(ws + W_UKV), 1024, 256, E); }
#endif
            } else if (sp == 2) {
#if (PHMASK & 8)
                for (int w = vcu; w < 256; w += G) {
                    const int bh = w >> 4, sx = w & 15, b = bh >> 3, h = bh & 7;
                    const bf16_t* qm = (const bf16_t*)(ws + A_QMLA) + (size_t)bh * SEQ * 96;
                    const bf16_t* kn = (const bf16_t*)(ws + A_KNOPE) + (size_t)b * SEQ * 512 + h * 64;
                    const bf16_t* kp = (const bf16_t*)(ws + A_KPE) + (size_t)b * SEQ * 32;
                    const bf16_t* vm = (const bf16_t*)(ws + A_VTMLA) + (size_t)bh * 64 * SEQ;
                    bf16_t* om = (bf16_t*)(ws + A_OMLA) + (size_t)b * SEQ * 512 + h * 64;
                    attn_unit<0>(lds, qm, 96, kn, 512, kp, vm, om, 31 - sx, 0.f, tid);
                    attn_unit<0>(lds, qm, 96, kn, 512, kp, vm, om, sx, 0.f, tid);
                    bf16_t* qs = (bf16_t*)(ws + A_QSWA) + (size_t)b * SEQ * 512 + h * 64;
                    const bf16_t* ksw = (const bf16_t*)(ws + A_KSWA) + (size_t)b * SEQ * 128 + (h >> 2) * 64;
                    const bf16_t* vsw = (const bf16_t*)(ws + A_VTSWA) + (size_t)(b * 2 + (h >> 2)) * 64 * SEQ;
                    const float sink2 = a->in[9][l * 8 + h] * LOG2E;
                    attn_unit<1>(lds, qs, 512, ksw, 128, nullptr, vsw, qs, 2 * sx, sink2, tid);
                    attn_unit<1>(lds, qs, 512, ksw, 128, nullptr, vsw, qs, 2 * sx + 1, sink2, tid);
                    bf16_t* qb_ = (bf16_t*)(ws + A_QSB) + (size_t)b * SEQ * 512 + h * 64;
                    const bf16_t* kb_ = (const bf16_t*)(ws + A_KSB) + (size_t)b * SEQ * 512 + h * 64;
                    const bf16_t* vb_ = (const bf16_t*)(ws + A_VTSB) + (size_t)bh * 64 * SEQ;
                    attn_unit<2>(lds, qb_, 512, kb_, 512, nullptr, vb_, qb_, 2 * sx, 0.f, tid);
                    attn_unit<2>(lds, qb_, 512, kb_, 512, nullptr, vb_, qb_, 2 * sx + 1, 0.f, tid);
                }
#endif
            } else if (sp == 3) {
#if (PHMASK & 16)
                for (int br = 0; br < 3; ++br) {
                    EpiBranch E{a, br};
                    const bf16_t* A = br == 0 ? (const bf16_t*)(ws + A_OMLA) : br == 1 ? (const bf16_t*)(ws + A_QSWA) : (const bf16_t*)(ws + A_QSB);
                    run_gemm(lds, tid, G, bx, A, (const bf16_t*)(ws + W_OA) + (size_t)br * 1024 * 512, 1024, 512, E);
                }
                {
                    __builtin_amdgcn_fence(__ATOMIC_ACQUIRE, "agent");
                    pg8::StaticOrder S; S.init(MTOK, 1024, G, bx); Unit u;
                    if (S.next(0, u)) {
                        const bf16_t* Gp = (const bf16_t*)(ws + A_G); bf16_t* R = (bf16_t*)(ws + A_MIXED);
                        for (int i = tid; i < 256 * 32; i += NTHR) {
                            const int r = u.pm * 256 + (i >> 5), c = u.pn * 256 + (i & 31) * 8; const unsigned off = (unsigned)r * DM + c;
                            float acc8[8] = {0.f, 0.f, 0.f, 0.f, 0.f, 0.f, 0.f, 0.f};
#pragma unroll
                            for (int b3 = 0; b3 < 3; ++b3) {
                                const u32x4 gw = *(const u32x4*)(Gp + (unsigned)r * NGATE + b3 * 1024 + c), rw = *(const u32x4*)(R + (size_t)b3 * MTOK * DM + off);
                                acc8[0] += __uint_as_float(gw.x << 16) * __uint_as_float(rw.x << 16); acc8[1] += __uint_as_float(gw.x & 0xffff0000u) * __uint_as_float(rw.x & 0xffff0000u);
                                acc8[2] += __uint_as_float(gw.y << 16) * __uint_as_float(rw.y << 16); acc8[3] += __uint_as_float(gw.y & 0xffff0000u) * __uint_as_float(rw.y & 0xffff0000u);
                                acc8[4] += __uint_as_float(gw.z << 16) * __uint_as_float(rw.z << 16); acc8[5] += __uint_as_float(gw.z & 0xffff0000u) * __uint_as_float(rw.z & 0xffff0000u);
                                acc8[6] += __uint_as_float(gw.w << 16) * __uint_as_float(rw.w << 16); acc8[7] += __uint_as_float(gw.w & 0xffff0000u) * __uint_as_float(rw.w & 0xffff0000u);
                            }
                            *(u32x4*)(R + off) = pack8(acc8);
                        }
                    }
                }
#endif
            } else if (sp == 4) {
#if 0
                const bf16_t* Gp = (const bf16_t*)(ws + A_G); bf16_t* R = (bf16_t*)(ws + A_MIXED);
                for (int i = bx * NTHR + tid; i < MTOK * DM / 8; i += G * NTHR) {
                    const int r = i >> 7, c = (i & 127) * 8; const unsigned off = (unsigned)r * DM + c;
                    float acc8[8] = {0.f, 0.f, 0.f, 0.f, 0.f, 0.f, 0.f, 0.f};
#pragma unroll
                    for (int b3 = 0; b3 < 3; ++b3) {
                        const u32x4 gw = *(const u32x4*)(Gp + (unsigned)r * NGATE + b3 * 1024 + c), rw = *(const u32x4*)(R + (size_t)b3 * MTOK * DM + off);
                        acc8[0] += __uint_as_float(gw.x << 16) * __uint_as_float(rw.x << 16); acc8[1] += __uint_as_float(gw.x & 0xffff0000u) * __uint_as_float(rw.x & 0xffff0000u);
                        acc8[2] += __uint_as_float(gw.y << 16) * __uint_as_float(rw.y << 16); acc8[3] += __uint_as_float(gw.y & 0xffff0000u) * __uint_as_float(rw.y & 0xffff0000u);
                        acc8[4] += __uint_as_float(gw.z << 16) * __uint_as_float(rw.z << 16); acc8[5] += __uint_as_float(gw.z & 0xffff0000u) * __uint_as_float(rw.z & 0xffff0000u);
                        acc8[6] += __uint_as_float(gw.w << 16) * __uint_as_float(rw.w << 16); acc8[7] += __uint_as_float(gw.w & 0xffff0000u) * __uint_as_float(rw.w & 0xffff0000u);
                    }
                    *(u32x4*)(R + off) = pack8(acc8);
                }
#endif
            } else if (sp == 5 || sp == 8) {
#if (PHMASK & 32)
                EpiY E{a, l, sp == 5 ? 0 : 1};
                if (sp == 5) run_gemm(lds, tid, G, bx, (const bf16_t*)(ws + A_MIXEDB), (const bf16_t*)(ws + W_OUT), 1024, 1024, E);
                else run_gemm(lds, tid, G, bx, (const bf16_t*)(ws + A_U), (const bf16_t*)(ws + W_DN), 1024, 4096, E);
#endif
            } else if (sp == 6 || sp == 9) {
#if (PHMASK & 64)
                const float* xin = (sp == 6 && l == 0) ? a->in[0] : a->out;
                const float* Y = (const float*)(ws + (sp == 6 ? A_Y : A_Y2));
                const float* gpost = (sp == 6 ? a->in[14] : a->in[18]) + l * DM;
                for (int r = gw; r < MTOK; r += ngw) row_update(xin, a->out, Y, sp == 6 ? ssq_y : ssq_y2, gpost, XB, ctl + (sp == 6 ? SS_X1 : SS_X), r, lane);
                if (sp == 9 && l + 1 < DEPTH) conv_layer(a, l + 1, lds, gw, ngw, wave, lane);
#endif
            } else if (sp == 7) {
#if (PHMASK & 128)
                EpiUp E{a};
                run_gemm(lds, tid, G, bx, XB, (const bf16_t*)(ws + W_UP), FF, 1024, E);
#endif
            }
        }
    }
}

__global__ void __launch_bounds__(NTHR, 2) mk_fwd(Args a_) {
    extern __shared__ __attribute__((aligned(16))) unsigned char lds_raw[];
    LAS unsigned char* lds = (LAS unsigned char*)lds_raw;
    cg::grid_group grid = cg::this_grid();
    const int ph_lo = a_.ph_lo, ph_hi = a_.ph_hi;
    const int wave_s = __builtin_amdgcn_readfirstlane(threadIdx.x >> 6);
    static_assert(NPHASES == 41, "phase list below");
#define SEAM(P) do { if ((P) == 0 || gridDim.x != 256) grid.sync(); else { unsigned o_ = ~0u; int bx_ = blockIdx.x; asm volatile("" : "+s"(o_), "+s"(bx_)); const int t_ = wave_s * 64 + (int)__builtin_amdgcn_mbcnt_hi(o_, __builtin_amdgcn_mbcnt_lo(o_, 0u)); ms::grid_sync((unsigned*)(a_.ws + WS_BAR), t_, bx_, (unsigned)(P) + 1u); } } while (0)
#define RUN_PH(P) if (!((P) > 0 && ((P) - 1) % NPH_LAYER == 4) && ph_lo <= (P) && (P) < ph_hi) { do_phase<P>(lds, wave_s); if ((P) + 1 < ph_hi) SEAM(P); }
    RUN_PH(0)
    RUN_PH(1)
    RUN_PH(2)
    RUN_PH(3)
    RUN_PH(4)
    RUN_PH(5)
    RUN_PH(6)
    RUN_PH(7)
    RUN_PH(8)
    RUN_PH(9)
    RUN_PH(10)
    RUN_PH(11)
    RUN_PH(12)
    RUN_PH(13)
    RUN_PH(14)
    RUN_PH(15)
    RUN_PH(16)
    RUN_PH(17)
    RUN_PH(18)
    RUN_PH(19)
    RUN_PH(20)
    RUN_PH(21)
    RUN_PH(22)
    RUN_PH(23)
    RUN_PH(24)
    RUN_PH(25)
    RUN_PH(26)
    RUN_PH(27)
    RUN_PH(28)
    RUN_PH(29)
    RUN_PH(30)
    RUN_PH(31)
    RUN_PH(32)
    RUN_PH(33)
    RUN_PH(34)
    RUN_PH(35)
    RUN_PH(36)
    RUN_PH(37)
    RUN_PH(38)
    RUN_PH(39)
    RUN_PH(40)
#undef RUN_PH
#undef SEAM
}

#ifdef DBG_STOP
__global__ void dbg_dump(const unsigned short* ws16, float* out) {
    const size_t i = (size_t)blockIdx.x * blockDim.x + threadIdx.x;
    if (i >= (size_t)MTOK * DM) return;
    float acc = 0.f;
#ifdef DBG_OFF
#ifdef DBG_F32
    acc = ((const float*)ws16)[(size_t)(DBG_OFF) / 4 + i];
#else
    { const unsigned short w = ws16[(size_t)(DBG_OFF) / 2 + i]; acc = __uint_as_float((unsigned)w << 16); }
#endif
#else
    const size_t base = WS_XB / 2, total = (WS_END - WS_XB) / 2;
    for (size_t o = i; o < total; o += (size_t)MTOK * DM) { const unsigned short w = ws16[base + o]; if (((w >> 7) & 0xff) != 0xff) acc += __uint_as_float((unsigned)w << 16); }
#endif
    out[i] = acc;
}
#endif
}

extern "C" void kernel_launch(void* const* d_in, const int* in_sizes, int n_in, void* d_out, int out_size, void* d_ws, size_t ws_size, hipStream_t stream) {
    using namespace mk;
    static int grid = 0;
    if (grid == 0) {
        if (n_in != 19 || out_size != MTOK * DM || ws_size < WS_END) { fprintf(stderr, "kernel_launch: unexpected shapes (n_in %d, out %d, ws %zu < %zu)\n", n_in, out_size, ws_size, (size_t)WS_END); grid = -1; return; }
        int dev = 0, cus = 0, per_cu = 0;
        (void)hipGetDevice(&dev); (void)hipDeviceGetAttribute(&cus, hipDeviceAttributeMultiprocessorCount, dev);
        (void)hipFuncSetAttribute((const void*)mk_fwd, hipFuncAttributeMaxDynamicSharedMemorySize, LDS_BYTES);
        if (hipOccupancyMaxActiveBlocksPerMultiprocessor(&per_cu, (const void*)mk_fwd, NTHR, LDS_BYTES) != hipSuccess || per_cu < 1) { fprintf(stderr, "kernel_launch: occupancy query says %d\n", per_cu); per_cu = 1; }
        (void)hipGetLastError();
        grid = cus * per_cu;
        if (grid < 256) { fprintf(stderr, "kernel_launch: this kernel needs a 256-workgroup resident grid (got %d)\n", grid); grid = -1; return; }
        if (grid > 256) grid = 256;
    }
    if (grid < 0) return;
    Args a{};
    for (int i = 0; i < 19; ++i) a.in[i] = (const float*)d_in[i];
    a.pos = (const int*)d_in[1]; a.out = (float*)d_out; a.ws = (unsigned char*)d_ws;
#if ONE_LAUNCH
    a.ph_lo = 0; a.ph_hi = NPHASES;
    void* args[] = {&a};
    hipError_t e = hipLaunchCooperativeKernel((const void*)mk_fwd, dim3(grid), dim3(NTHR), args, LDS_BYTES, stream);
    if (e != hipSuccess) fprintf(stderr, "cooperative launch failed: %s (grid %d)\n", hipGetErrorString(e), grid);
#else
#ifdef DBG_STOP
    for (int ph = 0; ph <= DBG_STOP; ++ph) { a.ph_lo = ph; a.ph_hi = ph + 1; hipLaunchKernelGGL(mk_fwd, dim3(grid), dim3(NTHR), LDS_BYTES, stream, a); }
#ifndef DBG_NODUMP
    hipLaunchKernelGGL(dbg_dump, dim3(MTOK * DM / 256), dim3(256), 0, stream, (const unsigned short*)d_ws, (float*)d_out);
#endif
#else
    for (int ph = 0; ph < NPHASES; ++ph) { a.ph_lo = ph; a.ph_hi = ph + 1; hipLaunchKernelGGL(mk_fwd, dim3(grid), dim3(NTHR), LDS_BYTES, stream, a); }
#endif
#endif
}
```

```cpp
#include <hip/hip_runtime.h>
#include <hip/hip_cooperative_groups.h>
#include <cstdio>
#include <cstdint>
namespace cg = cooperative_groups;
#define ONE_LAUNCH 1
namespace pg8 {
#define PG8_LAS __attribute__((address_space(3)))
typedef unsigned short bf16_t;
typedef short bf16x8 __attribute__((ext_vector_type(8)));
typedef float f32x4 __attribute__((ext_vector_type(4)));
typedef unsigned u32x4 __attribute__((ext_vector_type(4)));
constexpr int BM = 256, BK = 64, HALF = 128, HTB = HALF * BK * 2  , STAGE_BYTES = 8 * HTB, NXCD = 8, WGM = 8;

__host__ __device__ __forceinline__ int lds_byte(int r, int c) { const int st = (r >> 4) * 2 + (c >> 5), rr = r & 15, cc = c & 31, ob = rr * 64 + cc * 2; return st * 1024 + (ob ^ (((ob >> 9) & 1) << 5)); }
__host__ __device__ __forceinline__ void stage_rc(int b, int& R, int& C) { const int st = b / 1024, sb = b % 1024, swz = sb ^ (((sb >> 9) & 1) << 5); R = (st >> 1) * 16 + swz / 64; C = (st & 1) * 32 + (swz % 64) / 2; }
__host__ __device__ __forceinline__ int perm32(int rho) { const int n = rho >> 4, i = rho & 15; return 8 * (i >> 2) + 4 * n + (i & 3); }

struct Unit { int pm, pn; };
struct Gemm { const bf16_t* A; const bf16_t* Bt; int M, N, K; };

struct StaticOrder {
    int nM, nN, nwg, G, c;
    __host__ __device__ void init(int M, int N, int G_, int c_) { nM = M / BM; nN = N / BM; nwg = nM * nN; G = G_; c = c_; }
    __host__ __device__ bool next(int i, Unit& u) const {
        const long L = (long)i * G + c; if (L >= nwg) return false;
        int wgid = (int)L; { const int q = nwg / NXCD, r = nwg % NXCD, xcd = wgid % NXCD, off = wgid / NXCD; wgid = (xcd < r ? xcd * (q + 1) : r * (q + 1) + (xcd - r) * q) + off; }
        const int nig = WGM * nN, gid = wgid / nig, fm = gid * WGM, gsz = (nM - fm) < WGM ? (nM - fm) : WGM;
        u.pm = fm + ((wgid % nig) % gsz); u.pn = (wgid % nig) / gsz; return true;
    }
    __device__ __forceinline__ void a_ready(const Unit&) const {}
    __device__ __forceinline__ void done(const Unit&) const {}
};

__device__ __forceinline__ unsigned cvt_pk_bf16(float lo, float hi) { unsigned r; asm volatile("v_cvt_pk_bf16_f32 %0, %1, %2" : "=v"(r) : "v"(lo), "v"(hi)); return r; }
template <class Epi, class Sched, bool ALIGN_EPI = false, bool SP2 = false>
__device__ __forceinline__ void gemm_phase(PG8_LAS unsigned char* lds, const Gemm g, const Sched& S, const Epi& E, int tid_in) {
    int tid_ = tid_in; asm volatile("" : "+v"(tid_));
    const int tid = tid_, wid = __builtin_amdgcn_readfirstlane(tid >> 6), lane = tid & 63, wr = wid >> 2, wc = wid & 3, fr = lane & 15, fq = lane >> 4;
    const int K = g.K, nt = K / BK;
    unsigned voffA[2], voffB[2];
#pragma unroll
    for (int i = 0; i < 2; ++i) { int R, C; stage_rc(tid * 16 + i * 8192, R, C); const int Rb = Epi::PERM ? ((R & ~31) + perm32(R & 31)) : R;
        voffA[i] = (unsigned)(R * K + C) * 2u; voffB[i] = (unsigned)(Rb * K + C) * 2u; }
    const size_t kstep = (size_t)(BK * 2);
    const size_t hstep = (size_t)HALF * K * 2;
    const size_t tstep = 2 * hstep;
    const unsigned ldsw = (unsigned)wid * 1024u;
    const int aoff = lds_byte(wr * 64 + fr, fq * 8), boff = lds_byte(wc * 32 + fr, fq * 8);
#define PG8_SA(b, h) (((b) * 2 + (h)) * HTB)
#define PG8_SB(b, h) ((4 + (b) * 2 + (h)) * HTB)
#define PG8_STAGE(bufoff, gbase, voff) do { _Pragma("unroll") for (int _i = 0; _i < 2; ++_i) \
        __builtin_amdgcn_global_load_lds((const unsigned*)((const char*)(gbase) + (voff)[_i]), (PG8_LAS unsigned*)(lds + (bufoff) + ldsw + _i * 8192), 16, 0, 0); } while (0)
#define PG8_LDA(dst, b, h) do { _Pragma("unroll") for (int m = 0; m < 4; ++m) _Pragma("unroll") for (int k = 0; k < 2; ++k) dst[m][k] = *(const PG8_LAS bf16x8*)(lds + PG8_SA(b, h) + aoff + m * 2048 + k * 1024); } while (0)
#define PG8_LDB(dst, b, h) do { _Pragma("unroll") for (int n = 0; n < 2; ++n) _Pragma("unroll") for (int k = 0; k < 2; ++k) dst[n][k] = *(const PG8_LAS bf16x8*)(lds + PG8_SB(b, h) + boff + n * 2048 + k * 1024); } while (0)
#define PG8_MMA(ai, bj, At, Bt) do { __builtin_amdgcn_s_setprio(1); _Pragma("unroll") for (int m = 0; m < 4; ++m) _Pragma("unroll") for (int n = 0; n < 2; ++n) _Pragma("unroll") for (int k = 0; k < 2; ++k) \
        acc[ai][bj][m][n] = __builtin_amdgcn_mfma_f32_16x16x32_bf16(Bt[n][k], At[m][k], acc[ai][bj][m][n], 0, 0, 0); __builtin_amdgcn_s_setprio(0); } while (0)
#define PG8_WAIT_V(n) asm volatile("s_waitcnt vmcnt(" #n ")" ::: "memory")
#define PG8_WAIT_L(n) asm volatile("s_waitcnt lgkmcnt(" #n ")" ::: "memory")
#define PG8_BAR __builtin_amdgcn_s_barrier()
#define PG8_SCHED __builtin_amdgcn_sched_barrier(0)
    Unit cur, nxt; int ui = 0;
    if (!S.next(0, cur)) return;
    f32x4 acc[2][2][4][2];
    float z_ = 0.f; asm volatile("" : "+v"(z_));
#pragma unroll
    for (int a = 0; a < 2; ++a)
#pragma unroll
        for (int b = 0; b < 2; ++b)
#pragma unroll
            for (int m = 0; m < 4; ++m)
#pragma unroll
                for (int n = 0; n < 2; ++n) acc[a][b][m][n] = (f32x4){z_, z_, z_, z_};
    bf16x8 At[4][2], B0[2][2], B1[2][2];
    const char* cA = (const char*)g.A + (size_t)cur.pm * tstep; const char* cB = (const char*)g.Bt + (size_t)cur.pn * tstep;
    S.a_ready(cur);
    if constexpr (SP2) {
        PG8_STAGE(PG8_SB(0, 0), cB, voffB); PG8_STAGE(PG8_SB(0, 1), cB + hstep, voffB); PG8_STAGE(PG8_SA(0, 0), cA, voffA); PG8_STAGE(PG8_SA(0, 1), cA + hstep, voffA);
        if (wr == 1) PG8_BAR;
        PG8_WAIT_V(2); PG8_BAR;
        PG8_STAGE(PG8_SB(1, 0), cB + kstep, voffB); PG8_STAGE(PG8_SA(1, 0), cA + kstep, voffA); PG8_STAGE(PG8_SB(1, 1), cB + hstep + kstep, voffB);
        PG8_WAIT_V(6); PG8_BAR;
    } else {
        PG8_STAGE(PG8_SB(0, 0), cB, voffB); PG8_STAGE(PG8_SA(0, 0), cA, voffA); PG8_STAGE(PG8_SB(0, 1), cB + hstep, voffB); PG8_STAGE(PG8_SA(0, 1), cA + hstep, voffA);
        if (wr == 1) PG8_BAR;
        PG8_WAIT_V(4); PG8_BAR;
        PG8_STAGE(PG8_SB(1, 0), cB + kstep, voffB); PG8_STAGE(PG8_SA(1, 0), cA + kstep, voffA); PG8_STAGE(PG8_SB(1, 1), cB + hstep + kstep, voffB);
        PG8_WAIT_V(6); PG8_BAR;
    }
    for (;;) {
        const bool has_next = S.next(ui + 1, nxt);
        const char* nA = has_next ? (const char*)g.A + (size_t)nxt.pm * tstep : cA; const char* nB = has_next ? (const char*)g.Bt + (size_t)nxt.pn * tstep : cB;
        for (int t = 0; t < nt; t += 2) {
            const bool last = (t == nt - 2);
            const char* a1 = cA + (size_t)(t + 1) * kstep;
            const char* a2 = last ? nA : cA + (size_t)(t + 2) * kstep; const char* b2 = last ? nB : cB + (size_t)(t + 2) * kstep;
            const char* a3 = a2 + kstep; const char* b3 = b2 + kstep;
            if (last && has_next) S.a_ready(nxt);
            if constexpr (SP2) {
            PG8_LDB(B0, 0, 0); PG8_LDB(B1, 0, 1); PG8_SCHED; PG8_LDA(At, 0, 0); PG8_STAGE(PG8_SA(1, 1), a1 + hstep, voffA);
            PG8_WAIT_V(8); PG8_WAIT_L(0); PG8_BAR; PG8_MMA(0, 0, At, B0); PG8_MMA(0, 1, At, B1); PG8_BAR; PG8_SCHED;
            PG8_LDA(At, 0, 1); PG8_STAGE(PG8_SB(0, 0), b2, voffB); PG8_STAGE(PG8_SB(0, 1), b2 + hstep, voffB); PG8_STAGE(PG8_SA(0, 0), a2, voffA);
            PG8_WAIT_V(8); PG8_WAIT_L(0); PG8_BAR; PG8_MMA(1, 0, At, B0); PG8_MMA(1, 1, At, B1); PG8_BAR; PG8_SCHED;
            PG8_LDB(B0, 1, 0); PG8_LDB(B1, 1, 1); PG8_SCHED; PG8_LDA(At, 1, 0); PG8_STAGE(PG8_SA(0, 1), a2 + hstep, voffA);
            PG8_WAIT_V(8); PG8_WAIT_L(0); PG8_BAR; PG8_MMA(0, 0, At, B0); PG8_MMA(0, 1, At, B1); PG8_BAR; PG8_SCHED;
            PG8_LDA(At, 1, 1); PG8_STAGE(PG8_SB(1, 0), b3, voffB); PG8_STAGE(PG8_SB(1, 1), b3 + hstep, voffB); PG8_STAGE(PG8_SA(1, 0), a3, voffA);
            PG8_WAIT_V(8); PG8_WAIT_L(0); PG8_BAR; PG8_MMA(1, 0, At, B0); PG8_MMA(1, 1, At, B1); PG8_BAR; PG8_SCHED;
            } else {
            PG8_LDB(B0, 0, 0); PG8_SCHED; PG8_LDA(At, 0, 0); PG8_STAGE(PG8_SA(1, 1), a1 + hstep, voffA);
            PG8_WAIT_L(8); PG8_BAR; PG8_WAIT_L(0); PG8_MMA(0, 0, At, B0); PG8_BAR; PG8_SCHED;
            PG8_LDB(B1, 0, 1); PG8_STAGE(PG8_SB(0, 0), b2, voffB);
            PG8_BAR; PG8_WAIT_L(0); PG8_MMA(0, 1, At, B1); PG8_BAR;
            PG8_LDA(At, 0, 1); PG8_STAGE(PG8_SA(0, 0), a2, voffA);
            PG8_BAR; PG8_WAIT_L(0); PG8_MMA(1, 0, At, B0); PG8_BAR; PG8_SCHED;
            PG8_STAGE(PG8_SB(0, 1), b2 + hstep, voffB);
            PG8_WAIT_V(6); PG8_BAR; PG8_MMA(1, 1, At, B1); PG8_BAR;
            PG8_LDB(B0, 1, 0); PG8_SCHED; PG8_LDA(At, 1, 0); PG8_STAGE(PG8_SA(0, 1), a2 + hstep, voffA);
            PG8_WAIT_L(8); PG8_BAR; PG8_WAIT_L(0); PG8_MMA(0, 0, At, B0); PG8_BAR; PG8_SCHED;
            PG8_LDB(B1, 1, 1); PG8_STAGE(PG8_SB(1, 0), b3, voffB);
            PG8_BAR; PG8_WAIT_L(0); PG8_MMA(0, 1, At, B1); PG8_BAR;
            PG8_LDA(At, 1, 1); PG8_STAGE(PG8_SA(1, 0), a3, voffA);
            PG8_BAR; PG8_WAIT_L(0); PG8_MMA(1, 0, At, B0); PG8_BAR; PG8_SCHED;
            PG8_STAGE(PG8_SB(1, 1), b3 + hstep, voffB);
            PG8_WAIT_V(6); PG8_BAR; PG8_MMA(1, 1, At, B1); PG8_BAR;
            }
        }
        if constexpr (ALIGN_EPI) { if (wr == 0) PG8_BAR; }
        if constexpr (!Epi::AFTER_DRAIN) { E(acc, cur, wr, wc, fr, fq); S.done(cur); }
        if (!has_next) break;
        z_ = 0.f; asm volatile("" : "+v"(z_));
#pragma unroll
        for (int a = 0; a < 2; ++a)
#pragma unroll
            for (int b = 0; b < 2; ++b)
#pragma unroll
                for (int m = 0; m < 4; ++m)
#pragma unroll
                    for (int n = 0; n < 2; ++n) acc[a][b][m][n] = (f32x4){z_, z_, z_, z_};
        cur = nxt; cA = nA; cB = nB; ++ui;
        if constexpr (ALIGN_EPI) { if (wr == 1) PG8_BAR; }
    }
    PG8_WAIT_V(0);
    if constexpr (!ALIGN_EPI) { if (wr == 0) PG8_BAR; }
    PG8_BAR;
    if constexpr (Epi::AFTER_DRAIN) { E.fused(acc, cur, wr, wc, fr, fq, lds, wid, lane); S.done(cur); }
#undef PG8_SA
#undef PG8_SB
#undef PG8_STAGE
#undef PG8_LDA
#undef PG8_LDB
#undef PG8_MMA
#undef PG8_WAIT_V
#undef PG8_WAIT_L
#undef PG8_BAR
#undef PG8_SCHED
}
}
namespace ms {
__device__ __forceinline__ unsigned ld(const unsigned* p) { return __hip_atomic_load(p, __ATOMIC_RELAXED, __HIP_MEMORY_SCOPE_AGENT); }
__device__ __forceinline__ void st(unsigned* p, unsigned v) { __hip_atomic_store(p, v, __ATOMIC_RELAXED, __HIP_MEMORY_SCOPE_AGENT); }
constexpr int W_ARR = 0, W_GF = 512, W_REL = 1024;
__device__ __forceinline__ void grid_sync(unsigned* bw, int tid, int bx, unsigned seam) {
    asm volatile("s_waitcnt vmcnt(0)" ::: "memory");
    __syncthreads();
    if (tid < 64) {
        if (tid == 0) { __builtin_amdgcn_fence(__ATOMIC_RELEASE, "agent"); asm volatile("s_waitcnt vmcnt(0)" ::: "memory"); st(&bw[W_ARR + bx], seam); }
        if ((bx & 31) == 0) {
            const int g = bx >> 5;
            for (unsigned sp = 0; sp < (1u << 22); ++sp) { const unsigned v = (tid < 32) ? ld(&bw[W_ARR + g * 32 + tid]) : seam; if (__all(v == seam)) break; __builtin_amdgcn_s_sleep(1); }
            if (tid == 0) st(&bw[W_GF + 32 * g], seam);
            if (bx == 0) {
                for (unsigned sp = 0; sp < (1u << 22); ++sp) { const unsigned v = (tid < 8) ? ld(&bw[W_GF + 32 * tid]) : seam; if (__all(v == seam)) break; __builtin_amdgcn_s_sleep(1); }
                if (tid == 0) st(&bw[W_REL], seam);
            }
        }
        for (unsigned sp = 0; sp < (1u << 22); ++sp) { const unsigned v = ld(&bw[W_REL]); if (__all(v == seam)) break; __builtin_amdgcn_s_sleep(1); }
        if (tid == 0) { __builtin_amdgcn_fence(__ATOMIC_ACQUIRE, "agent"); asm volatile("s_waitcnt vmcnt(0)" ::: "memory"); }
    }
    __syncthreads();
}
}

#ifndef PHMASK
#define PHMASK 0x3ff
#endif
#ifndef ONE_LAUNCH
#define ONE_LAUNCH 1
#endif
namespace mk {
using pg8::bf16_t; using pg8::f32x4; using pg8::bf16x8; using pg8::u32x4; using pg8::Unit; using pg8::cvt_pk_bf16;
#define LAS __attribute__((address_space(3)))
typedef float f32x16 __attribute__((ext_vector_type(16)));
typedef unsigned u32x2 __attribute__((ext_vector_type(2)));
typedef short s16x4 __attribute__((ext_vector_type(4)));
#define DI __device__ __forceinline__
#define MFMA32(a, b, c) __builtin_amdgcn_mfma_f32_32x32x16_bf16((a), (b), (c), 0, 0, 0)

constexpr int BATCH = 2, SEQ = 8192, DM = 1024, MTOK = BATCH * SEQ, DEPTH = 4, FF = 4096, NIN = 5888, NGATE = 3072;
constexpr float EPS = 1e-6f, LOG2E = 1.4426950408889634f;
constexpr int NTHR = 512, LDS_BYTES = 147456;
constexpr int NPH_LAYER = 10, NPHASES = 1 + NPH_LAYER * DEPTH;

constexpr size_t MiB = (size_t)1 << 20;
constexpr size_t WS_CTL = 0, WS_TAB = 2 * MiB, WS_W = 6 * MiB, WS_XB = 40 * MiB, WS_AR = 72 * MiB, WS_END = WS_AR + 249 * MiB;
constexpr size_t W_IN = WS_W, W_UQ = W_IN + (size_t)NIN * 1024 * 2, W_UKV = W_UQ + 768 * 256 * 2, W_OA = W_UKV + 1024 * 256 * 2, W_OB = W_OA + 1024 * 512 * 2,
                 W_OC = W_OB + 1024 * 512 * 2, W_OUT = W_OC + 1024 * 512 * 2, W_UP = W_OUT + 1024 * 1024 * 2, W_DN = W_UP + (size_t)4096 * 1024 * 2, W_ENDW = W_DN + (size_t)4096 * 1024 * 2;
static_assert(W_ENDW <= WS_XB, "weights fit");
constexpr size_t A_G = WS_AR, A_QSWA = WS_AR + 96 * MiB, A_QSB = WS_AR + 112 * MiB, A_KSB = WS_AR + 128 * MiB, A_VTSB = WS_AR + 144 * MiB, A_CQ = WS_AR + 160 * MiB,
                 A_CKV = WS_AR + 237 * MiB  , A_KPE = WS_AR + 172 * MiB, A_KSWA = WS_AR + 173 * MiB, A_VTSWA = WS_AR + 177 * MiB, A_QMLA = WS_AR + 181 * MiB,
                 A_KNOPE = WS_AR + 205 * MiB, A_VTMLA = WS_AR + 221 * MiB;
constexpr size_t A_MIXED = WS_AR + 128 * MiB, A_MIXEDB = WS_AR + 128 * MiB  , A_Y = WS_AR, A_U = WS_AR, A_Y2 = WS_AR + 128 * MiB, A_OMLA = WS_XB;
constexpr int SS_X = 0, SS_X1 = MTOK, SS_L0 = 2 * MTOK;
constexpr size_t WS_BAR = WS_CTL + MiB, BAR_BYTES = 16384;
constexpr size_t A_SSP = WS_AR + 245 * MiB;
constexpr int SP_CQ = 0, SP_CKV = 4 * MTOK, SP_Y = 8 * MTOK, SP_Y2 = 24 * MTOK;

__constant__ float ROPE_INV[32] = {1.000000000e+00f, 7.498942018e-01f, 5.623413324e-01f, 4.216965139e-01f, 3.162277639e-01f, 2.371373773e-01f, 1.778279394e-01f, 1.333521456e-01f, 1.000000015e-01f, 7.498942316e-02f, 5.623413250e-02f, 4.216964915e-02f, 3.162277490e-02f, 2.371373773e-02f, 1.778279431e-02f, 1.333521400e-02f, 9.999999776e-03f, 7.498942316e-03f, 5.623413250e-03f, 4.216964822e-03f, 3.162277630e-03f, 2.371373819e-03f, 1.778279431e-03f, 1.333521446e-03f, 1.000000047e-03f, 7.498941850e-04f, 5.623413017e-04f, 4.216965172e-04f, 3.162277571e-04f, 2.371373703e-04f, 1.778279402e-04f, 1.333521504e-04f};
struct Args { const float* in[19]; const int* pos; float* out; unsigned char* ws; int ph_lo, ph_hi; };
typedef const __attribute__((address_space(4))) Args* CArgsP;

DI float shx(float v, int mask, int lane) { return __int_as_float(__builtin_amdgcn_ds_bpermute((lane ^ mask) << 2, __float_as_int(v))); }
DI float wave_sum(float v, int lane) {
#pragma unroll
    for (int o = 1; o < 64; o <<= 1) v += shx(v, o, lane);
    return v;
}
DI float bf2f(unsigned short b) { return __uint_as_float((unsigned)b << 16); }
DI u32x4 pack8(const float* v) { u32x4 w; w.x = cvt_pk_bf16(v[0], v[1]); w.y = cvt_pk_bf16(v[2], v[3]); w.z = cvt_pk_bf16(v[4], v[5]); w.w = cvt_pk_bf16(v[6], v[7]); return w; }
DI u32x2 pack4(float a, float b, float c, float d) { u32x2 w; w.x = cvt_pk_bf16(a, b); w.y = cvt_pk_bf16(c, d); return w; }
DI float fast_rsq(float x) { return __builtin_amdgcn_rsqf(x); }

DI int perm64inv(int d) { return d < 32 ? 8 * (d >> 2) + (d & 3) : 8 * ((d - 32) >> 2) + 4 + (d & 3); }
DI int perm32inv(int d) { return d < 16 ? 8 * (d >> 2) + (d & 3) : 8 * ((d - 16) >> 2) + 4 + (d & 3); }
DI int rowmap(int kind, int n) {
    if (kind == 0) return n;
    if (kind == 1) {
        if (n < 384) return n;
        if (n < 416) return 384 + perm32inv(n - 384);
        if (n < 928) { const int t = n - 416; return 512 + (t & ~63) + perm64inv(t & 63); }
        if (n < 1056) { const int t = n - 928; return 1024 + (t & ~63) + perm64inv(t & 63); }
        return n + 96;
    }
    if (kind == 2) { const int h = n / 96, j = n % 96; return j < 64 ? h * 64 + j : 512 + h * 32 + perm32inv(j - 64); }
    { const int h = n >> 7, j = n & 127; return j < 64 ? h * 64 + j : 512 + h * 64 + (j - 64); }
}
DI void conv_item(const float* W, int K, int N, bf16_t* WT, const float* gk, int kind, LAS float* scr, int item, int lane, int ldw = 0) {
    if (ldw == 0) ldw = K;
    const int nblk = N / 32, kb = item / nblk, nb = item % nblk, k0 = 64 * kb, n0 = 32 * nb;
#pragma unroll 8
    for (int i = 0; i < 32; ++i) { const int kk = 2 * i + (lane >> 5); float v = W[(size_t)(k0 + kk) * N + n0 + (lane & 31)]; if (gk) v *= gk[k0 + kk]; scr[kk * 33 + (lane & 31)] = v; }
    asm volatile("s_waitcnt lgkmcnt(0)" ::: "memory");
    const int c = lane & 7;
#pragma unroll
    for (int j = 0; j < 4; ++j) { const int n = (lane >> 3) + 8 * j; const LAS float* s = scr + (8 * c) * 33 + n;
        u32x4 o; o.x = cvt_pk_bf16(s[0 * 33], s[1 * 33]); o.y = cvt_pk_bf16(s[2 * 33], s[3 * 33]); o.z = cvt_pk_bf16(s[4 * 33], s[5 * 33]); o.w = cvt_pk_bf16(s[6 * 33], s[7 * 33]);
        *(u32x4*)(WT + (size_t)rowmap(kind, n0 + n) * ldw + k0 + 8 * c) = o; }
    asm volatile("s_waitcnt lgkmcnt(0)" ::: "memory");
}
DI void conv_layer(CArgsP a, int l, LAS unsigned char* lds, int gw, int ngw, int wave, int lane) {
    LAS float* scr = (LAS float*)(lds + wave * 16384);
    unsigned char* ws = a->ws;
    constexpr int I_IN = 16 * 181, I_UQ = 4 * 24, I_UKV = 2 * 32, I_O = 8 * 32, I_OUT = 16 * 32, I_UP = 16 * 128, I_DN = 64 * 32;
    constexpr int NITEMS = I_IN + I_UQ + I_UKV + 3 * I_O + I_OUT + I_UP + I_DN;
    for (int it = gw; it < NITEMS; it += ngw) {
        int r = it;
        if (r < I_IN) { conv_item(a->in[3] + (size_t)l * 1024 * 5792, 1024, 5792, (bf16_t*)(ws + W_IN), a->in[2] + l * 1024, 1, scr, r, lane); continue; } r -= I_IN;
        if (r < I_UQ) { conv_item(a->in[7] + (size_t)l * 256 * 768, 256, 768, (bf16_t*)(ws + W_UQ), a->in[5] + l * 256, 2, scr, r, lane); continue; } r -= I_UQ;
        if (r < I_UKV) { conv_item(a->in[8] + (size_t)l * 128 * 1024, 128, 1024, (bf16_t*)(ws + W_UKV), a->in[6] + l * 128, 3, scr, r, lane, 256); continue; } r -= I_UKV;
        if (r < I_O) { conv_item(a->in[10] + (size_t)l * 512 * 1024, 512, 1024, (bf16_t*)(ws + W_OA), nullptr, 0, scr, r, lane); continue; } r -= I_O;
        if (r < I_O) { conv_item(a->in[11] + (size_t)l * 512 * 1024, 512, 1024, (bf16_t*)(ws + W_OB), nullptr, 0, scr, r, lane); continue; } r -= I_O;
        if (r < I_O) { conv_item(a->in[12] + (size_t)l * 512 * 1024, 512, 1024, (bf16_t*)(ws + W_OC), nullptr, 0, scr, r, lane); continue; } r -= I_O;
        if (r < I_OUT) { conv_item(a->in[13] + (size_t)l * 1024 * 1024, 1024, 1024, (bf16_t*)(ws + W_OUT), nullptr, 0, scr, r, lane); continue; } r -= I_OUT;
        if (r < I_UP) { conv_item(a->in[16] + (size_t)l * 1024 * 4096, 1024, 4096, (bf16_t*)(ws + W_UP), a->in[15] + l * 1024, 0, scr, r, lane); continue; } r -= I_UP;
        conv_item(a->in[17] + (size_t)l * 4096 * 1024, 4096, 1024, (bf16_t*)(ws + W_DN), nullptr, 0, scr, r, lane);
    }
}

DI void row_update(const float* xin, float* xout, const float* Y, const float* ssq_y, const float* g, bf16_t* XB, float* ssq_out, int r, int lane) {
    const f32x4* xr = (const f32x4*)(xin + (size_t)r * DM) + lane;
    float ss = 0.f;
    float rs = 0.f;
    if (Y) { float p_ = ssq_y[(unsigned)r * 16 + (lane & 15)]; p_ += shx(p_, 1, lane); p_ += shx(p_, 2, lane); p_ += shx(p_, 4, lane); p_ += shx(p_, 8, lane); rs = fast_rsq(p_ * (1.f / DM) + EPS); }
#pragma unroll
    for (int j = 0; j < 4; ++j) {
        f32x4 v = xr[64 * j];
        if (Y) { const f32x4 y = ((const f32x4*)(Y + (size_t)r * DM) + lane)[64 * j]; const f32x4 gg = ((const f32x4*)g + lane)[64 * j]; v = v + y * rs * gg; ((f32x4*)(xout + (size_t)r * DM) + lane)[64 * j] = v; }
        ss += (v.x * v.x + v.y * v.y) + (v.z * v.z + v.w * v.w);
        ((u32x2*)(XB + (size_t)r * DM) + lane)[64 * j] = pack4(v.x, v.y, v.z, v.w);
    }
    ss = wave_sum(ss, lane);
    if (lane == 0) ssq_out[r] = ss;
}

#define EPI_ROWS _Pragma("unroll") for (int ai = 0; ai < 2; ++ai) _Pragma("unroll") for (int m = 0; m < 4; ++m, ({ asm volatile("" ::: "memory"); }))
#define EPI_GETV(v, sc) float v[8]; { const f32x4 a0_ = acc[ai][bj][m][0], a1_ = acc[ai][bj][m][1]; v[0] = a0_[0] * (sc); v[1] = a0_[1] * (sc); v[2] = a0_[2] * (sc); v[3] = a0_[3] * (sc); v[4] = a1_[0] * (sc); v[5] = a1_[1] * (sc); v[6] = a1_[2] * (sc); v[7] = a1_[3] * (sc); }
DI void rope8(const float* v, const float* tc, const float* ts, int r, int i0, int stride, float* o1, float* o2) {
#pragma unroll
    for (int e = 0; e < 4; ++e) { const float c = tc[(unsigned)(r * 32 + (i0 + e) * stride)], s = ts[(unsigned)(r * 32 + (i0 + e) * stride)]; o1[e] = v[e] * c - v[4 + e] * s; o2[e] = v[4 + e] * c + v[e] * s; }
}
DI void vt_scatter(bf16_t* vt, int nh, int r, int h, int d0, const float* v) {
    const int b = r >> 13, s = r & (SEQ - 1);
    const unsigned off = (unsigned)(((b * nh + h) * 64 + d0) * SEQ + s);
#pragma unroll
    for (int j = 0; j < 8; j += 2) { const unsigned w = cvt_pk_bf16(v[j], v[j + 1]); vt[off + (unsigned)(j * SEQ)] = (bf16_t)(w & 0xffffu); vt[off + (unsigned)((j + 1) * SEQ)] = (bf16_t)(w >> 16); asm volatile("" ::: "memory"); }
}
DI void ssq_row_put(float part, float* dst, int fr, int fq) {
    const int lane = fq * 16 + fr; part += shx(part, 16, lane); part += shx(part, 32, lane);
    if (fq == 0) *dst = part;
}

struct EpiIn {
    static constexpr bool PERM = true, AFTER_DRAIN = false;
    CArgsP a0; int l;
    DI void operator()(const f32x4 (&acc)[2][2][4][2], const Unit& u, int wr, int wc, int fr0, int fq0) const {
        asm volatile("s_waitcnt vmcnt(0)" ::: "memory");     unsigned ones_ = ~0u; asm volatile("" : "+s"(ones_)); const int lane_ = (int)__builtin_amdgcn_mbcnt_hi(ones_, __builtin_amdgcn_mbcnt_lo(ones_, 0u)); const int fr = lane_ & 15, fq = lane_ >> 4; (void)fr0; (void)fq0;
        CArgsP a = a0; asm volatile("" : "+s"(a));
        unsigned char* ws = a->ws; float* ctl = (float*)(ws + WS_CTL);
        const float* ssq_x = ctl + SS_X; float* ssq_cq = (float*)(ws + A_SSP) + SP_CQ; float* ssq_ckv = (float*)(ws + A_SSP) + SP_CKV;
        const float* bgate = a->in[4] + l * NGATE; const float* tc = (const float*)(ws + WS_TAB); const float* ts = tc + (size_t)MTOK * 32;
        bf16_t *cq = (bf16_t*)(ws + A_CQ), *ckv = (bf16_t*)(ws + A_CKV), *kpe = (bf16_t*)(ws + A_KPE), *qswa = (bf16_t*)(ws + A_QSWA), *kswa = (bf16_t*)(ws + A_KSWA), *vtswa = (bf16_t*)(ws + A_VTSWA),
               *qsb = (bf16_t*)(ws + A_QSB), *ksb = (bf16_t*)(ws + A_KSB), *vtsb = (bf16_t*)(ws + A_VTSB), *G = (bf16_t*)(ws + A_G);
        const int pn = u.pn;
        EPI_ROWS {
            const int r = u.pm * 256 + ai * 128 + wr * 64 + m * 16 + fr;
            const float rs = fast_rsq(ssq_x[r] * (1.f / DM) + EPS);
            if (pn == 0) {
                float part = 0.f;
#pragma unroll
                for (int bj = 0; bj < 2; ++bj) { EPI_GETV(v, rs);
#pragma unroll
                    for (int j = 0; j < 8; ++j) part += v[j] * v[j];
                    *(u32x4*)(cq + (unsigned)r * 256 + bj * 128 + wc * 32 + fq * 8) = pack8(v); }
                ssq_row_put(part, ssq_cq + (unsigned)r * 4 + wc, fr, fq);
            } else if (pn == 1) {
                float part = 0.f;
                { constexpr int bj = 0; EPI_GETV(v, rs);
#pragma unroll
                    for (int j = 0; j < 8; ++j) part += v[j] * v[j];
                    *(u32x4*)(ckv + (unsigned)r * 256 + wc * 32 + fq * 8) = pack8(v); *(u32x4*)(ckv + (unsigned)r * 256 + 128 + wc * 32 + fq * 8) = (u32x4){0u, 0u, 0u, 0u}; }
                ssq_row_put(part, ssq_ckv + (unsigned)r * 4 + wc, fr, fq);
                if (wc == 0) { constexpr int bj = 1; EPI_GETV(v, rs); float o1[4], o2[4]; rope8(v, tc, ts, r, 4 * fq, 2, o1, o2);
                    *(u32x2*)(kpe + (unsigned)r * 32 + 4 * fq) = pack4(o1[0], o1[1], o1[2], o1[3]); *(u32x2*)(kpe + (unsigned)r * 32 + 16 + 4 * fq) = pack4(o2[0], o2[1], o2[2], o2[3]); }
            } else if (pn <= 3) {
                const float sc = rs * (0.125f * LOG2E);
#pragma unroll
                for (int bj = 0; bj < 2; ++bj) { EPI_GETV(v, sc); const int head = (pn - 2) * 4 + bj * 2 + (wc >> 1), g = 4 * (wc & 1) + fq; float o1[4], o2[4]; rope8(v, tc, ts, r, 4 * g, 1, o1, o2);
                    bf16_t* p = qswa + (unsigned)r * 512 + head * 64 + 4 * g; *(u32x2*)p = pack4(o1[0], o1[1], o1[2], o1[3]); *(u32x2*)(p + 32) = pack4(o2[0], o2[1], o2[2], o2[3]); }
            } else if (pn == 4) {
                { constexpr int bj = 0; EPI_GETV(v, rs); const int kvh = wc >> 1, g = 4 * (wc & 1) + fq; float o1[4], o2[4]; rope8(v, tc, ts, r, 4 * g, 1, o1, o2);
                    bf16_t* p = kswa + (unsigned)r * 128 + kvh * 64 + 4 * g; *(u32x2*)p = pack4(o1[0], o1[1], o1[2], o1[3]); *(u32x2*)(p + 32) = pack4(o2[0], o2[1], o2[2], o2[3]); }
                { constexpr int bj = 1; EPI_GETV(v, rs); vt_scatter(vtswa, 2, r, wc >> 1, 32 * (wc & 1) + 8 * fq, v); }
            } else if (pn <= 6) {
                const float sc = rs * 0.125f;
#pragma unroll
                for (int bj = 0; bj < 2; ++bj) { EPI_GETV(v, sc); *(u32x4*)(qsb + (unsigned)r * 512 + (pn - 5) * 256 + bj * 128 + wc * 32 + fq * 8) = pack8(v); }
            } else if (pn <= 8) {
#pragma unroll
                for (int bj = 0; bj < 2; ++bj) { EPI_GETV(v, rs); *(u32x4*)(ksb + (unsigned)r * 512 + (pn - 7) * 256 + bj * 128 + wc * 32 + fq * 8) = pack8(v); }
            } else if (pn <= 10) {
#pragma unroll
                for (int bj = 0; bj < 2; ++bj) { EPI_GETV(v, rs); const int c = (pn - 9) * 256 + bj * 128 + wc * 32 + fq * 8; vt_scatter(vtsb, 8, r, c >> 6, c & 63, v); }
            } else {
#pragma unroll
                for (int bj = 0; bj < 2; ++bj) { EPI_GETV(v, rs); const int c = (pn - 11) * 256 + bj * 128 + wc * 32 + fq * 8;
                    const f32x4 b0 = *(const f32x4*)(bgate + c), b1 = *(const f32x4*)(bgate + c + 4); const float bb[8] = {b0[0], b0[1], b0[2], b0[3], b1[0], b1[1], b1[2], b1[3]};
#pragma unroll
                    for (int j = 0; j < 8; ++j) v[j] = __builtin_amdgcn_rcpf(1.f + __expf(-(v[j] + bb[j])));
                    *(u32x4*)(G + (unsigned)r * NGATE + c) = pack8(v); }
            }
        }
    }
};
struct EpiGate {
    static constexpr bool PERM = true, AFTER_DRAIN = false;
    CArgsP a0; int l;
    DI void operator()(const f32x4 (&acc)[2][2][4][2], const Unit& u, int wr, int wc, int fr0, int fq0) const {
        asm volatile("s_waitcnt vmcnt(0)" ::: "memory"); unsigned ones_ = ~0u; asm volatile("" : "+s"(ones_)); const int lane_ = (int)__builtin_amdgcn_mbcnt_hi(ones_, __builtin_amdgcn_mbcnt_lo(ones_, 0u)); const int fr = lane_ & 15, fq = lane_ >> 4; (void)fr0; (void)fq0;
        CArgsP a = a0; asm volatile("" : "+s"(a));
        unsigned char* ws = a->ws; const float* ssq_x = (const float*)(ws + WS_CTL) + SS_X; const float* bgate = a->in[4] + l * NGATE; bf16_t* G = (bf16_t*)(ws + A_G);
        EPI_ROWS {
            const int r = u.pm * 256 + ai * 128 + wr * 64 + m * 16 + fr;
            const float rs = fast_rsq(ssq_x[r] * (1.f / DM) + EPS);
#pragma unroll
            for (int bj = 0; bj < 2; ++bj) { EPI_GETV(v, rs); const int c = u.pn * 256 + bj * 128 + wc * 32 + fq * 8;
                const f32x4 b0 = *(const f32x4*)(bgate + c), b1 = *(const f32x4*)(bgate + c + 4); const float bb[8] = {b0[0], b0[1], b0[2], b0[3], b1[0], b1[1], b1[2], b1[3]};
#pragma unroll
                for (int j = 0; j < 8; ++j) v[j] = __builtin_amdgcn_rcpf(1.f + __expf(-(v[j] + bb[j])));
                *(u32x4*)(G + (unsigned)r * NGATE + c) = pack8(v); }
        }
    }
};
struct EpiUpQ {
    static constexpr bool PERM = true, AFTER_DRAIN = false;
    CArgsP a0; int l;
    DI void operator()(const f32x4 (&acc)[2][2][4][2], const Unit& u, int wr, int wc, int fr0, int fq0) const {
        asm volatile("s_waitcnt vmcnt(0)" ::: "memory");     unsigned ones_ = ~0u; asm volatile("" : "+s"(ones_)); const int lane_ = (int)__builtin_amdgcn_mbcnt_hi(ones_, __builtin_amdgcn_mbcnt_lo(ones_, 0u)); const int fr = lane_ & 15, fq = lane_ >> 4; (void)fr0; (void)fq0;
        CArgsP a = a0; asm volatile("" : "+s"(a));
        unsigned char* ws = a->ws; const float* ssq_cq = (const float*)(ws + A_SSP) + SP_CQ;
        const float* tc = (const float*)(ws + WS_TAB); const float* ts = tc + (size_t)MTOK * 32; bf16_t* qm = (bf16_t*)(ws + A_QMLA);
        const int pn = u.pn;
        EPI_ROWS {
            const int r = u.pm * 256 + ai * 128 + wr * 64 + m * 16 + fr; const int b = r >> 13, s = r & (SEQ - 1);
            const f32x4 pq_ = *(const f32x4*)(ssq_cq + (unsigned)r * 4); const float sc = fast_rsq(((pq_[0] + pq_[1]) + (pq_[2] + pq_[3])) * (1.f / 256) + EPS) * (0.10206207261596577f * LOG2E);
#pragma unroll
            for (int bj = 0; bj < 2; ++bj) { EPI_GETV(v, sc);
                if (pn < 2) { const int c = pn * 256 + bj * 128 + wc * 32 + fq * 8; *(u32x4*)(qm + (unsigned)(((b * 8 + (c >> 6)) * SEQ + s) * 96 + (c & 63))) = pack8(v); }
                else { const int h = bj * 4 + wc; float o1[4], o2[4]; rope8(v, tc, ts, r, 4 * fq, 2, o1, o2); bf16_t* p = qm + (unsigned)(((b * 8 + h) * SEQ + s) * 96 + 64 + 4 * fq);
                    *(u32x2*)p = pack4(o1[0], o1[1], o1[2], o1[3]); *(u32x2*)(p + 16) = pack4(o2[0], o2[1], o2[2], o2[3]); }
            }
        }
    }
};
struct EpiUpKV {
    static constexpr bool PERM = true, AFTER_DRAIN = false;
    CArgsP a0; int l;
    DI void operator()(const f32x4 (&acc)[2][2][4][2], const Unit& u, int wr, int wc, int fr0, int fq0) const {
        asm volatile("s_waitcnt vmcnt(0)" ::: "memory");     unsigned ones_ = ~0u; asm volatile("" : "+s"(ones_)); const int lane_ = (int)__builtin_amdgcn_mbcnt_hi(ones_, __builtin_amdgcn_mbcnt_lo(ones_, 0u)); const int fr = lane_ & 15, fq = lane_ >> 4; (void)fr0; (void)fq0;
        CArgsP a = a0; asm volatile("" : "+s"(a));
        unsigned char* ws = a->ws; const float* ssq_ckv = (const float*)(ws + A_SSP) + SP_CKV; bf16_t* knope = (bf16_t*)(ws + A_KNOPE); bf16_t* vt = (bf16_t*)(ws + A_VTMLA);
        const int pn = u.pn;
        EPI_ROWS {
            const int r = u.pm * 256 + ai * 128 + wr * 64 + m * 16 + fr;
            const f32x4 pk_ = *(const f32x4*)(ssq_ckv + (unsigned)r * 4); const float rs = fast_rsq(((pk_[0] + pk_[1]) + (pk_[2] + pk_[3])) * (1.f / 128) + EPS);
#pragma unroll
            for (int bj = 0; bj < 2; ++bj) { EPI_GETV(v, rs);
                if (pn < 2) *(u32x4*)(knope + (unsigned)r * 512 + pn * 256 + bj * 128 + wc * 32 + fq * 8) = pack8(v);
                else { const int c = (pn - 2) * 256 + bj * 128 + wc * 32 + fq * 8; vt_scatter(vt, 8, r, c >> 6, c & 63, v); }
            }
        }
    }
};
struct EpiBranch {
    static constexpr bool PERM = true, AFTER_DRAIN = false;
    CArgsP a0; int br;
    DI void operator()(const f32x4 (&acc)[2][2][4][2], const Unit& u, int wr, int wc, int fr0, int fq0) const {
        asm volatile("s_waitcnt vmcnt(0)" ::: "memory");     unsigned ones_ = ~0u; asm volatile("" : "+s"(ones_)); const int lane_ = (int)__builtin_amdgcn_mbcnt_hi(ones_, __builtin_amdgcn_mbcnt_lo(ones_, 0u)); const int fr = lane_ & 15, fq = lane_ >> 4; (void)fr0; (void)fq0;
        CArgsP a = a0; asm volatile("" : "+s"(a));
        bf16_t* R = (bf16_t*)(a->ws + A_MIXED) + (size_t)br * MTOK * DM;
        EPI_ROWS {
            const int r = u.pm * 256 + ai * 128 + wr * 64 + m * 16 + fr;
#pragma unroll
            for (int bj = 0; bj < 2; ++bj) { EPI_GETV(v, 1.f); *(u32x4*)(R + (unsigned)r * DM + u.pn * 256 + bj * 128 + wc * 32 + fq * 8) = pack8(v); }
        }
    }
};
struct EpiY {
    static constexpr bool PERM = true, AFTER_DRAIN = false;
    CArgsP a0; int l, second;
    DI void operator()(const f32x4 (&acc)[2][2][4][2], const Unit& u, int wr, int wc, int fr0, int fq0) const {
        asm volatile("s_waitcnt vmcnt(0)" ::: "memory");     unsigned ones_ = ~0u; asm volatile("" : "+s"(ones_)); const int lane_ = (int)__builtin_amdgcn_mbcnt_hi(ones_, __builtin_amdgcn_mbcnt_lo(ones_, 0u)); const int fr = lane_ & 15, fq = lane_ >> 4; (void)fr0; (void)fq0;
        CArgsP a = a0; asm volatile("" : "+s"(a));
        unsigned char* ws = a->ws; float* Y = (float*)(ws + (second ? A_Y2 : A_Y)); float* ssq = (float*)(ws + A_SSP) + (second ? SP_Y2 : SP_Y);
        EPI_ROWS {
            const int r = u.pm * 256 + ai * 128 + wr * 64 + m * 16 + fr; float part = 0.f;
#pragma unroll
            for (int bj = 0; bj < 2; ++bj) { const int c = u.pn * 256 + bj * 128 + wc * 32 + fq * 8; const f32x4 a0 = acc[ai][bj][m][0], a1 = acc[ai][bj][m][1];
                part += (a0[0] * a0[0] + a0[1] * a0[1]) + (a0[2] * a0[2] + a0[3] * a0[3]) + (a1[0] * a1[0] + a1[1] * a1[1]) + (a1[2] * a1[2] + a1[3] * a1[3]);
                float* yp = Y + (unsigned)r * DM + c; *(f32x4*)yp = a0; *(f32x4*)(yp + 4) = a1; }
            ssq_row_put(part, ssq + (unsigned)r * 16 + u.pn * 4 + wc, fr, fq);
        }
    }
};
struct EpiUp {
    static constexpr bool PERM = true, AFTER_DRAIN = false;
    CArgsP a0;
    DI void operator()(const f32x4 (&acc)[2][2][4][2], const Unit& u, int wr, int wc, int fr0, int fq0) const {
        asm volatile("s_waitcnt vmcnt(0)" ::: "memory");     unsigned ones_ = ~0u; asm volatile("" : "+s"(ones_)); const int lane_ = (int)__builtin_amdgcn_mbcnt_hi(ones_, __builtin_amdgcn_mbcnt_lo(ones_, 0u)); const int fr = lane_ & 15, fq = lane_ >> 4; (void)fr0; (void)fq0;
        CArgsP a = a0; asm volatile("" : "+s"(a));
        unsigned char* ws = a->ws; const float* ssq_x1 = (const float*)(ws + WS_CTL) + SS_X1; bf16_t* U = (bf16_t*)(ws + A_U);
        EPI_ROWS {
            const int r = u.pm * 256 + ai * 128 + wr * 64 + m * 16 + fr;
            const float rs = fast_rsq(ssq_x1[r] * (1.f / DM) + EPS);
#pragma unroll
            for (int bj = 0; bj < 2; ++bj) { EPI_GETV(v, rs);
#pragma unroll
                for (int j = 0; j < 8; ++j) { const float t = fmaxf(v[j], 0.f); v[j] = t * t; }
                *(u32x4*)(U + (unsigned)r * FF + u.pn * 256 + bj * 128 + wc * 32 + fq * 8) = pack8(v); }
        }
    }
};

constexpr int KROW = 208, VROW = 136, KS_BYTES = 64 * KROW, VS_BYTES = 64 * VROW, AT_FLAGS = 2 * KS_BYTES + 2 * VS_BYTES;
DI int crow(int reg, int h) { return (reg & 3) + 8 * (reg >> 2) + 4 * h; }
DI bf16x8 pack_frag(const f32x16& x, int s) {
    u32x4 p; p.x = cvt_pk_bf16(x[8 * s], x[8 * s + 1]); p.y = cvt_pk_bf16(x[8 * s + 2], x[8 * s + 3]); p.z = cvt_pk_bf16(x[8 * s + 4], x[8 * s + 5]); p.w = cvt_pk_bf16(x[8 * s + 6], x[8 * s + 7]);
    return __builtin_bit_cast(bf16x8, p);
}
DI void sb_group(f32x16& s, float& carry, int key_base, int q_abs, int h, int lane) {
    float L[16];
#pragma unroll
    for (int i = 0; i < 16; ++i) { const float z = s[i]; const float sp = fmaxf(z, 0.f) + __logf(1.f + __expf(-fabsf(z))); L[i] = (key_base + crow(i, h) < q_abs) ? -sp : 0.f; }
    float cs[4], pc[4];
#pragma unroll
    for (int c = 0; c < 4; ++c) { cs[c] = (L[4 * c] + L[4 * c + 1]) + (L[4 * c + 2] + L[4 * c + 3]); pc[c] = shx(cs[c], 32, lane); }
    float run = carry;
#pragma unroll
    for (int c = 3; c >= 0; --c) {
        float t = (h == 0) ? run + pc[c] : run;
#pragma unroll
        for (int e = 3; e >= 0; --e) { const int i = 4 * c + e; const bool before = key_base + crow(i, h) < q_abs; const float a = __expf(L[i] + s[i] + t); t += L[i]; s[i] = before ? a : 0.f; }
        run += cs[c] + pc[c];
    }
    carry = run;
}
template <int MODE>
DI void attn_unit(LAS unsigned char* lds, const bf16_t* Qp, int qpitch, const bf16_t* Kp, int kpitch, const bf16_t* Kpe, const bf16_t* Vt, bf16_t* Op, int qb, float sink2, int tid) {
    constexpr int NK = MODE == 0 ? 6 : 4;
    const int lane = tid & 63, wave = tid >> 6, r32 = lane & 31, h = lane >> 5;
    const int row0 = qb * 256 + wave * 32, q_abs = row0 + r32;
    bf16x8 qf[NK];
#pragma unroll
    for (int kk = 0; kk < NK; ++kk) qf[kk] = *(const bf16x8*)(Qp + (size_t)q_abs * qpitch + 16 * kk + 8 * h);
    const int jt_hi = 4 * qb + 3, jt_lo = (MODE == 1) ? (4 * qb - 2 > 0 ? 4 * qb - 2 : 0) : 0, nT = jt_hi - jt_lo + 1;
    f32x16 o0, o1;
#pragma unroll
    for (int i = 0; i < 16; ++i) { o0[i] = 0.f; o1[i] = 0.f; }
    float mrun = (MODE == 1) ? sink2 : -1e30f, lrun = (MODE == 1 && h == 0) ? 1.f : 0.f, carry = 0.f;
    bool wdone = false;
    LAS unsigned* flags = (LAS unsigned*)(lds + AT_FLAGS);
    const int kkey = tid >> 3, kch = tid & 7, pkey = tid >> 2, pch = tid & 3;
    u32x4 kreg, vreg, preg;
    auto issue = [&](int jt) {
        kreg = *(const u32x4*)(Kp + (size_t)(64 * jt + kkey) * kpitch + kch * 8);
        vreg = *(const u32x4*)(Vt + (size_t)kkey * SEQ + 64 * jt + kch * 8);
        if (MODE == 0 && tid < 256) preg = *(const u32x4*)(Kpe + (size_t)(64 * jt + pkey) * 32 + pch * 8);
    };
    auto commit = [&](int buf) {
        *(LAS u32x4*)(lds + buf * KS_BYTES + kkey * KROW + kch * 16) = kreg;
        LAS u32x2* vp = (LAS u32x2*)(lds + 2 * KS_BYTES + buf * VS_BYTES + kkey * VROW + kch * 16); vp[0] = (u32x2){vreg.x, vreg.y}; vp[1] = (u32x2){vreg.z, vreg.w};
        if (MODE == 0 && tid < 256) *(LAS u32x4*)(lds + buf * KS_BYTES + pkey * KROW + 128 + pch * 16) = preg;
    };
    __syncthreads();
    issue(MODE == 2 ? jt_hi : jt_lo); commit(0);
    __syncthreads();
    for (int it = 0; it < nT; ++it) {
        const int jt = (MODE == 2) ? jt_hi - it : jt_lo + it, buf = it & 1;
        const bool more = it + 1 < nT;
        if (more) issue(MODE == 2 ? jt - 1 : jt + 1);
        bool active = (64 * jt <= row0 + 31);
        if (MODE == 1) active = active && (64 * jt + 63 >= row0 - 127);
        if (MODE == 2) active = active && !wdone;
        if (active) {
            const LAS unsigned char* ks = lds + buf * KS_BYTES; const LAS unsigned char* vs = lds + 2 * KS_BYTES + buf * VS_BYTES;
            f32x16 s0, s1;
#pragma unroll
            for (int i = 0; i < 16; ++i) { s0[i] = 0.f; s1[i] = 0.f; }
#pragma unroll
            for (int kk = 0; kk < NK; ++kk) {
                const bf16x8 a0 = *(const LAS bf16x8*)(ks + r32 * KROW + (16 * kk + 8 * h) * 2);
                const bf16x8 a1 = *(const LAS bf16x8*)(ks + (32 + r32) * KROW + (16 * kk + 8 * h) * 2);
                s0 = MFMA32(a0, qf[kk], s0); s1 = MFMA32(a1, qf[kk], s1);
            }
            const int kb0 = 64 * jt;
            if (MODE == 2) {
                sb_group(s1, carry, kb0 + 32, q_abs, h, lane);
                sb_group(s0, carry, kb0, q_abs, h, lane);
            } else {
                const bool need_mask = (MODE == 1) || (kb0 + 63 > row0);
                if (need_mask) {
#pragma unroll
                    for (int i = 0; i < 16; ++i) { const int k0 = kb0 + crow(i, h), k1 = k0 + 32;
                        bool v0 = k0 <= q_abs, v1 = k1 <= q_abs;
                        if (MODE == 1) { v0 = v0 && (q_abs - k0 < 128); v1 = v1 && (q_abs - k1 < 128); }
                        s0[i] = v0 ? s0[i] : -1e30f; s1[i] = v1 ? s1[i] : -1e30f; }
                }
                float mx = -1e30f;
#pragma unroll
                for (int i = 0; i < 16; ++i) mx = fmaxf(mx, fmaxf(s0[i], s1[i]));
                mx = fmaxf(mx, shx(mx, 32, lane));
                const float mnew = fmaxf(mrun, mx), alpha = __builtin_amdgcn_exp2f(mrun - mnew);
                float ls = 0.f;
#pragma unroll
                for (int i = 0; i < 16; ++i) { s0[i] = __builtin_amdgcn_exp2f(s0[i] - mnew); s1[i] = __builtin_amdgcn_exp2f(s1[i] - mnew); ls += s0[i] + s1[i]; }
                lrun = lrun * alpha + ls; mrun = mnew;
#pragma unroll
                for (int i = 0; i < 16; ++i) { o0[i] *= alpha; o1[i] *= alpha; }
            }
#pragma unroll
            for (int g = 0; g < 2; ++g)
#pragma unroll
                for (int s = 0; s < 2; ++s) {
                    const bf16x8 pf = pack_frag(g == 0 ? s0 : s1, s);
                    const int kofs = (32 * g + 16 * s + 4 * h) * 2;
                    { const s16x4 lo = *(const LAS s16x4*)(vs + r32 * VROW + kofs), hi = *(const LAS s16x4*)(vs + r32 * VROW + kofs + 16);
                      o0 = MFMA32(__builtin_shufflevector(lo, hi, 0, 1, 2, 3, 4, 5, 6, 7), pf, o0); }
                    { const s16x4 lo = *(const LAS s16x4*)(vs + (32 + r32) * VROW + kofs), hi = *(const LAS s16x4*)(vs + (32 + r32) * VROW + kofs + 16);
                      o1 = MFMA32(__builtin_shufflevector(lo, hi, 0, 1, 2, 3, 4, 5, 6, 7), pf, o1); }
                }
            if (MODE == 2) wdone = __all(carry < -88.f);
        }
        if (more) commit(buf ^ 1);
        if (MODE == 2 && lane == 0) flags[(it & 1) * 8 + wave] = wdone ? 1u : 0u;
        __syncthreads();
        if (MODE == 2) { unsigned all = 1u;
#pragma unroll
            for (int w = 0; w < 8; ++w) all &= flags[(it & 1) * 8 + w];
            if (all) break; }
    }
    if (MODE != 2) { const float l = lrun + shx(lrun, 32, lane); const float inv = 1.f / l;
#pragma unroll
        for (int i = 0; i < 16; ++i) { o0[i] *= inv; o1[i] *= inv; } }
    bf16_t* orow = Op + (size_t)q_abs * 512;
#pragma unroll
    for (int c = 0; c < 4; ++c) {
        *(u32x2*)(orow + 8 * c + 4 * h) = pack4(o0[4 * c], o0[4 * c + 1], o0[4 * c + 2], o0[4 * c + 3]);
        *(u32x2*)(orow + 32 + 8 * c + 4 * h) = pack4(o1[4 * c], o1[4 * c + 1], o1[4 * c + 2], o1[4 * c + 3]);
    }
}

struct RoundOrder {
    pg8::StaticOrder S; int rnd;
    DI bool next(int i, Unit& u) const { return i == 0 ? S.next(rnd, u) : false; }
    DI void a_ready(const Unit&) const {}
    DI void done(const Unit&) const {}
};
template <int N, class Epi>
DI void run_gemm_n(LAS unsigned char* lds, int tid, int G, int bx, const bf16_t* A, const bf16_t* Bt, int K, const Epi& E) {
    pg8::Gemm g{A, Bt, MTOK, N, K};
    constexpr int nwg = (MTOK / 256) * (N / 256), NR = (nwg + 255) / 256;
    if constexpr (N == FF || N == NGATE) {
        pg8::StaticOrder S; S.init(MTOK, N, G, bx);
        pg8::gemm_phase<Epi, pg8::StaticOrder, true, true>(lds, g, S, E, tid);
    } else {
#pragma unroll
        for (int rnd = 0; rnd < NR; ++rnd) { RoundOrder R; R.S.init(MTOK, N, G, bx); R.rnd = rnd; pg8::gemm_phase<Epi, RoundOrder, false, true>(lds, g, R, E, tid); }
    }
}
#define run_gemm(lds, tid, G, bx, A, Bt, N, K, E) run_gemm_n<N>(lds, tid, G, bx, A, Bt, K, E)

template <int PH>
DI void do_phase(LAS unsigned char* lds, int wave_s) {
    constexpr int ph = PH;
    {
        CArgsP a = (CArgsP)__builtin_amdgcn_kernarg_segment_ptr(); asm volatile("" : "+s"(a));
        unsigned char* ws = a->ws;
        float* ctl = (float*)(ws + WS_CTL);
        const float* tc = (const float*)(ws + WS_TAB); const float* ts = tc + (size_t)MTOK * 32;
        bf16_t* XB = (bf16_t*)(ws + WS_XB);
        int G = gridDim.x, bx = blockIdx.x; unsigned ones = ~0u; asm volatile("" : "+s"(G), "+s"(bx), "+s"(ones));
        const int vcu = (G % 8 == 0) ? (bx % 8) * (G / 8) + bx / 8 : bx;
        int tid = wave_s * 64 + (int)__builtin_amdgcn_mbcnt_hi(ones, __builtin_amdgcn_mbcnt_lo(ones, 0u)); asm volatile("" : "+v"(tid));
        const int lane = tid & 63, wave = __builtin_amdgcn_readfirstlane(tid >> 6);
        const int gw = vcu * 8 + wave, ngw = G * 8;
        if (ph == 0) {
#if (PHMASK & 1)
            { u32x4* z = (u32x4*)((bf16_t*)(ws + W_IN) + (size_t)416 * 1024); for (int i = bx * NTHR + tid; i < 96 * 1024 * 2 / 16; i += G * NTHR) z[i] = (u32x4){0u, 0u, 0u, 0u}; }
            { unsigned char* z = ws + W_UKV; for (int i = bx * NTHR + tid; i < 1024 * 16; i += G * NTHR) *(u32x4*)(z + (size_t)(i >> 4) * 512 + 256 + (i & 15) * 16) = (u32x4){0u, 0u, 0u, 0u}; }
            for (int i = bx * NTHR + tid; i < (int)(BAR_BYTES / 4); i += G * NTHR) ((unsigned*)(ws + WS_BAR))[i] = 0u;
            for (int i = bx * NTHR + tid; i < MTOK * 32; i += G * NTHR) {
                const int r = i >> 5, k = i & 31;
                const float inv = ROPE_INV[k];
                const float ang = (float)a->pos[r] * inv;
                double rev = (double)ang * 0.15915494309189535; rev -= floor(rev);
                const float fr = (float)rev;
                ((float*)(ws + WS_TAB))[i] = __builtin_amdgcn_cosf(fr); ((float*)(ws + WS_TAB))[(size_t)MTOK * 32 + i] = __builtin_amdgcn_sinf(fr);
            }
            for (int r = gw; r < MTOK; r += ngw) row_update(a->in[0], nullptr, nullptr, nullptr, nullptr, XB, ctl + SS_X, r, lane);
            conv_layer(a, 0, lds, gw, ngw, wave, lane);
#endif
        } else {
            const int l = (ph - 1) / NPH_LAYER, sp = (ph - 1) % NPH_LAYER;
            const float* ssq_y = (const float*)(ws + A_SSP) + SP_Y; const float* ssq_y2 = (const float*)(ws + A_SSP) + SP_Y2;
            if (sp == 0) {
#if (PHMASK & 2)
                { EpiIn E{a, l}; run_gemm(lds, tid, G, bx, XB, (const bf16_t*)(ws + W_IN), 2816, 1024, E); }
                { EpiGate E{a, l}; run_gemm(lds, tid, G, bx, XB, (const bf16_t*)(ws + W_IN) + (size_t)2816 * 1024, NGATE, 1024, E); }
#endif
            } else if (sp == 1) {
#if (PHMASK & 4)
                { EpiUpQ E{a, l}; run_gemm(lds, tid, G, bx, (const bf16_t*)(ws + A_CQ), (const bf16_t*)(ws + W_UQ), 768, 256, E); }
                { EpiUpKV E{a, l}; run_gemm(lds, tid, G, bx, (const bf16_t*)(ws + A_CKV), (const bf16_t*)(ws + W_UKV), 1024, 256, E); }
#endif
            } else if (sp == 2) {
#if (PHMASK & 8)
                for (int w = vcu; w < 256; w += G) {
                    const int bh = w >> 4, sx = w & 15, b = bh >> 3, h = bh & 7;
                    const bf16_t* qm = (const bf16_t*)(ws + A_QMLA) + (size_t)bh * SEQ * 96;
                    const bf16_t* kn = (const bf16_t*)(ws + A_KNOPE) + (size_t)b * SEQ * 512 + h * 64;
                    const bf16_t* kp = (const bf16_t*)(ws + A_KPE) + (size_t)b * SEQ * 32;
                    const bf16_t* vm = (const bf16_t*)(ws + A_VTMLA) + (size_t)bh * 64 * SEQ;
                    bf16_t* om = (bf16_t*)(ws + A_OMLA) + (size_t)b * SEQ * 512 + h * 64;
                    attn_unit<0>(lds, qm, 96, kn, 512, kp, vm, om, 31 - sx, 0.f, tid);
                    attn_unit<0>(lds, qm, 96, kn, 512, kp, vm, om, sx, 0.f, tid);
                    bf16_t* qs = (bf16_t*)(ws + A_QSWA) + (size_t)b * SEQ * 512 + h * 64;
                    const bf16_t* ksw = (const bf16_t*)(ws + A_KSWA) + (size_t)b * SEQ * 128 + (h >> 2) * 64;
                    const bf16_t* vsw = (const bf16_t*)(ws + A_VTSWA) + (size_t)(b * 2 + (h >> 2)) * 64 * SEQ;
                    const float sink2 = a->in[9][l * 8 + h] * LOG2E;
                    attn_unit<1>(lds, qs, 512, ksw, 128, nullptr, vsw, qs, 2 * sx, sink2, tid);
                    attn_unit<1>(lds, qs, 512, ksw, 128, nullptr, vsw, qs, 2 * sx + 1, sink2, tid);
                    bf16_t* qb_ = (bf16_t*)(ws + A_QSB) + (size_t)b * SEQ * 512 + h * 64;
                    const bf16_t* kb_ = (const bf16_t*)(ws + A_KSB) + (size_t)b * SEQ * 512 + h * 64;
                    const bf16_t* vb_ = (const bf16_t*)(ws + A_VTSB) + (size_t)bh * 64 * SEQ;
                    attn_unit<2>(lds, qb_, 512, kb_, 512, nullptr, vb_, qb_, 2 * sx, 0.f, tid);
                    attn_unit<2>(lds, qb_, 512, kb_, 512, nullptr, vb_, qb_, 2 * sx + 1, 0.f, tid);
                }
#endif
            } else if (sp == 3) {
#if (PHMASK & 16)
                for (int br = 0; br < 3; ++br) {
                    EpiBranch E{a, br};
                    const bf16_t* A = br == 0 ? (const bf16_t*)(ws + A_OMLA) : br == 1 ? (const bf16_t*)(ws + A_QSWA) : (const bf16_t*)(ws + A_QSB);
                    run_gemm(lds, tid, G, bx, A, (const bf16_t*)(ws + W_OA) + (size_t)br * 1024 * 512, 1024, 512, E);
                }
                {
                    __builtin_amdgcn_fence(__ATOMIC_ACQUIRE, "agent");
                    pg8::StaticOrder S; S.init(MTOK, 1024, G, bx); Unit u;
                    if (S.next(0, u)) {
                        const bf16_t* Gp = (const bf16_t*)(ws + A_G); bf16_t* R = (bf16_t*)(ws + A_MIXED);
                        for (int i = tid; i < 256 * 32; i += NTHR) {
                            const int r = u.pm * 256 + (i >> 5), c = u.pn * 256 + (i & 31) * 8; const unsigned off = (unsigned)r * DM + c;
                            float acc8[8] = {0.f, 0.f, 0.f, 0.f, 0.f, 0.f, 0.f, 0.f};
#pragma unroll
                            for (int b3 = 0; b3 < 3; ++b3) {
                                const u32x4 gw = *(const u32x4*)(Gp + (unsigned)r * NGATE + b3 * 1024 + c), rw = *(const u32x4*)(R + (size_t)b3 * MTOK * DM + off);
                                acc8[0] += __uint_as_float(gw.x << 16) * __uint_as_float(rw.x << 16); acc8[1] += __uint_as_float(gw.x & 0xffff0000u) * __uint_as_float(rw.x & 0xffff0000u);
                                acc8[2] += __uint_as_float(gw.y << 16) * __uint_as_float(rw.y << 16); acc8[3] += __uint_as_float(gw.y & 0xffff0000u) * __uint_as_float(rw.y & 0xffff0000u);
                                acc8[4] += __uint_as_float(gw.z << 16) * __uint_as_float(rw.z << 16); acc8[5] += __uint_as_float(gw.z & 0xffff0000u) * __uint_as_float(rw.z & 0xffff0000u);
                                acc8[6] += __uint_as_float(gw.w << 16) * __uint_as_float(rw.w << 16); acc8[7] += __uint_as_float(gw.w & 0xffff0000u) * __uint_as_float(rw.w & 0xffff0000u);
                            }
                            *(u32x4*)(R + off) = pack8(acc8);
                        }
                    }
                }
#endif
            } else if (sp == 4) {
#if 0
                const bf16_t* Gp = (const bf16_t*)(ws + A_G); bf16_t* R = (bf16_t*)(ws + A_MIXED);
                for (int i = bx * NTHR + tid; i < MTOK * DM / 8; i += G * NTHR) {
                    const int r = i >> 7, c = (i & 127) * 8; const unsigned off = (unsigned)r * DM + c;
                    float acc8[8] = {0.f, 0.f, 0.f, 0.f, 0.f, 0.f, 0.f, 0.f};
#pragma unroll
                    for (int b3 = 0; b3 < 3; ++b3) {
                        const u32x4 gw = *(const u32x4*)(Gp + (unsigned)r * NGATE + b3 * 1024 + c), rw = *(const u32x4*)(R + (size_t)b3 * MTOK * DM + off);
                        acc8[0] += __uint_as_float(gw.x << 16) * __uint_as_float(rw.x << 16); acc8[1] += __uint_as_float(gw.x & 0xffff0000u) * __uint_as_float(rw.x & 0xffff0000u);
                        acc8[2] += __uint_as_float(gw.y << 16) * __uint_as_float(rw.y << 16); acc8[3] += __uint_as_float(gw.y & 0xffff0000u) * __uint_as_float(rw.y & 0xffff0000u);
                        acc8[4] += __uint_as_float(gw.z << 16) * __uint_as_float(rw.z << 16); acc8[5] += __uint_as_float(gw.z & 0xffff0000u) * __uint_as_float(rw.z & 0xffff0000u);
                        acc8[6] += __uint_as_float(gw.w << 16) * __uint_as_float(rw.w << 16); acc8[7] += __uint_as_float(gw.w & 0xffff0000u) * __uint_as_float(rw.w & 0xffff0000u);
                    }
                    *(u32x4*)(R + off) = pack8(acc8);
                }
#endif
            } else if (sp == 5 || sp == 8) {
#if (PHMASK & 32)
                EpiY E{a, l, sp == 5 ? 0 : 1};
                if (sp == 5) run_gemm(lds, tid, G, bx, (const bf16_t*)(ws + A_MIXEDB), (const bf16_t*)(ws + W_OUT), 1024, 1024, E);
                else run_gemm(lds, tid, G, bx, (const bf16_t*)(ws + A_U), (const bf16_t*)(ws + W_DN), 1024, 4096, E);
#endif
            } else if (sp == 6 || sp == 9) {
#if (PHMASK & 64)
                const float* xin = (sp == 6 && l == 0) ? a->in[0] : a->out;
                const float* Y = (const float*)(ws + (sp == 6 ? A_Y : A_Y2));
                const float* gpost = (sp == 6 ? a->in[14] : a->in[18]) + l * DM;
                for (int r = gw; r < MTOK; r += ngw) row_update(xin, a->out, Y, sp == 6 ? ssq_y : ssq_y2, gpost, XB, ctl + (sp == 6 ? SS_X1 : SS_X), r, lane);
                if (sp == 9 && l + 1 < DEPTH) conv_layer(a, l + 1, lds, gw, ngw, wave, lane);
#endif
            } else if (sp == 7) {
#if (PHMASK & 128)
                EpiUp E{a};
                run_gemm(lds, tid, G, bx, XB, (const bf16_t*)(ws + W_UP), FF, 1024, E);
#endif
            }
        }
    }
}

__global__ void __launch_bounds__(NTHR, 2) mk_fwd(Args a_) {
    extern __shared__ __attribute__((aligned(16))) unsigned char lds_raw[];
    LAS unsigned char* lds = (LAS unsigned char*)lds_raw;
    cg::grid_group grid = cg::this_grid();
    const int ph_lo = a_.ph_lo, ph_hi = a_.ph_hi;
    const int wave_s = __builtin_amdgcn_readfirstlane(threadIdx.x >> 6);
    static_assert(NPHASES == 41, "phase list below");
#define SEAM(P) do { if ((P) == 0 || gridDim.x != 256) grid.sync(); else { unsigned o_ = ~0u; int bx_ = blockIdx.x; asm volatile("" : "+s"(o_), "+s"(bx_)); const int t_ = wave_s * 64 + (int)__builtin_amdgcn_mbcnt_hi(o_, __builtin_amdgcn_mbcnt_lo(o_, 0u)); ms::grid_sync((unsigned*)(a_.ws + WS_BAR), t_, bx_, (unsigned)(P) + 1u); } } while (0)
#define RUN_PH(P) if (!((P) > 0 && ((P) - 1) % NPH_LAYER == 4) && ph_lo <= (P) && (P) < ph_hi) { do_phase<P>(lds, wave_s); if ((P) + 1 < ph_hi) SEAM(P); }
    RUN_PH(0)
    RUN_PH(1)
    RUN_PH(2)
    RUN_PH(3)
    RUN_PH(4)
    RUN_PH(5)
    RUN_PH(6)
    RUN_PH(7)
    RUN_PH(8)
    RUN_PH(9)
    RUN_PH(10)
    RUN_PH(11)
    RUN_PH(12)
    RUN_PH(13)
    RUN_PH(14)
    RUN_PH(15)
    RUN_PH(16)
    RUN_PH(17)
    RUN_PH(18)
    RUN_PH(19)
    RUN_PH(20)
    RUN_PH(21)
    RUN_PH(22)
    RUN_PH(23)
    RUN_PH(24)
    RUN_PH(25)
    RUN_PH(26)
    RUN_PH(27)
    RUN_PH(28)
    RUN_PH(29)
    RUN_PH(30)
    RUN_PH(31)
    RUN_PH(32)
    RUN_PH(33)
    RUN_PH(34)
    RUN_PH(35)
    RUN_PH(36)
    RUN_PH(37)
    RUN_PH(38)
    RUN_PH(39)
    RUN_PH(40)
#undef RUN_PH
#undef SEAM
}

#ifdef DBG_STOP
__global__ void dbg_dump(const unsigned short* ws16, float* out) {
    const size_t i = (size_t)blockIdx.x * blockDim.x + threadIdx.x;
    if (i >= (size_t)MTOK * DM) return;
    float acc = 0.f;
#ifdef DBG_OFF
#ifdef DBG_F32
    acc = ((const float*)ws16)[(size_t)(DBG_OFF) / 4 + i];
#else
    { const unsigned short w = ws16[(size_t)(DBG_OFF) / 2 + i]; acc = __uint_as_float((unsigned)w << 16); }
#endif
#else
    const size_t base = WS_XB / 2, total = (WS_END - WS_XB) / 2;
    for (size_t o = i; o < total; o += (size_t)MTOK * DM) { const unsigned short w = ws16[base + o]; if (((w >> 7) & 0xff) != 0xff) acc += __uint_as_float((unsigned)w << 16); }
#endif
    out[i] = acc;
}
#endif
}

extern "C" void kernel_launch(void* const* d_in, const int* in_sizes, int n_in, void* d_out, int out_size, void* d_ws, size_t ws_size, hipStream_t stream) {
    using namespace mk;
    static int grid = 0;
    if (grid == 0) {
        if (n_in != 19 || out_size != MTOK * DM || ws_size < WS_END) { fprintf(stderr, "kernel_launch: unexpected shapes (n_in %d, out %d, ws %zu < %zu)\n", n_in, out_size, ws_size, (size_t)WS_END); grid = -1; return; }
        int dev = 0, cus = 0, per_cu = 0;
        (void)hipGetDevice(&dev); (void)hipDeviceGetAttribute(&cus, hipDeviceAttributeMultiprocessorCount, dev);
        (void)hipFuncSetAttribute((const void*)mk_fwd, hipFuncAttributeMaxDynamicSharedMemorySize, LDS_BYTES);
        if (hipOccupancyMaxActiveBlocksPerMultiprocessor(&per_cu, (const void*)mk_fwd, NTHR, LDS_BYTES) != hipSuccess || per_cu < 1) { fprintf(stderr, "kernel_launch: occupancy query says %d\n", per_cu); per_cu = 1; }
        (void)hipGetLastError();
        grid = cus * per_cu;
        if (grid < 256) { fprintf(stderr, "kernel_launch: this kernel needs a 256-workgroup resident grid (got %d)\n", grid); grid = -1; return; }
        if (grid > 256) grid = 256;
    }
    if (grid < 0) return;
    Args a{};
    for (int i = 0; i < 19; ++i) a.in[i] = (const float*)d_in[i];
    a.pos = (const int*)d_in[1]; a.out = (float*)d_out; a.ws = (unsigned char*)d_ws;
#if ONE_LAUNCH
    a.ph_lo = 0; a.ph_hi = NPHASES;
    void* args[] = {&a};
    hipError_t e = hipLaunchCooperativeKernel((const void*)mk_fwd, dim3(grid), dim3(NTHR), args, LDS_BYTES, stream);
    if (e != hipSuccess) fprintf(stderr, "cooperative launch failed: %s (grid %d)\n", hipGetErrorString(e), grid);
#else
#ifdef DBG_STOP
    for (int ph = 0; ph <= DBG_STOP; ++ph) { a.ph_lo = ph; a.ph_hi = ph + 1; hipLaunchKernelGGL(mk_fwd, dim3(grid), dim3(NTHR), LDS_BYTES, stream, a); }
#ifndef DBG_NODUMP
    hipLaunchKernelGGL(dbg_dump, dim3(MTOK * DM / 256), dim3(256), 0, stream, (const unsigned short*)d_ws, (float*)d_out);
#endif
#else
    for (int ph = 0; ph < NPHASES; ++ph) { a.ph_lo = ph; a.ph_hi = ph + 1; hipLaunchKernelGGL(mk_fwd, dim3(grid), dim3(NTHR), LDS_BYTES, stream, a); }
#endif
#endif
}
```

```cpp
#include <hip/hip_runtime.h>
#include <hip/hip_cooperative_groups.h>
#include <cstdio>
#include <cstdint>
namespace cg = cooperative_groups;
#define ONE_LAUNCH 1
namespace pg8 {
#define PG8_LAS __attribute__((address_space(3)))
typedef unsigned short bf16_t;
typedef short bf16x8 __attribute__((ext_vector_type(8)));
typedef float f32x4 __attribute__((ext_vector_type(4)));
typedef unsigned u32x4 __attribute__((ext_vector_type(4)));
constexpr int BM = 256, BK = 64, HALF = 128, HTB = HALF * BK * 2  , STAGE_BYTES = 8 * HTB, NXCD = 8, WGM = 8;

__host__ __device__ __forceinline__ int lds_byte(int r, int c) { const int st = (r >> 4) * 2 + (c >> 5), rr = r & 15, cc = c & 31, ob = rr * 64 + cc * 2; return st * 1024 + (ob ^ (((ob >> 9) & 1) << 5)); }
__host__ __device__ __forceinline__ void stage_rc(int b, int& R, int& C) { const int st = b / 1024, sb = b % 1024, swz = sb ^ (((sb >> 9) & 1) << 5); R = (st >> 1) * 16 + swz / 64; C = (st & 1) * 32 + (swz % 64) / 2; }
__host__ __device__ __forceinline__ int perm32(int rho) { const int n = rho >> 4, i = rho & 15; return 8 * (i >> 2) + 4 * n + (i & 3); }

struct Unit { int pm, pn; };
struct Gemm { const bf16_t* A; const bf16_t* Bt; int M, N, K; };

struct StaticOrder {
    int nM, nN, nwg, G, c;
    __host__ __device__ void init(int M, int N, int G_, int c_) { nM = M / BM; nN = N / BM; nwg = nM * nN; G = G_; c = c_; }
    __host__ __device__ bool next(int i, Unit& u) const {
        const long L = (long)i * G + c; if (L >= nwg) return false;
        int wgid = (int)L; { const int q = nwg / NXCD, r = nwg % NXCD, xcd = wgid % NXCD, off = wgid / NXCD; wgid = (xcd < r ? xcd * (q + 1) : r * (q + 1) + (xcd - r) * q) + off; }
        const int nig = WGM * nN, gid = wgid / nig, fm = gid * WGM, gsz = (nM - fm) < WGM ? (nM - fm) : WGM;
        u.pm = fm + ((wgid % nig) % gsz); u.pn = (wgid % nig) / gsz; return true;
    }
    __device__ __forceinline__ void a_ready(const Unit&) const {}
    __device__ __forceinline__ void done(const Unit&) const {}
};

__device__ __forceinline__ unsigned cvt_pk_bf16(float lo, float hi) { unsigned r; asm volatile("v_cvt_pk_bf16_f32 %0, %1, %2" : "=v"(r) : "v"(lo), "v"(hi)); return r; }
template <class Epi, class Sched, bool ALIGN_EPI = false, bool SP2 = false>
__device__ __forceinline__ void gemm_phase(PG8_LAS unsigned char* lds, const Gemm g, const Sched& S, const Epi& E, int tid_in) {
    int tid_ = tid_in; asm volatile("" : "+v"(tid_));
    const int tid = tid_, wid = __builtin_amdgcn_readfirstlane(tid >> 6), lane = tid & 63, wr = wid >> 2, wc = wid & 3, fr = lane & 15, fq = lane >> 4;
    const int K = g.K, nt = K / BK;
    unsigned voffA[2], voffB[2];
#pragma unroll
    for (int i = 0; i < 2; ++i) { int R, C; stage_rc(tid * 16 + i * 8192, R, C); const int Rb = Epi::PERM ? ((R & ~31) + perm32(R & 31)) : R;
        voffA[i] = (unsigned)(R * K + C) * 2u; voffB[i] = (unsigned)(Rb * K + C) * 2u; }
    const size_t kstep = (size_t)(BK * 2);
    const size_t hstep = (size_t)HALF * K * 2;
    const size_t tstep = 2 * hstep;
    const unsigned ldsw = (unsigned)wid * 1024u;
    const int aoff = lds_byte(wr * 64 + fr, fq * 8), boff = lds_byte(wc * 32 + fr, fq * 8);
#define PG8_SA(b, h) (((b) * 2 + (h)) * HTB)
#define PG8_SB(b, h) ((4 + (b) * 2 + (h)) * HTB)
#define PG8_STAGE(bufoff, gbase, voff) do { _Pragma("unroll") for (int _i = 0; _i < 2; ++_i) \
        __builtin_amdgcn_global_load_lds((const unsigned*)((const char*)(gbase) + (voff)[_i]), (PG8_LAS unsigned*)(lds + (bufoff) + ldsw + _i * 8192), 16, 0, 0); } while (0)
#define PG8_LDA(dst, b, h) do { _Pragma("unroll") for (int m = 0; m < 4; ++m) _Pragma("unroll") for (int k = 0; k < 2; ++k) dst[m][k] = *(const PG8_LAS bf16x8*)(lds + PG8_SA(b, h) + aoff + m * 2048 + k * 1024); } while (0)
#define PG8_LDB(dst, b, h) do { _Pragma("unroll") for (int n = 0; n < 2; ++n) _Pragma("unroll") for (int k = 0; k < 2; ++k) dst[n][k] = *(const PG8_LAS bf16x8*)(lds + PG8_SB(b, h) + boff + n * 2048 + k * 1024); } while (0)
#define PG8_MMA(ai, bj, At, Bt) do { __builtin_amdgcn_s_setprio(1); _Pragma("unroll") for (int m = 0; m < 4; ++m) _Pragma("unroll") for (int n = 0; n < 2; ++n) _Pragma("unroll") for (int k = 0; k < 2; ++k) \
        acc[ai][bj][m][n] = __builtin_amdgcn_mfma_f32_16x16x32_bf16(Bt[n][k], At[m][k], acc[ai][bj][m][n], 0, 0, 0); __builtin_amdgcn_s_setprio(0); } while (0)
#define PG8_WAIT_V(n) asm volatile("s_waitcnt vmcnt(" #n ")" ::: "memory")
#define PG8_WAIT_L(n) asm volatile("s_waitcnt lgkmcnt(" #n ")" ::: "memory")
#define PG8_BAR __builtin_amdgcn_s_barrier()
#define PG8_SCHED __builtin_amdgcn_sched_barrier(0)
    Unit cur, nxt; int ui = 0;
    if (!S.next(0, cur)) return;
    f32x4 acc[2][2][4][2];
    float z_ = 0.f; asm volatile("" : "+v"(z_));
#pragma unroll
    for (int a = 0; a < 2; ++a)
#pragma unroll
        for (int b = 0; b < 2; ++b)
#pragma unroll
            for (int m = 0; m < 4; ++m)
#pragma unroll
                for (int n = 0; n < 2; ++n) acc[a][b][m][n] = (f32x4){z_, z_, z_, z_};
    bf16x8 At[4][2], B0[2][2], B1[2][2];
    const char* cA = (const char*)g.A + (size_t)cur.pm * tstep; const char* cB = (const char*)g.Bt + (size_t)cur.pn * tstep;
    S.a_ready(cur);
    if constexpr (SP2) {
        PG8_STAGE(PG8_SB(0, 0), cB, voffB); PG8_STAGE(PG8_SB(0, 1), cB + hstep, voffB); PG8_STAGE(PG8_SA(0, 0), cA, voffA); PG8_STAGE(PG8_SA(0, 1), cA + hstep, voffA);
        if (wr == 1) PG8_BAR;
        PG8_WAIT_V(2); PG8_BAR;
        PG8_STAGE(PG8_SB(1, 0), cB + kstep, voffB); PG8_STAGE(PG8_SA(1, 0), cA + kstep, voffA); PG8_STAGE(PG8_SB(1, 1), cB + hstep + kstep, voffB);
        PG8_WAIT_V(6); PG8_BAR;
    } else {
        PG8_STAGE(PG8_SB(0, 0), cB, voffB); PG8_STAGE(PG8_SA(0, 0), cA, voffA); PG8_STAGE(PG8_SB(0, 1), cB + hstep, voffB); PG8_STAGE(PG8_SA(0, 1), cA + hstep, voffA);
        if (wr == 1) PG8_BAR;
        PG8_WAIT_V(4); PG8_BAR;
        PG8_STAGE(PG8_SB(1, 0), cB + kstep, voffB); PG8_STAGE(PG8_SA(1, 0), cA + kstep, voffA); PG8_STAGE(PG8_SB(1, 1), cB + hstep + kstep, voffB);
        PG8_WAIT_V(6); PG8_BAR;
    }
    for (;;) {
        const bool has_next = S.next(ui + 1, nxt);
        const char* nA = has_next ? (const char*)g.A + (size_t)nxt.pm * tstep : cA; const char* nB = has_next ? (const char*)g.Bt + (size_t)nxt.pn * tstep : cB;
        for (int t = 0; t < nt; t += 2) {
            const bool last = (t == nt - 2);
            const char* a1 = cA + (size_t)(t + 1) * kstep;
            const char* a2 = last ? nA : cA + (size_t)(t + 2) * kstep; const char* b2 = last ? nB : cB + (size_t)(t + 2) * kstep;
            const char* a3 = a2 + kstep; const char* b3 = b2 + kstep;
            if (last && has_next) S.a_ready(nxt);
            if constexpr (SP2) {
            PG8_LDB(B0, 0, 0); PG8_LDB(B1, 0, 1); PG8_SCHED; PG8_LDA(At, 0, 0); PG8_STAGE(PG8_SA(1, 1), a1 + hstep, voffA);
            PG8_WAIT_V(8); PG8_WAIT_L(0); PG8_BAR; PG8_MMA(0, 0, At, B0); PG8_MMA(0, 1, At, B1); PG8_BAR; PG8_SCHED;
            PG8_LDA(At, 0, 1); PG8_STAGE(PG8_SB(0, 0), b2, voffB); PG8_STAGE(PG8_SB(0, 1), b2 + hstep, voffB); PG8_STAGE(PG8_SA(0, 0), a2, voffA);
            PG8_WAIT_V(8); PG8_WAIT_L(0); PG8_BAR; PG8_MMA(1, 0, At, B0); PG8_MMA(1, 1, At, B1); PG8_BAR; PG8_SCHED;
            PG8_LDB(B0, 1, 0); PG8_LDB(B1, 1, 1); PG8_SCHED; PG8_LDA(At, 1, 0); PG8_STAGE(PG8_SA(0, 1), a2 + hstep, voffA);
            PG8_WAIT_V(8); PG8_WAIT_L(0); PG8_BAR; PG8_MMA(0, 0, At, B0); PG8_MMA(0, 1, At, B1); PG8_BAR; PG8_SCHED;
            PG8_LDA(At, 1, 1); PG8_STAGE(PG8_SB(1, 0), b3, voffB); PG8_STAGE(PG8_SB(1, 1), b3 + hstep, voffB); PG8_STAGE(PG8_SA(1, 0), a3, voffA);
            PG8_WAIT_V(8); PG8_WAIT_L(0); PG8_BAR; PG8_MMA(1, 0, At, B0); PG8_MMA(1, 1, At, B1); PG8_BAR; PG8_SCHED;
            } else {
            PG8_LDB(B0, 0, 0); PG8_SCHED; PG8_LDA(At, 0, 0); PG8_STAGE(PG8_SA(1, 1), a1 + hstep, voffA);
            PG8_WAIT_L(8); PG8_BAR; PG8_WAIT_L(0); PG8_MMA(0, 0, At, B0); PG8_BAR; PG8_SCHED;
            PG8_LDB(B1, 0, 1); PG8_STAGE(PG8_SB(0, 0), b2, voffB);
            PG8_BAR; PG8_WAIT_L(0); PG8_MMA(0, 1, At, B1); PG8_BAR;
            PG8_LDA(At, 0, 1); PG8_STAGE(PG8_SA(0, 0), a2, voffA);
            PG8_BAR; PG8_WAIT_L(0); PG8_MMA(1, 0, At, B0); PG8_BAR; PG8_SCHED;
            PG8_STAGE(PG8_SB(0, 1), b2 + hstep, voffB);
            PG8_WAIT_V(6); PG8_BAR; PG8_MMA(1, 1, At, B1); PG8_BAR;
            PG8_LDB(B0, 1, 0); PG8_SCHED; PG8_LDA(At, 1, 0); PG8_STAGE(PG8_SA(0, 1), a2 + hstep, voffA);
            PG8_WAIT_L(8); PG8_BAR; PG8_WAIT_L(0); PG8_MMA(0, 0, At, B0); PG8_BAR; PG8_SCHED;
            PG8_LDB(B1, 1, 1); PG8_STAGE(PG8_SB(1, 0), b3, voffB);
            PG8_BAR; PG8_WAIT_L(0); PG8_MMA(0, 1, At, B1); PG8_BAR;
            PG8_LDA(At, 1, 1); PG8_STAGE(PG8_SA(1, 0), a3, voffA);
            PG8_BAR; PG8_WAIT_L(0); PG8_MMA(1, 0, At, B0); PG8_BAR; PG8_SCHED;
            PG8_STAGE(PG8_SB(1, 1), b3 + hstep, voffB);
            PG8_WAIT_V(6); PG8_BAR; PG8_MMA(1, 1, At, B1); PG8_BAR;
            }
        }
        if constexpr (ALIGN_EPI) { if (wr == 0) PG8_BAR; }
        if constexpr (!Epi::AFTER_DRAIN) { E(acc, cur, wr, wc, fr, fq); S.done(cur); }
        if (!has_next) break;
        z_ = 0.f; asm volatile("" : "+v"(z_));
#pragma unroll
        for (int a = 0; a < 2; ++a)
#pragma unroll
            for (int b = 0; b < 2; ++b)
#pragma unroll
                for (int m = 0; m < 4; ++m)
#pragma unroll
                    for (int n = 0; n < 2; ++n) acc[a][b][m][n] = (f32x4){z_, z_, z_, z_};
        cur = nxt; cA = nA; cB = nB; ++ui;
        if constexpr (ALIGN_EPI) { if (wr == 1) PG8_BAR; }
    }
    PG8_WAIT_V(0);
    if constexpr (!ALIGN_EPI) { if (wr == 0) PG8_BAR; }
    PG8_BAR;
    if constexpr (Epi::AFTER_DRAIN) { E.fused(acc, cur, wr, wc, fr, fq, lds, wid, lane); S.done(cur); }
#undef PG8_SA
#undef PG8_SB
#undef PG8_STAGE
#undef PG8_LDA
#undef PG8_LDB
#undef PG8_MMA
#undef PG8_WAIT_V
#undef PG8_WAIT_L
#undef PG8_BAR
#undef PG8_SCHED
}
}
namespace ms {
__device__ __forceinline__ unsigned ld(const unsigned* p) { return __hip_atomic_load(p, __ATOMIC_RELAXED, __HIP_MEMORY_SCOPE_AGENT); }
__device__ __forceinline__ void st(unsigned* p, unsigned v) { __hip_atomic_store(p, v, __ATOMIC_RELAXED, __HIP_MEMORY_SCOPE_AGENT); }
constexpr int W_ARR = 0, W_GF = 512, W_REL = 1024;
__device__ __forceinline__ void grid_sync(unsigned* bw, int tid, int bx, unsigned seam) {
    asm volatile("s_waitcnt vmcnt(0)" ::: "memory");
    __syncthreads();
    if (tid < 64) {
        if (tid == 0) { __builtin_amdgcn_fence(__ATOMIC_RELEASE, "agent"); asm volatile("s_waitcnt vmcnt(0)" ::: "memory"); st(&bw[W_ARR + bx], seam); }
        if ((bx & 31) == 0) {
            const int g = bx >> 5;
            for (unsigned sp = 0; sp < (1u << 22); ++sp) { const unsigned v = (tid < 32) ? ld(&bw[W_ARR + g * 32 + tid]) : seam; if (__all(v == seam)) break; __builtin_amdgcn_s_sleep(1); }
            if (tid == 0) st(&bw[W_GF + 32 * g], seam);
            if (bx == 0) {
                for (unsigned sp = 0; sp < (1u << 22); ++sp) { const unsigned v = (tid < 8) ? ld(&bw[W_GF + 32 * tid]) : seam; if (__all(v == seam)) break; __builtin_amdgcn_s_sleep(1); }
                if (tid == 0) st(&bw[W_REL], seam);
            }
        }
        for (unsigned sp = 0; sp < (1u << 22); ++sp) { const unsigned v = ld(&bw[W_REL]); if (__all(v == seam)) break; __builtin_amdgcn_s_sleep(1); }
        if (tid == 0) { __builtin_amdgcn_fence(__ATOMIC_ACQUIRE, "agent"); asm volatile("s_waitcnt vmcnt(0)" ::: "memory"); }
    }
    __syncthreads();
}
}

#ifndef PHMASK
#define PHMASK 0x3ff
#endif
#ifndef ONE_LAUNCH
#define ONE_LAUNCH 1
#endif
namespace mk {
using pg8::bf16_t; using pg8::f32x4; using pg8::bf16x8; using pg8::u32x4; using pg8::Unit; using pg8::cvt_pk_bf16;
#define LAS __attribute__((address_space(3)))
typedef float f32x16 __attribute__((ext_vector_type(16)));
typedef unsigned u32x2 __attribute__((ext_vector_type(2)));
typedef short s16x4 __attribute__((ext_vector_type(4)));
#define DI __device__ __forceinline__
#define MFMA32(a, b, c) __builtin_amdgcn_mfma_f32_32x32x16_bf16((a), (b), (c), 0, 0, 0)

constexpr int BATCH = 2, SEQ = 8192, DM = 1024, MTOK = BATCH * SEQ, DEPTH = 4, FF = 4096, NIN = 5888, NGATE = 3072;
constexpr float EPS = 1e-6f, LOG2E = 1.4426950408889634f;
constexpr int NTHR = 512, LDS_BYTES = 147456;
constexpr int NPH_LAYER = 10, NPHASES = 1 + NPH_LAYER * DEPTH;

constexpr size_t MiB = (size_t)1 << 20;
constexpr size_t WS_CTL = 0, WS_TAB = 2 * MiB, WS_W = 6 * MiB, WS_XB = 40 * MiB, WS_AR = 72 * MiB, WS_END = WS_AR + 249 * MiB;
constexpr size_t W_IN = WS_W, W_UQ = W_IN + (size_t)NIN * 1024 * 2, W_UKV = W_UQ + 768 * 256 * 2, W_OA = W_UKV + 1024 * 256 * 2, W_OB = W_OA + 1024 * 512 * 2,
                 W_OC = W_OB + 1024 * 512 * 2, W_OUT = W_OC + 1024 * 512 * 2, W_UP = W_OUT + 1024 * 1024 * 2, W_DN = W_UP + (size_t)4096 * 1024 * 2, W_ENDW = W_DN + (size_t)4096 * 1024 * 2;
static_assert(W_ENDW <= WS_XB, "weights fit");
constexpr size_t A_G = WS_AR, A_QSWA = WS_AR + 96 * MiB, A_QSB = WS_AR + 112 * MiB, A_KSB = WS_AR + 128 * MiB, A_VTSB = WS_AR + 144 * MiB, A_CQ = WS_AR + 160 * MiB,
                 A_CKV = WS_AR + 237 * MiB  , A_KPE = WS_AR + 172 * MiB, A_KSWA = WS_AR + 173 * MiB, A_VTSWA = WS_AR + 177 * MiB, A_QMLA = WS_AR + 181 * MiB,
                 A_KNOPE = WS_AR + 205 * MiB, A_VTMLA = WS_AR + 221 * MiB;
constexpr size_t A_MIXED = WS_AR + 128 * MiB, A_MIXEDB = WS_AR + 128 * MiB  , A_Y = WS_AR, A_U = WS_AR, A_Y2 = WS_AR + 128 * MiB, A_OMLA = WS_XB;
constexpr int SS_X = 0, SS_X1 = MTOK, SS_L0 = 2 * MTOK;
constexpr size_t WS_BAR = WS_CTL + MiB, BAR_BYTES = 16384;
constexpr size_t A_SSP = WS_AR + 245 * MiB;
constexpr int SP_CQ = 0, SP_CKV = 4 * MTOK, SP_Y = 8 * MTOK, SP_Y2 = 24 * MTOK;

__constant__ float ROPE_INV[32] = {1.000000000e+00f, 7.498942018e-01f, 5.623413324e-01f, 4.216965139e-01f, 3.162277639e-01f, 2.371373773e-01f, 1.778279394e-01f, 1.333521456e-01f, 1.000000015e-01f, 7.498942316e-02f, 5.623413250e-02f, 4.216964915e-02f, 3.162277490e-02f, 2.371373773e-02f, 1.778279431e-02f, 1.333521400e-02f, 9.999999776e-03f, 7.498942316e-03f, 5.623413250e-03f, 4.216964822e-03f, 3.162277630e-03f, 2.371373819e-03f, 1.778279431e-03f, 1.333521446e-03f, 1.000000047e-03f, 7.498941850e-04f, 5.623413017e-04f, 4.216965172e-04f, 3.162277571e-04f, 2.371373703e-04f, 1.778279402e-04f, 1.333521504e-04f};
struct Args { const float* in[19]; const int* pos; float* out; unsigned char* ws; int ph_lo, ph_hi; };
typedef const __attribute__((address_space(4))) Args* CArgsP;

DI float shx(float v, int mask, int lane) { return __int_as_float(__builtin_amdgcn_ds_bpermute((lane ^ mask) << 2, __float_as_int(v))); }
DI float wave_sum(float v, int lane) {
#pragma unroll
    for (int o = 1; o < 64; o <<= 1) v += shx(v, o, lane);
    return v;
}
DI float bf2f(unsigned short b) { return __uint_as_float((unsigned)b << 16); }
DI u32x4 pack8(const float* v) { u32x4 w; w.x = cvt_pk_bf16(v[0], v[1]); w.y = cvt_pk_bf16(v[2], v[3]); w.z = cvt_pk_bf16(v[4], v[5]); w.w = cvt_pk_bf16(v[6], v[7]); return w; }
DI u32x2 pack4(float a, float b, float c, float d) { u32x2 w; w.x = cvt_pk_bf16(a, b); w.y = cvt_pk_bf16(c, d); return w; }
DI float fast_rsq(float x) { return __builtin_amdgcn_rsqf(x); }

DI int perm64inv(int d) { return d < 32 ? 8 * (d >> 2) + (d & 3) : 8 * ((d - 32) >> 2) + 4 + (d & 3); }
DI int perm32inv(int d) { return d < 16 ? 8 * (d >> 2) + (d & 3) : 8 * ((d - 16) >> 2) + 4 + (d & 3); }
DI int rowmap(int kind, int n) {
    if (kind == 0) return n;
    if (kind == 1) {
        if (n < 384) return n;
        if (n < 416) return 384 + perm32inv(n - 384);
        if (n < 928) { const int t = n - 416; return 512 + (t & ~63) + perm64inv(t & 63); }
        if (n < 1056) { const int t = n - 928; return 1024 + (t & ~63) + perm64inv(t & 63); }
        return n + 96;
    }
    if (kind == 2) { const int h = n / 96, j = n % 96; return j < 64 ? h * 64 + j : 512 + h * 32 + perm32inv(j - 64); }
    { const int h = n >> 7, j = n & 127; return j < 64 ? h * 64 + j : 512 + h * 64 + (j - 64); }
}
DI void conv_item(const float* W, int K, int N, bf16_t* WT, const float* gk, int kind, LAS float* scr, int item, int lane, int ldw = 0) {
    if (ldw == 0) ldw = K;
    const int nblk = N / 32, kb = item / nblk, nb = item % nblk, k0 = 64 * kb, n0 = 32 * nb;
#pragma unroll 8
    for (int i = 0; i < 32; ++i) { const int kk = 2 * i + (lane >> 5); float v = W[(size_t)(k0 + kk) * N + n0 + (lane & 31)]; if (gk) v *= gk[k0 + kk]; scr[kk * 33 + (lane & 31)] = v; }
    asm volatile("s_waitcnt lgkmcnt(0)" ::: "memory");
    const int c = lane & 7;
#pragma unroll
    for (int j = 0; j < 4; ++j) { const int n = (lane >> 3) + 8 * j; const LAS float* s = scr + (8 * c) * 33 + n;
        u32x4 o; o.x = cvt_pk_bf16(s[0 * 33], s[1 * 33]); o.y = cvt_pk_bf16(s[2 * 33], s[3 * 33]); o.z = cvt_pk_bf16(s[4 * 33], s[5 * 33]); o.w = cvt_pk_bf16(s[6 * 33], s[7 * 33]);
        *(u32x4*)(WT + (size_t)rowmap(kind, n0 + n) * ldw + k0 + 8 * c) = o; }
    asm volatile("s_waitcnt lgkmcnt(0)" ::: "memory");
}
DI void conv_layer(CArgsP a, int l, LAS unsigned char* lds, int gw, int ngw, int wave, int lane) {
    LAS float* scr = (LAS float*)(lds + wave * 16384);
    unsigned char* ws = a->ws;
    constexpr int I_IN = 16 * 181, I_UQ = 4 * 24, I_UKV = 2 * 32, I_O = 8 * 32, I_OUT = 16 * 32, I_UP = 16 * 128, I_DN = 64 * 32;
    constexpr int NITEMS = I_IN + I_UQ + I_UKV + 3 * I_O + I_OUT + I_UP + I_DN;
    for (int it = gw; it < NITEMS; it += ngw) {
        int r = it;
        if (r < I_IN) { conv_item(a->in[3] + (size_t)l * 1024 * 5792, 1024, 5792, (bf16_t*)(ws + W_IN), a->in[2] + l * 1024, 1, scr, r, lane); continue; } r -= I_IN;
        if (r < I_UQ) { conv_item(a->in[7] + (size_t)l * 256 * 768, 256, 768, (bf16_t*)(ws + W_UQ), a->in[5] + l * 256, 2, scr, r, lane); continue; } r -= I_UQ;
        if (r < I_UKV) { conv_item(a->in[8] + (size_t)l * 128 * 1024, 128, 1024, (bf16_t*)(ws + W_UKV), a->in[6] + l * 128, 3, scr, r, lane, 256); continue; } r -= I_UKV;
        if (r < I_O) { conv_item(a->in[10] + (size_t)l * 512 * 1024, 512, 1024, (bf16_t*)(ws + W_OA), nullptr, 0, scr, r, lane); continue; } r -= I_O;
        if (r < I_O) { conv_item(a->in[11] + (size_t)l * 512 * 1024, 512, 1024, (bf16_t*)(ws + W_OB), nullptr, 0, scr, r, lane); continue; } r -= I_O;
        if (r < I_O) { conv_item(a->in[12] + (size_t)l * 512 * 1024, 512, 1024, (bf16_t*)(ws + W_OC), nullptr, 0, scr, r, lane); continue; } r -= I_O;
        if (r < I_OUT) { conv_item(a->in[13] + (size_t)l * 1024 * 1024, 1024, 1024, (bf16_t*)(ws + W_OUT), nullptr, 0, scr, r, lane); continue; } r -= I_OUT;
        if (r < I_UP) { conv_item(a->in[16] + (size_t)l * 1024 * 4096, 1024, 4096, (bf16_t*)(ws + W_UP), a->in[15] + l * 1024, 0, scr, r, lane); continue; } r -= I_UP;
        conv_item(a->in[17] + (size_t)l * 4096 * 1024, 4096, 1024, (bf16_t*)(ws + W_DN), nullptr, 0, scr, r, lane);
    }
}

DI void row_update(const float* xin, float* xout, const float* Y, const float* ssq_y, const float* g, bf16_t* XB, float* ssq_out, int r, int lane) {
    const f32x4* xr = (const f32x4*)(xin + (size_t)r * DM) + lane;
    float ss = 0.f;
    float rs = 0.f;
    if (Y) { float p_ = ssq_y[(unsigned)r * 16 + (lane & 15)]; p_ += shx(p_, 1, lane); p_ += shx(p_, 2, lane); p_ += shx(p_, 4, lane); p_ += shx(p_, 8, lane); rs = fast_rsq(p_ * (1.f / DM) + EPS); }
#pragma unroll
    for (int j = 0; j < 4; ++j) {
        f32x4 v = xr[64 * j];
        if (Y) { const u32x2 yw = ((const u32x2*)((const bf16_t*)Y + (size_t)r * DM) + lane)[64 * j]; const f32x4 y = (f32x4){__uint_as_float(yw.x << 16), __uint_as_float(yw.x & 0xffff0000u), __uint_as_float(yw.y << 16), __uint_as_float(yw.y & 0xffff0000u)};
            const f32x4 gg = ((const f32x4*)g + lane)[64 * j]; v = v + y * rs * gg; ((f32x4*)(xout + (size_t)r * DM) + lane)[64 * j] = v; }
        ss += (v.x * v.x + v.y * v.y) + (v.z * v.z + v.w * v.w);
        ((u32x2*)(XB + (size_t)r * DM) + lane)[64 * j] = pack4(v.x, v.y, v.z, v.w);
    }
    ss = wave_sum(ss, lane);
    if (lane == 0) ssq_out[r] = ss;
}

#define EPI_ROWS _Pragma("unroll") for (int ai = 0; ai < 2; ++ai) _Pragma("unroll") for (int m = 0; m < 4; ++m, ({ asm volatile("" ::: "memory"); }))
#define EPI_GETV(v, sc) float v[8]; { const f32x4 a0_ = acc[ai][bj][m][0], a1_ = acc[ai][bj][m][1]; v[0] = a0_[0] * (sc); v[1] = a0_[1] * (sc); v[2] = a0_[2] * (sc); v[3] = a0_[3] * (sc); v[4] = a1_[0] * (sc); v[5] = a1_[1] * (sc); v[6] = a1_[2] * (sc); v[7] = a1_[3] * (sc); }
DI void rope8(const float* v, const float* tc, const float* ts, int r, int i0, int stride, float* o1, float* o2) {
#pragma unroll
    for (int e = 0; e < 4; ++e) { const float c = tc[(unsigned)(r * 32 + (i0 + e) * stride)], s = ts[(unsigned)(r * 32 + (i0 + e) * stride)]; o1[e] = v[e] * c - v[4 + e] * s; o2[e] = v[4 + e] * c + v[e] * s; }
}
DI void vt_scatter(bf16_t* vt, int nh, int r, int h, int d0, const float* v) {
    const int b = r >> 13, s = r & (SEQ - 1);
    const unsigned off = (unsigned)(((b * nh + h) * 64 + d0) * SEQ + s);
#pragma unroll
    for (int j = 0; j < 8; j += 2) { const unsigned w = cvt_pk_bf16(v[j], v[j + 1]); vt[off + (unsigned)(j * SEQ)] = (bf16_t)(w & 0xffffu); vt[off + (unsigned)((j + 1) * SEQ)] = (bf16_t)(w >> 16); asm volatile("" ::: "memory"); }
}
DI void ssq_row_put(float part, float* dst, int fr, int fq) {
    const int lane = fq * 16 + fr; part += shx(part, 16, lane); part += shx(part, 32, lane);
    if (fq == 0) *dst = part;
}

struct EpiIn {
    static constexpr bool PERM = true, AFTER_DRAIN = false;
    CArgsP a0; int l;
    DI void operator()(const f32x4 (&acc)[2][2][4][2], const Unit& u, int wr, int wc, int fr0, int fq0) const {
        asm volatile("s_waitcnt vmcnt(0)" ::: "memory");     unsigned ones_ = ~0u; asm volatile("" : "+s"(ones_)); const int lane_ = (int)__builtin_amdgcn_mbcnt_hi(ones_, __builtin_amdgcn_mbcnt_lo(ones_, 0u)); const int fr = lane_ & 15, fq = lane_ >> 4; (void)fr0; (void)fq0;
        CArgsP a = a0; asm volatile("" : "+s"(a));
        unsigned char* ws = a->ws; float* ctl = (float*)(ws + WS_CTL);
        const float* ssq_x = ctl + SS_X; float* ssq_cq = (float*)(ws + A_SSP) + SP_CQ; float* ssq_ckv = (float*)(ws + A_SSP) + SP_CKV;
        const float* bgate = a->in[4] + l * NGATE; const float* tc = (const float*)(ws + WS_TAB); const float* ts = tc + (size_t)MTOK * 32;
        bf16_t *cq = (bf16_t*)(ws + A_CQ), *ckv = (bf16_t*)(ws + A_CKV), *kpe = (bf16_t*)(ws + A_KPE), *qswa = (bf16_t*)(ws + A_QSWA), *kswa = (bf16_t*)(ws + A_KSWA), *vtswa = (bf16_t*)(ws + A_VTSWA),
               *qsb = (bf16_t*)(ws + A_QSB), *ksb = (bf16_t*)(ws + A_KSB), *vtsb = (bf16_t*)(ws + A_VTSB), *G = (bf16_t*)(ws + A_G);
        const int pn = u.pn;
        EPI_ROWS {
            const int r = u.pm * 256 + ai * 128 + wr * 64 + m * 16 + fr;
            const float rs = fast_rsq(ssq_x[r] * (1.f / DM) + EPS);
            if (pn == 0) {
                float part = 0.f;
#pragma unroll
                for (int bj = 0; bj < 2; ++bj) { EPI_GETV(v, rs);
#pragma unroll
                    for (int j = 0; j < 8; ++j) part += v[j] * v[j];
                    *(u32x4*)(cq + (unsigned)r * 256 + bj * 128 + wc * 32 + fq * 8) = pack8(v); }
                ssq_row_put(part, ssq_cq + (unsigned)r * 4 + wc, fr, fq);
            } else if (pn == 1) {
                float part = 0.f;
                { constexpr int bj = 0; EPI_GETV(v, rs);
#pragma unroll
                    for (int j = 0; j < 8; ++j) part += v[j] * v[j];
                    *(u32x4*)(ckv + (unsigned)r * 256 + wc * 32 + fq * 8) = pack8(v); *(u32x4*)(ckv + (unsigned)r * 256 + 128 + wc * 32 + fq * 8) = (u32x4){0u, 0u, 0u, 0u}; }
                ssq_row_put(part, ssq_ckv + (unsigned)r * 4 + wc, fr, fq);
                if (wc == 0) { constexpr int bj = 1; EPI_GETV(v, rs); float o1[4], o2[4]; rope8(v, tc, ts, r, 4 * fq, 2, o1, o2);
                    *(u32x2*)(kpe + (unsigned)r * 32 + 4 * fq) = pack4(o1[0], o1[1], o1[2], o1[3]); *(u32x2*)(kpe + (unsigned)r * 32 + 16 + 4 * fq) = pack4(o2[0], o2[1], o2[2], o2[3]); }
            } else if (pn <= 3) {
                const float sc = rs * (0.125f * LOG2E);
#pragma unroll
                for (int bj = 0; bj < 2; ++bj) { EPI_GETV(v, sc); const int head = (pn - 2) * 4 + bj * 2 + (wc >> 1), g = 4 * (wc & 1) + fq; float o1[4], o2[4]; rope8(v, tc, ts, r, 4 * g, 1, o1, o2);
                    bf16_t* p = qswa + (unsigned)r * 512 + head * 64 + 4 * g; *(u32x2*)p = pack4(o1[0], o1[1], o1[2], o1[3]); *(u32x2*)(p + 32) = pack4(o2[0], o2[1], o2[2], o2[3]); }
            } else if (pn == 4) {
                { constexpr int bj = 0; EPI_GETV(v, rs); const int kvh = wc >> 1, g = 4 * (wc & 1) + fq; float o1[4], o2[4]; rope8(v, tc, ts, r, 4 * g, 1, o1, o2);
                    bf16_t* p = kswa + (unsigned)r * 128 + kvh * 64 + 4 * g; *(u32x2*)p = pack4(o1[0], o1[1], o1[2], o1[3]); *(u32x2*)(p + 32) = pack4(o2[0], o2[1], o2[2], o2[3]); }
                { constexpr int bj = 1; EPI_GETV(v, rs); vt_scatter(vtswa, 2, r, wc >> 1, 32 * (wc & 1) + 8 * fq, v); }
            } else if (pn <= 6) {
                const float sc = rs * 0.125f;
#pragma unroll
                for (int bj = 0; bj < 2; ++bj) { EPI_GETV(v, sc); *(u32x4*)(qsb + (unsigned)r * 512 + (pn - 5) * 256 + bj * 128 + wc * 32 + fq * 8) = pack8(v); }
            } else if (pn <= 8) {
#pragma unroll
                for (int bj = 0; bj < 2; ++bj) { EPI_GETV(v, rs); *(u32x4*)(ksb + (unsigned)r * 512 + (pn - 7) * 256 + bj * 128 + wc * 32 + fq * 8) = pack8(v); }
            } else if (pn <= 10) {
#pragma unroll
                for (int bj = 0; bj < 2; ++bj) { EPI_GETV(v, rs); const int c = (pn - 9) * 256 + bj * 128 + wc * 32 + fq * 8; vt_scatter(vtsb, 8, r, c >> 6, c & 63, v); }
            } else {
#pragma unroll
                for (int bj = 0; bj < 2; ++bj) { EPI_GETV(v, rs); const int c = (pn - 11) * 256 + bj * 128 + wc * 32 + fq * 8;
                    const f32x4 b0 = *(const f32x4*)(bgate + c), b1 = *(const f32x4*)(bgate + c + 4); const float bb[8] = {b0[0], b0[1], b0[2], b0[3], b1[0], b1[1], b1[2], b1[3]};
#pragma unroll
                    for (int j = 0; j < 8; ++j) v[j] = __builtin_amdgcn_rcpf(1.f + __expf(-(v[j] + bb[j])));
                    *(u32x4*)(G + (unsigned)r * NGATE + c) = pack8(v); }
            }
        }
    }
};
struct EpiGate {
    static constexpr bool PERM = true, AFTER_DRAIN = false;
    CArgsP a0; int l;
    DI void operator()(const f32x4 (&acc)[2][2][4][2], const Unit& u, int wr, int wc, int fr0, int fq0) const {
        asm volatile("s_waitcnt vmcnt(0)" ::: "memory"); unsigned ones_ = ~0u; asm volatile("" : "+s"(ones_)); const int lane_ = (int)__builtin_amdgcn_mbcnt_hi(ones_, __builtin_amdgcn_mbcnt_lo(ones_, 0u)); const int fr = lane_ & 15, fq = lane_ >> 4; (void)fr0; (void)fq0;
        CArgsP a = a0; asm volatile("" : "+s"(a));
        unsigned char* ws = a->ws; const float* ssq_x = (const float*)(ws + WS_CTL) + SS_X; const float* bgate = a->in[4] + l * NGATE; bf16_t* G = (bf16_t*)(ws + A_G);
        EPI_ROWS {
            const int r = u.pm * 256 + ai * 128 + wr * 64 + m * 16 + fr;
            const float rs = fast_rsq(ssq_x[r] * (1.f / DM) + EPS);
#pragma unroll
            for (int bj = 0; bj < 2; ++bj) { EPI_GETV(v, rs); const int c = u.pn * 256 + bj * 128 + wc * 32 + fq * 8;
                const f32x4 b0 = *(const f32x4*)(bgate + c), b1 = *(const f32x4*)(bgate + c + 4); const float bb[8] = {b0[0], b0[1], b0[2], b0[3], b1[0], b1[1], b1[2], b1[3]};
#pragma unroll
                for (int j = 0; j < 8; ++j) v[j] = __builtin_amdgcn_rcpf(1.f + __expf(-(v[j] + bb[j])));
                *(u32x4*)(G + (unsigned)r * NGATE + c) = pack8(v); }
        }
    }
};
struct EpiUpQ {
    static constexpr bool PERM = true, AFTER_DRAIN = false;
    CArgsP a0; int l;
    DI void operator()(const f32x4 (&acc)[2][2][4][2], const Unit& u, int wr, int wc, int fr0, int fq0) const {
        asm volatile("s_waitcnt vmcnt(0)" ::: "memory");     unsigned ones_ = ~0u; asm volatile("" : "+s"(ones_)); const int lane_ = (int)__builtin_amdgcn_mbcnt_hi(ones_, __builtin_amdgcn_mbcnt_lo(ones_, 0u)); const int fr = lane_ & 15, fq = lane_ >> 4; (void)fr0; (void)fq0;
        CArgsP a = a0; asm volatile("" : "+s"(a));
        unsigned char* ws = a->ws; const float* ssq_cq = (const float*)(ws + A_SSP) + SP_CQ;
        const float* tc = (const float*)(ws + WS_TAB); const float* ts = tc + (size_t)MTOK * 32; bf16_t* qm = (bf16_t*)(ws + A_QMLA);
        const int pn = u.pn;
        EPI_ROWS {
            const int r = u.pm * 256 + ai * 128 + wr * 64 + m * 16 + fr; const int b = r >> 13, s = r & (SEQ - 1);
            const f32x4 pq_ = *(const f32x4*)(ssq_cq + (unsigned)r * 4); const float sc = fast_rsq(((pq_[0] + pq_[1]) + (pq_[2] + pq_[3])) * (1.f / 256) + EPS) * (0.10206207261596577f * LOG2E);
#pragma unroll
            for (int bj = 0; bj < 2; ++bj) { EPI_GETV(v, sc);
                if (pn < 2) { const int c = pn * 256 + bj * 128 + wc * 32 + fq * 8; *(u32x4*)(qm + (unsigned)(((b * 8 + (c >> 6)) * SEQ + s) * 96 + (c & 63))) = pack8(v); }
                else { const int h = bj * 4 + wc; float o1[4], o2[4]; rope8(v, tc, ts, r, 4 * fq, 2, o1, o2); bf16_t* p = qm + (unsigned)(((b * 8 + h) * SEQ + s) * 96 + 64 + 4 * fq);
                    *(u32x2*)p = pack4(o1[0], o1[1], o1[2], o1[3]); *(u32x2*)(p + 16) = pack4(o2[0], o2[1], o2[2], o2[3]); }
            }
        }
    }
};
struct EpiUpKV {
    static constexpr bool PERM = true, AFTER_DRAIN = false;
    CArgsP a0; int l;
    DI void operator()(const f32x4 (&acc)[2][2][4][2], const Unit& u, int wr, int wc, int fr0, int fq0) const {
        asm volatile("s_waitcnt vmcnt(0)" ::: "memory");     unsigned ones_ = ~0u; asm volatile("" : "+s"(ones_)); const int lane_ = (int)__builtin_amdgcn_mbcnt_hi(ones_, __builtin_amdgcn_mbcnt_lo(ones_, 0u)); const int fr = lane_ & 15, fq = lane_ >> 4; (void)fr0; (void)fq0;
        CArgsP a = a0; asm volatile("" : "+s"(a));
        unsigned char* ws = a->ws; const float* ssq_ckv = (const float*)(ws + A_SSP) + SP_CKV; bf16_t* knope = (bf16_t*)(ws + A_KNOPE); bf16_t* vt = (bf16_t*)(ws + A_VTMLA);
        const int pn = u.pn;
        EPI_ROWS {
            const int r = u.pm * 256 + ai * 128 + wr * 64 + m * 16 + fr;
            const f32x4 pk_ = *(const f32x4*)(ssq_ckv + (unsigned)r * 4); const float rs = fast_rsq(((pk_[0] + pk_[1]) + (pk_[2] + pk_[3])) * (1.f / 128) + EPS);
#pragma unroll
            for (int bj = 0; bj < 2; ++bj) { EPI_GETV(v, rs);
                if (pn < 2) *(u32x4*)(knope + (unsigned)r * 512 + pn * 256 + bj * 128 + wc * 32 + fq * 8) = pack8(v);
                else { const int c = (pn - 2) * 256 + bj * 128 + wc * 32 + fq * 8; vt_scatter(vt, 8, r, c >> 6, c & 63, v); }
            }
        }
    }
};
struct EpiBranch {
    static constexpr bool PERM = true, AFTER_DRAIN = false;
    CArgsP a0; int br;
    DI void operator()(const f32x4 (&acc)[2][2][4][2], const Unit& u, int wr, int wc, int fr0, int fq0) const {
        asm volatile("s_waitcnt vmcnt(0)" ::: "memory");     unsigned ones_ = ~0u; asm volatile("" : "+s"(ones_)); const int lane_ = (int)__builtin_amdgcn_mbcnt_hi(ones_, __builtin_amdgcn_mbcnt_lo(ones_, 0u)); const int fr = lane_ & 15, fq = lane_ >> 4; (void)fr0; (void)fq0;
        CArgsP a = a0; asm volatile("" : "+s"(a));
        bf16_t* R = (bf16_t*)(a->ws + A_MIXED) + (size_t)br * MTOK * DM;
        EPI_ROWS {
            const int r = u.pm * 256 + ai * 128 + wr * 64 + m * 16 + fr;
#pragma unroll
            for (int bj = 0; bj < 2; ++bj) { EPI_GETV(v, 1.f); *(u32x4*)(R + (unsigned)r * DM + u.pn * 256 + bj * 128 + wc * 32 + fq * 8) = pack8(v); }
        }
    }
};
struct EpiY {
    static constexpr bool PERM = true, AFTER_DRAIN = false;
    CArgsP a0; int l, second;
    DI void operator()(const f32x4 (&acc)[2][2][4][2], const Unit& u, int wr, int wc, int fr0, int fq0) const {
        asm volatile("s_waitcnt vmcnt(0)" ::: "memory");     unsigned ones_ = ~0u; asm volatile("" : "+s"(ones_)); const int lane_ = (int)__builtin_amdgcn_mbcnt_hi(ones_, __builtin_amdgcn_mbcnt_lo(ones_, 0u)); const int fr = lane_ & 15, fq = lane_ >> 4; (void)fr0; (void)fq0;
        CArgsP a = a0; asm volatile("" : "+s"(a));
        unsigned char* ws = a->ws; float* Y = (float*)(ws + (second ? A_Y2 : A_Y)); float* ssq = (float*)(ws + A_SSP) + (second ? SP_Y2 : SP_Y);
        EPI_ROWS {
            const int r = u.pm * 256 + ai * 128 + wr * 64 + m * 16 + fr; float part = 0.f;
#pragma unroll
            for (int bj = 0; bj < 2; ++bj) { const int c = u.pn * 256 + bj * 128 + wc * 32 + fq * 8; const f32x4 a0 = acc[ai][bj][m][0], a1 = acc[ai][bj][m][1];
                part += (a0[0] * a0[0] + a0[1] * a0[1]) + (a0[2] * a0[2] + a0[3] * a0[3]) + (a1[0] * a1[0] + a1[1] * a1[1]) + (a1[2] * a1[2] + a1[3] * a1[3]);
                { const float yv_[8] = {a0[0] * 1.f, a0[1] * 1.f, a0[2] * 1.f, a0[3] * 1.f, a1[0] * 1.f, a1[1] * 1.f, a1[2] * 1.f, a1[3] * 1.f}; *(u32x4*)((bf16_t*)Y + (unsigned)r * DM + c) = pack8(yv_); } }
            ssq_row_put(part, ssq + (unsigned)r * 16 + u.pn * 4 + wc, fr, fq);
        }
    }
};
struct EpiUp {
    static constexpr bool PERM = true, AFTER_DRAIN = false;
    CArgsP a0;
    DI void operator()(const f32x4 (&acc)[2][2][4][2], const Unit& u, int wr, int wc, int fr0, int fq0) const {
        asm volatile("s_waitcnt vmcnt(0)" ::: "memory");     unsigned ones_ = ~0u; asm volatile("" : "+s"(ones_)); const int lane_ = (int)__builtin_amdgcn_mbcnt_hi(ones_, __builtin_amdgcn_mbcnt_lo(ones_, 0u)); const int fr = lane_ & 15, fq = lane_ >> 4; (void)fr0; (void)fq0;
        CArgsP a = a0; asm volatile("" : "+s"(a));
        unsigned char* ws = a->ws; const float* ssq_x1 = (const float*)(ws + WS_CTL) + SS_X1; bf16_t* U = (bf16_t*)(ws + A_U);
        EPI_ROWS {
            const int r = u.pm * 256 + ai * 128 + wr * 64 + m * 16 + fr;
            const float rs = fast_rsq(ssq_x1[r] * (1.f / DM) + EPS);
#pragma unroll
            for (int bj = 0; bj < 2; ++bj) { EPI_GETV(v, rs);
#pragma unroll
                for (int j = 0; j < 8; ++j) { const float t = fmaxf(v[j], 0.f); v[j] = t * t; }
                *(u32x4*)(U + (unsigned)r * FF + u.pn * 256 + bj * 128 + wc * 32 + fq * 8) = pack8(v); }
        }
    }
};

constexpr int KROW = 208, VROW = 136, KS_BYTES = 64 * KROW, VS_BYTES = 64 * VROW, AT_FLAGS = 2 * KS_BYTES + 2 * VS_BYTES;
DI int crow(int reg, int h) { return (reg & 3) + 8 * (reg >> 2) + 4 * h; }
DI bf16x8 pack_frag(const f32x16& x, int s) {
    u32x4 p; p.x = cvt_pk_bf16(x[8 * s], x[8 * s + 1]); p.y = cvt_pk_bf16(x[8 * s + 2], x[8 * s + 3]); p.z = cvt_pk_bf16(x[8 * s + 4], x[8 * s + 5]); p.w = cvt_pk_bf16(x[8 * s + 6], x[8 * s + 7]);
    return __builtin_bit_cast(bf16x8, p);
}
DI void sb_group(f32x16& s, float& carry, int key_base, int q_abs, int h, int lane) {
    float L[16];
#pragma unroll
    for (int i = 0; i < 16; ++i) { const float z = s[i]; const float sp = fmaxf(z, 0.f) + __logf(1.f + __expf(-fabsf(z))); L[i] = (key_base + crow(i, h) < q_abs) ? -sp : 0.f; }
    float cs[4], pc[4];
#pragma unroll
    for (int c = 0; c < 4; ++c) { cs[c] = (L[4 * c] + L[4 * c + 1]) + (L[4 * c + 2] + L[4 * c + 3]); pc[c] = shx(cs[c], 32, lane); }
    float run = carry;
#pragma unroll
    for (int c = 3; c >= 0; --c) {
        float t = (h == 0) ? run + pc[c] : run;
#pragma unroll
        for (int e = 3; e >= 0; --e) { const int i = 4 * c + e; const bool before = key_base + crow(i, h) < q_abs; const float a = __expf(L[i] + s[i] + t); t += L[i]; s[i] = before ? a : 0.f; }
        run += cs[c] + pc[c];
    }
    carry = run;
}
template <int MODE>
DI void attn_unit(LAS unsigned char* lds, const bf16_t* Qp, int qpitch, const bf16_t* Kp, int kpitch, const bf16_t* Kpe, const bf16_t* Vt, bf16_t* Op, int qb, float sink2, int tid) {
    constexpr int NK = MODE == 0 ? 6 : 4;
    const int lane = tid & 63, wave = tid >> 6, r32 = lane & 31, h = lane >> 5;
    const int row0 = qb * 256 + wave * 32, q_abs = row0 + r32;
    bf16x8 qf[NK];
#pragma unroll
    for (int kk = 0; kk < NK; ++kk) qf[kk] = *(const bf16x8*)(Qp + (size_t)q_abs * qpitch + 16 * kk + 8 * h);
    const int jt_hi = 4 * qb + 3, jt_lo = (MODE == 1) ? (4 * qb - 2 > 0 ? 4 * qb - 2 : 0) : 0, nT = jt_hi - jt_lo + 1;
    f32x16 o0, o1;
#pragma unroll
    for (int i = 0; i < 16; ++i) { o0[i] = 0.f; o1[i] = 0.f; }
    float mrun = (MODE == 1) ? sink2 : -1e30f, lrun = (MODE == 1 && h == 0) ? 1.f : 0.f, carry = 0.f;
    bool wdone = false;
    LAS unsigned* flags = (LAS unsigned*)(lds + AT_FLAGS);
    const int kkey = tid >> 3, kch = tid & 7, pkey = tid >> 2, pch = tid & 3;
    u32x4 kreg, vreg, preg;
    auto issue = [&](int jt) {
        kreg = *(const u32x4*)(Kp + (size_t)(64 * jt + kkey) * kpitch + kch * 8);
        vreg = *(const u32x4*)(Vt + (size_t)kkey * SEQ + 64 * jt + kch * 8);
        if (MODE == 0 && tid < 256) preg = *(const u32x4*)(Kpe + (size_t)(64 * jt + pkey) * 32 + pch * 8);
    };
    auto commit = [&](int buf) {
        *(LAS u32x4*)(lds + buf * KS_BYTES + kkey * KROW + kch * 16) = kreg;
        LAS u32x2* vp = (LAS u32x2*)(lds + 2 * KS_BYTES + buf * VS_BYTES + kkey * VROW + kch * 16); vp[0] = (u32x2){vreg.x, vreg.y}; vp[1] = (u32x2){vreg.z, vreg.w};
        if (MODE == 0 && tid < 256) *(LAS u32x4*)(lds + buf * KS_BYTES + pkey * KROW + 128 + pch * 16) = preg;
    };
    __syncthreads();
    issue(MODE == 2 ? jt_hi : jt_lo); commit(0);
    __syncthreads();
    for (int it = 0; it < nT; ++it) {
        const int jt = (MODE == 2) ? jt_hi - it : jt_lo + it, buf = it & 1;
        const bool more = it + 1 < nT;
        if (more) issue(MODE == 2 ? jt - 1 : jt + 1);
        bool active = (64 * jt <= row0 + 31);
        if (MODE == 1) active = active && (64 * jt + 63 >= row0 - 127);
        if (MODE == 2) active = active && !wdone;
        if (active) {
            const LAS unsigned char* ks = lds + buf * KS_BYTES; const LAS unsigned char* vs = lds + 2 * KS_BYTES + buf * VS_BYTES;
            f32x16 s0, s1;
#pragma unroll
            for (int i = 0; i < 16; ++i) { s0[i] = 0.f; s1[i] = 0.f; }
#pragma unroll
            for (int kk = 0; kk < NK; ++kk) {
                const bf16x8 a0 = *(const LAS bf16x8*)(ks + r32 * KROW + (16 * kk + 8 * h) * 2);
                const bf16x8 a1 = *(const LAS bf16x8*)(ks + (32 + r32) * KROW + (16 * kk + 8 * h) * 2);
                s0 = MFMA32(a0, qf[kk], s0); s1 = MFMA32(a1, qf[kk], s1);
            }
            const int kb0 = 64 * jt;
            if (MODE == 2) {
                sb_group(s1, carry, kb0 + 32, q_abs, h, lane);
                sb_group(s0, carry, kb0, q_abs, h, lane);
            } else {
                const bool need_mask = (MODE == 1) || (kb0 + 63 > row0);
                if (need_mask) {
#pragma unroll
                    for (int i = 0; i < 16; ++i) { const int k0 = kb0 + crow(i, h), k1 = k0 + 32;
                        bool v0 = k0 <= q_abs, v1 = k1 <= q_abs;
                        if (MODE == 1) { v0 = v0 && (q_abs - k0 < 128); v1 = v1 && (q_abs - k1 < 128); }
                        s0[i] = v0 ? s0[i] : -1e30f; s1[i] = v1 ? s1[i] : -1e30f; }
                }
                float mx = -1e30f;
#pragma unroll
                for (int i = 0; i < 16; ++i) mx = fmaxf(mx, fmaxf(s0[i], s1[i]));
                mx = fmaxf(mx, shx(mx, 32, lane));
                const float mnew = fmaxf(mrun, mx), alpha = __builtin_amdgcn_exp2f(mrun - mnew);
                float ls = 0.f;
#pragma unroll
                for (int i = 0; i < 16; ++i) { s0[i] = __builtin_amdgcn_exp2f(s0[i] - mnew); s1[i] = __builtin_amdgcn_exp2f(s1[i] - mnew); ls += s0[i] + s1[i]; }
                lrun = lrun * alpha + ls; mrun = mnew;
#pragma unroll
                for (int i = 0; i < 16; ++i) { o0[i] *= alpha; o1[i] *= alpha; }
            }
#pragma unroll
            for (int g = 0; g < 2; ++g)
#pragma unroll
                for (int s = 0; s < 2; ++s) {
                    const bf16x8 pf = pack_frag(g == 0 ? s0 : s1, s);
                    const int kofs = (32 * g + 16 * s + 4 * h) * 2;
                    { const s16x4 lo = *(const LAS s16x4*)(vs + r32 * VROW + kofs), hi = *(const LAS s16x4*)(vs + r32 * VROW + kofs + 16);
                      o0 = MFMA32(__builtin_shufflevector(lo, hi, 0, 1, 2, 3, 4, 5, 6, 7), pf, o0); }
                    { const s16x4 lo = *(const LAS s16x4*)(vs + (32 + r32) * VROW + kofs), hi = *(const LAS s16x4*)(vs + (32 + r32) * VROW + kofs + 16);
                      o1 = MFMA32(__builtin_shufflevector(lo, hi, 0, 1, 2, 3, 4, 5, 6, 7), pf, o1); }
                }
            if (MODE == 2) wdone = __all(carry < -88.f);
        }
        if (more) commit(buf ^ 1);
        if (MODE == 2 && lane == 0) flags[(it & 1) * 8 + wave] = wdone ? 1u : 0u;
        __syncthreads();
        if (MODE == 2) { unsigned all = 1u;
#pragma unroll
            for (int w = 0; w < 8; ++w) all &= flags[(it & 1) * 8 + w];
            if (all) break; }
    }
    if (MODE != 2) { const float l = lrun + shx(lrun, 32, lane); const float inv = 1.f / l;
#pragma unroll
        for (int i = 0; i < 16; ++i) { o0[i] *= inv; o1[i] *= inv; } }
    bf16_t* orow = Op + (size_t)q_abs * 512;
#pragma unroll
    for (int c = 0; c < 4; ++c) {
        *(u32x2*)(orow + 8 * c + 4 * h) = pack4(o0[4 * c], o0[4 * c + 1], o0[4 * c + 2], o0[4 * c + 3]);
        *(u32x2*)(orow + 32 + 8 * c + 4 * h) = pack4(o1[4 * c], o1[4 * c + 1], o1[4 * c + 2], o1[4 * c + 3]);
    }
}

struct RoundOrder {
    pg8::StaticOrder S; int rnd;
    DI bool next(int i, Unit& u) const { return i == 0 ? S.next(rnd, u) : false; }
    DI void a_ready(const Unit&) const {}
    DI void done(const Unit&) const {}
};
template <int N, class Epi>
DI void run_gemm_n(LAS unsigned char* lds, int tid, int G, int bx, const bf16_t* A, const bf16_t* Bt, int K, const Epi& E) {
    pg8::Gemm g{A, Bt, MTOK, N, K};
    constexpr int nwg = (MTOK / 256) * (N / 256), NR = (nwg + 255) / 256;
    if constexpr (N == FF || N == NGATE) {
        pg8::StaticOrder S; S.init(MTOK, N, G, bx);
        pg8::gemm_phase<Epi, pg8::StaticOrder, true, true>(lds, g, S, E, tid);
    } else {
#pragma unroll
        for (int rnd = 0; rnd < NR; ++rnd) { RoundOrder R; R.S.init(MTOK, N, G, bx); R.rnd = rnd; pg8::gemm_phase<Epi, RoundOrder, false, true>(lds, g, R, E, tid); }
    }
}
#define run_gemm(lds, tid, G, bx, A, Bt, N, K, E) run_gemm_n<N>(lds, tid, G, bx, A, Bt, K, E)

template <int PH>
DI void do_phase(LAS unsigned char* lds, int wave_s) {
    constexpr int ph = PH;
    {
        CArgsP a = (CArgsP)__builtin_amdgcn_kernarg_segment_ptr(); asm volatile("" : "+s"(a));
        unsigned char* ws = a->ws;
        float* ctl = (float*)(ws + WS_CTL);
        const float* tc = (const float*)(ws + WS_TAB); const float* ts = tc + (size_t)MTOK * 32;
        bf16_t* XB = (bf16_t*)(ws + WS_XB);
        int G = gridDim.x, bx = blockIdx.x; unsigned ones = ~0u; asm volatile("" : "+s"(G), "+s"(bx), "+s"(ones));
        const int vcu = (G % 8 == 0) ? (bx % 8) * (G / 8) + bx / 8 : bx;
        int tid = wave_s * 64 + (int)__builtin_amdgcn_mbcnt_hi(ones, __builtin_amdgcn_mbcnt_lo(ones, 0u)); asm volatile("" : "+v"(tid));
        const int lane = tid & 63, wave = __builtin_amdgcn_readfirstlane(tid >> 6);
        const int gw = vcu * 8 + wave, ngw = G * 8;
        if (ph == 0) {
#if (PHMASK & 1)
            { u32x4* z = (u32x4*)((bf16_t*)(ws + W_IN) + (size_t)416 * 1024); for (int i = bx * NTHR + tid; i < 96 * 1024 * 2 / 16; i += G * NTHR) z[i] = (u32x4){0u, 0u, 0u, 0u}; }
            { unsigned char* z = ws + W_UKV; for (int i = bx * NTHR + tid; i < 1024 * 16; i += G * NTHR) *(u32x4*)(z + (size_t)(i >> 4) * 512 + 256 + (i & 15) * 16) = (u32x4){0u, 0u, 0u, 0u}; }
            for (int i = bx * NTHR + tid; i < (int)(BAR_BYTES / 4); i += G * NTHR) ((unsigned*)(ws + WS_BAR))[i] = 0u;
            for (int i = bx * NTHR + tid; i < MTOK * 32; i += G * NTHR) {
                const int r = i >> 5, k = i & 31;
                const float inv = ROPE_INV[k];
                const float ang = (float)a->pos[r] * inv;
                double rev = (double)ang * 0.15915494309189535; rev -= floor(rev);
                const float fr = (float)rev;
                ((float*)(ws + WS_TAB))[i] = __builtin_amdgcn_cosf(fr); ((float*)(ws + WS_TAB))[(size_t)MTOK * 32 + i] = __builtin_amdgcn_sinf(fr);
            }
            for (int r = gw; r < MTOK; r += ngw) row_update(a->in[0], nullptr, nullptr, nullptr, nullptr, XB, ctl + SS_X, r, lane);
            conv_layer(a, 0, lds, gw, ngw, wave, lane);
#endif
        } else {
            const int l = (ph - 1) / NPH_LAYER, sp = (ph - 1) % NPH_LAYER;
            const float* ssq_y = (const float*)(ws + A_SSP) + SP_Y; const float* ssq_y2 = (const float*)(ws + A_SSP) + SP_Y2;
            if (sp == 0) {
#if (PHMASK & 2)
                { EpiIn E{a, l}; run_gemm(lds, tid, G, bx, XB, (const bf16_t*)(ws + W_IN), 2816, 1024, E); }
                { EpiGate E{a, l}; run_gemm(lds, tid, G, bx, XB, (const bf16_t*)(ws + W_IN) + (size_t)2816 * 1024, NGATE, 1024, E); }
#endif
            } else if (sp == 1) {
#if (PHMASK & 4)
                { EpiUpQ E{a, l}; run_gemm(lds, tid, G, bx, (const bf16_t*)(ws + A_CQ), (const bf16_t*)(ws + W_UQ), 768, 256, E); }
                { EpiUpKV E{a, l}; run_gemm(lds, tid, G, bx, (const bf16_t*)(ws + A_CKV), (const bf16_t*)(ws + W_UKV), 1024, 256, E); }
#endif
            } else if (sp == 2) {
#if (PHMASK & 8)
                for (int w = vcu; w < 256; w += G) {
                    const int bh = w >> 4, sx = w & 15, b = bh >> 3, h = bh & 7;
                    const bf16_t* qm = (const bf16_t*)(ws + A_QMLA) + (size_t)bh * SEQ * 96;
                    const bf16_t* kn = (const bf16_t*)(ws + A_KNOPE) + (size_t)b * SEQ * 512 + h * 64;
                    const bf16_t* kp = (const bf16_t*)(ws + A_KPE) + (size_t)b * SEQ * 32;
                    const bf16_t* vm = (const bf16_t*)(ws + A_VTMLA) + (size_t)bh * 64 * SEQ;
                    bf16_t* om = (bf16_t*)(ws + A_OMLA) + (size_t)b * SEQ * 512 + h * 64;
                    attn_unit<0>(lds, qm, 96, kn, 512, kp, vm, om, 31 - sx, 0.f, tid);
                    attn_unit<0>(lds, qm, 96, kn, 512, kp, vm, om, sx, 0.f, tid);
                    bf16_t* qs = (bf16_t*)(ws + A_QSWA) + (size_t)b * SEQ * 512 + h * 64;
                    const bf16_t* ksw = (const bf16_t*)(ws + A_KSWA) + (size_t)b * SEQ * 128 + (h >> 2) * 64;
                    const bf16_t* vsw = (const bf16_t*)(ws + A_VTSWA) + (size_t)(b * 2 + (h >> 2)) * 64 * SEQ;
                    const float sink2 = a->in[9][l * 8 + h] * LOG2E;
                    attn_unit<1>(lds, qs, 512, ksw, 128, nullptr, vsw, qs, 2 * sx, sink2, tid);
                    attn_unit<1>(lds, qs, 512, ksw, 128, nullptr, vsw, qs, 2 * sx + 1, sink2, tid);
                    bf16_t* qb_ = (bf16_t*)(ws + A_QSB) + (size_t)b * SEQ * 512 + h * 64;
                    const bf16_t* kb_ = (const bf16_t*)(ws + A_KSB) + (size_t)b * SEQ * 512 + h * 64;
                    const bf16_t* vb_ = (const bf16_t*)(ws + A_VTSB) + (size_t)bh * 64 * SEQ;
                    attn_unit<2>(lds, qb_, 512, kb_, 512, nullptr, vb_, qb_, 2 * sx, 0.f, tid);
                    attn_unit<2>(lds, qb_, 512, kb_, 512, nullptr, vb_, qb_, 2 * sx + 1, 0.f, tid);
                }
#endif
            } else if (sp == 3) {
#if (PHMASK & 16)
                for (int br = 0; br < 3; ++br) {
                    EpiBranch E{a, br};
                    const bf16_t* A = br == 0 ? (const bf16_t*)(ws + A_OMLA) : br == 1 ? (const bf16_t*)(ws + A_QSWA) : (const bf16_t*)(ws + A_QSB);
                    run_gemm(lds, tid, G, bx, A, (const bf16_t*)(ws + W_OA) + (size_t)br * 1024 * 512, 1024, 512, E);
                }
                {
                    __builtin_amdgcn_fence(__ATOMIC_ACQUIRE, "agent");
                    pg8::StaticOrder S; S.init(MTOK, 1024, G, bx); Unit u;
                    if (S.next(0, u)) {
                        const bf16_t* Gp = (const bf16_t*)(ws + A_G); bf16_t* R = (bf16_t*)(ws + A_MIXED);
                        for (int i = tid; i < 256 * 32; i += NTHR) {
                            const int r = u.pm * 256 + (i >> 5), c = u.pn * 256 + (i & 31) * 8; const unsigned off = (unsigned)r * DM + c;
                            float acc8[8] = {0.f, 0.f, 0.f, 0.f, 0.f, 0.f, 0.f, 0.f};
#pragma unroll
                            for (int b3 = 0; b3 < 3; ++b3) {
                                const u32x4 gw = *(const u32x4*)(Gp + (unsigned)r * NGATE + b3 * 1024 + c), rw = *(const u32x4*)(R + (size_t)b3 * MTOK * DM + off);
                                acc8[0] += __uint_as_float(gw.x << 16) * __uint_as_float(rw.x << 16); acc8[1] += __uint_as_float(gw.x & 0xffff0000u) * __uint_as_float(rw.x & 0xffff0000u);
                                acc8[2] += __uint_as_float(gw.y << 16) * __uint_as_float(rw.y << 16); acc8[3] += __uint_as_float(gw.y & 0xffff0000u) * __uint_as_float(rw.y & 0xffff0000u);
                                acc8[4] += __uint_as_float(gw.z << 16) * __uint_as_float(rw.z << 16); acc8[5] += __uint_as_float(gw.z & 0xffff0000u) * __uint_as_float(rw.z & 0xffff0000u);
                                acc8[6] += __uint_as_float(gw.w << 16) * __uint_as_float(rw.w << 16); acc8[7] += __uint_as_float(gw.w & 0xffff0000u) * __uint_as_float(rw.w & 0xffff0000u);
                            }
                            *(u32x4*)(R + off) = pack8(acc8);
                        }
                    }
                }
#endif
            } else if (sp == 4) {
#if 0
                const bf16_t* Gp = (const bf16_t*)(ws + A_G); bf16_t* R = (bf16_t*)(ws + A_MIXED);
                for (int i = bx * NTHR + tid; i < MTOK * DM / 8; i += G * NTHR) {
                    const int r = i >> 7, c = (i & 127) * 8; const unsigned off = (unsigned)r * DM + c;
                    float acc8[8] = {0.f, 0.f, 0.f, 0.f, 0.f, 0.f, 0.f, 0.f};
#pragma unroll
                    for (int b3 = 0; b3 < 3; ++b3) {
                        const u32x4 gw = *(const u32x4*)(Gp + (unsigned)r * NGATE + b3 * 1024 + c), rw = *(const u32x4*)(R + (size_t)b3 * MTOK * DM + off);
                        acc8[0] += __uint_as_float(gw.x << 16) * __uint_as_float(rw.x << 16); acc8[1] += __uint_as_float(gw.x & 0xffff0000u) * __uint_as_float(rw.x & 0xffff0000u);
                        acc8[2] += __uint_as_float(gw.y << 16) * __uint_as_float(rw.y << 16); acc8[3] += __uint_as_float(gw.y & 0xffff0000u) * __uint_as_float(rw.y & 0xffff0000u);
                        acc8[4] += __uint_as_float(gw.z << 16) * __uint_as_float(rw.z << 16); acc8[5] += __uint_as_float(gw.z & 0xffff0000u) * __uint_as_float(rw.z & 0xffff0000u);
                        acc8[6] += __uint_as_float(gw.w << 16) * __uint_as_float(rw.w << 16); acc8[7] += __uint_as_float(gw.w & 0xffff0000u) * __uint_as_float(rw.w & 0xffff0000u);
                    }
                    *(u32x4*)(R + off) = pack8(acc8);
                }
#endif
            } else if (sp == 5 || sp == 8) {
#if (PHMASK & 32)
                EpiY E{a, l, sp == 5 ? 0 : 1};
                if (sp == 5) run_gemm(lds, tid, G, bx, (const bf16_t*)(ws + A_MIXEDB), (const bf16_t*)(ws + W_OUT), 1024, 1024, E);
                else run_gemm(lds, tid, G, bx, (const bf16_t*)(ws + A_U), (const bf16_t*)(ws + W_DN), 1024, 4096, E);
#endif
            } else if (sp == 6 || sp == 9) {
#if (PHMASK & 64)
                const float* xin = (sp == 6 && l == 0) ? a->in[0] : a->out;
                const float* Y = (const float*)(ws + (sp == 6 ? A_Y : A_Y2));
                const float* gpost = (sp == 6 ? a->in[14] : a->in[18]) + l * DM;
                for (int r = gw; r < MTOK; r += ngw) row_update(xin, a->out, Y, sp == 6 ? ssq_y : ssq_y2, gpost, XB, ctl + (sp == 6 ? SS_X1 : SS_X), r, lane);
                if (sp == 9 && l + 1 < DEPTH) conv_layer(a, l + 1, lds, gw, ngw, wave, lane);
#endif
            } else if (sp == 7) {
#if (PHMASK & 128)
                EpiUp E{a};
                run_gemm(lds, tid, G, bx, XB, (const bf16_t*)(ws + W_UP), FF, 1024, E);
#endif
            }
        }
    }
}

__global__ void __launch_bounds__(NTHR, 2) mk_fwd(Args a_) {
    extern __shared__ __attribute__((aligned(16))) unsigned char lds_raw[];
    LAS unsigned char* lds = (LAS unsigned char*)lds_raw;
    cg::grid_group grid = cg::this_grid();
    const int ph_lo = a_.ph_lo, ph_hi = a_.ph_hi;
    const int wave_s = __builtin_amdgcn_readfirstlane(threadIdx.x >> 6);
    static_assert(NPHASES == 41, "phase list below");
#define SEAM(P) do { if ((P) == 0 || gridDim.x != 256) grid.sync(); else { unsigned o_ = ~0u; int bx_ = blockIdx.x; asm volatile("" : "+s"(o_), "+s"(bx_)); const int t_ = wave_s * 64 + (int)__builtin_amdgcn_mbcnt_hi(o_, __builtin_amdgcn_mbcnt_lo(o_, 0u)); ms::grid_sync((unsigned*)(a_.ws + WS_BAR), t_, bx_, (unsigned)(P) + 1u); } } while (0)
#define RUN_PH(P) if (!((P) > 0 && ((P) - 1) % NPH_LAYER == 4) && ph_lo <= (P) && (P) < ph_hi) { do_phase<P>(lds, wave_s); if ((P) + 1 < ph_hi) SEAM(P); }
    RUN_PH(0)
    RUN_PH(1)
    RUN_PH(2)
    RUN_PH(3)
    RUN_PH(4)
    RUN_PH(5)
    RUN_PH(6)
    RUN_PH(7)
    RUN_PH(8)
    RUN_PH(9)
    RUN_PH(10)
    RUN_PH(11)
    RUN_PH(12)
    RUN_PH(13)
    RUN_PH(14)
    RUN_PH(15)
    RUN_PH(16)
    RUN_PH(17)
    RUN_PH(18)
    RUN_PH(19)
    RUN_PH(20)
    RUN_PH(21)
    RUN_PH(22)
    RUN_PH(23)
    RUN_PH(24)
    RUN_PH(25)
    RUN_PH(26)
    RUN_PH(27)
    RUN_PH(28)
    RUN_PH(29)
    RUN_PH(30)
    RUN_PH(31)
    RUN_PH(32)
    RUN_PH(33)
    RUN_PH(34)
    RUN_PH(35)
    RUN_PH(36)
    RUN_PH(37)
    RUN_PH(38)
    RUN_PH(39)
    RUN_PH(40)
#undef RUN_PH
#undef SEAM
}

#ifdef DBG_STOP
__global__ void dbg_dump(const unsigned short* ws16, float* out) {
    const size_t i = (size_t)blockIdx.x * blockDim.x + threadIdx.x;
    if (i >= (size_t)MTOK * DM) return;
    float acc = 0.f;
#ifdef DBG_OFF
#ifdef DBG_F32
    acc = ((const float*)ws16)[(size_t)(DBG_OFF) / 4 + i];
#else
    { const unsigned short w = ws16[(size_t)(DBG_OFF) / 2 + i]; acc = __uint_as_float((unsigned)w << 16); }
#endif
#else
    const size_t base = WS_XB / 2, total = (WS_END - WS_XB) / 2;
    for (size_t o = i; o < total; o += (size_t)MTOK * DM) { const unsigned short w = ws16[base + o]; if (((w >> 7) & 0xff) != 0xff) acc += __uint_as_float((unsigned)w << 16); }
#endif
    out[i] = acc;
}
#endif
}

extern "C" void kernel_launch(void* const* d_in, const int* in_sizes, int n_in, void* d_out, int out_size, void* d_ws, size_t ws_size, hipStream_t stream) {
    using namespace mk;
    static int grid = 0;
    if (grid == 0) {
        if (n_in != 19 || out_size != MTOK * DM || ws_size < WS_END) { fprintf(stderr, "kernel_launch: unexpected shapes (n_in %d, out %d, ws %zu < %zu)\n", n_in, out_size, ws_size, (size_t)WS_END); grid = -1; return; }
        int dev = 0, cus = 0, per_cu = 0;
        (void)hipGetDevice(&dev); (void)hipDeviceGetAttribute(&cus, hipDeviceAttributeMultiprocessorCount, dev);
        (void)hipFuncSetAttribute((const void*)mk_fwd, hipFuncAttributeMaxDynamicSharedMemorySize, LDS_BYTES);
        if (hipOccupancyMaxActiveBlocksPerMultiprocessor(&per_cu, (const void*)mk_fwd, NTHR, LDS_BYTES) != hipSuccess || per_cu < 1) { fprintf(stderr, "kernel_launch: occupancy query says %d\n", per_cu); per_cu = 1; }
        (void)hipGetLastError();
        grid = cus * per_cu;
        if (grid < 256) { fprintf(stderr, "kernel_launch: this kernel needs a 256-workgroup resident grid (got %d)\n", grid); grid = -1; return; }
        if (grid > 256) grid = 256;
    }
    if (grid < 0) return;
    Args a{};
    for (int i = 0; i < 19; ++i) a.in[i] = (const float*)d_in[i];
    a.pos = (const int*)d_in[1]; a.out = (float*)d_out; a.ws = (unsigned char*)d_ws;
#if ONE_LAUNCH
    a.ph_lo = 0; a.ph_hi = NPHASES;
    void* args[] = {&a};
    hipError_t e = hipLaunchCooperativeKernel((const void*)mk_fwd, dim3(grid), dim3(NTHR), args, LDS_BYTES, stream);
    if (e != hipSuccess) fprintf(stderr, "cooperative launch failed: %s (grid %d)\n", hipGetErrorString(e), grid);
#else
#ifdef DBG_STOP
    for (int ph = 0; ph <= DBG_STOP; ++ph) { a.ph_lo = ph; a.ph_hi = ph + 1; hipLaunchKernelGGL(mk_fwd, dim3(grid), dim3(NTHR), LDS_BYTES, stream, a); }
#ifndef DBG_NODUMP
    hipLaunchKernelGGL(dbg_dump, dim3(MTOK * DM / 256), dim3(256), 0, stream, (const unsigned short*)d_ws, (float*)d_out);
#endif
#else
    for (int ph = 0; ph < NPHASES; ++ph) { a.ph_lo = ph; a.ph_hi = ph + 1; hipLaunchKernelGGL(mk_fwd, dim3(grid), dim3(NTHR), LDS_BYTES, stream, a); }
#endif
#endif
}
```

```cpp
#include <hip/hip_runtime.h>
#include <hip/hip_cooperative_groups.h>
#include <cstdio>
#include <cstdint>
namespace cg = cooperative_groups;
#define ONE_LAUNCH 1
namespace pg8 {
#define PG8_LAS __attribute__((address_space(3)))
typedef unsigned short bf16_t;
typedef short bf16x8 __attribute__((ext_vector_type(8)));
typedef float f32x4 __attribute__((ext_vector_type(4)));
typedef unsigned u32x4 __attribute__((ext_vector_type(4)));
constexpr int BM = 256, BK = 64, HALF = 128, HTB = HALF * BK * 2  , STAGE_BYTES = 8 * HTB, NXCD = 8, WGM = 8;

__host__ __device__ __forceinline__ int lds_byte(int r, int c) { const int st = (r >> 4) * 2 + (c >> 5), rr = r & 15, cc = c & 31, ob = rr * 64 + cc * 2; return st * 1024 + (ob ^ (((ob >> 9) & 1) << 5)); }
__host__ __device__ __forceinline__ void stage_rc(int b, int& R, int& C) { const int st = b / 1024, sb = b % 1024, swz = sb ^ (((sb >> 9) & 1) << 5); R = (st >> 1) * 16 + swz / 64; C = (st & 1) * 32 + (swz % 64) / 2; }
__host__ __device__ __forceinline__ int perm32(int rho) { const int n = rho >> 4, i = rho & 15; return 8 * (i >> 2) + 4 * n + (i & 3); }

struct Unit { int pm, pn; };
struct Gemm { const bf16_t* A; const bf16_t* Bt; int M, N, K; };

struct StaticOrder {
    int nM, nN, nwg, G, c;
    __host__ __device__ void init(int M, int N, int G_, int c_) { nM = M / BM; nN = N / BM; nwg = nM * nN; G = G_; c = c_; }
    __host__ __device__ bool next(int i, Unit& u) const {
        const long L = (long)i * G + c; if (L >= nwg) return false;
        int wgid = (int)L; { const int q = nwg / NXCD, r = nwg % NXCD, xcd = wgid % NXCD, off = wgid / NXCD; wgid = (xcd < r ? xcd * (q + 1) : r * (q + 1) + (xcd - r) * q) + off; }
        const int nig = WGM * nN, gid = wgid / nig, fm = gid * WGM, gsz = (nM - fm) < WGM ? (nM - fm) : WGM;
        u.pm = fm + ((wgid % nig) % gsz); u.pn = (wgid % nig) / gsz; return true;
    }
    __device__ __forceinline__ void a_ready(const Unit&) const {}
    __device__ __forceinline__ void done(const Unit&) const {}
};

__device__ __forceinline__ unsigned cvt_pk_bf16(float lo, float hi) { unsigned r; asm volatile("v_cvt_pk_bf16_f32 %0, %1, %2" : "=v"(r) : "v"(lo), "v"(hi)); return r; }
template <class Epi, class Sched, bool ALIGN_EPI = false, bool SP2 = false>
__device__ __forceinline__ void gemm_phase(PG8_LAS unsigned char* lds, const Gemm g, const Sched& S, const Epi& E, int tid_in) {
    int tid_ = tid_in; asm volatile("" : "+v"(tid_));
    const int tid = tid_, wid = __builtin_amdgcn_readfirstlane(tid >> 6), lane = tid & 63, wr = wid >> 2, wc = wid & 3, fr = lane & 15, fq = lane >> 4;
    const int K = g.K, nt = K / BK;
    unsigned voffA[2], voffB[2];
#pragma unroll
    for (int i = 0; i < 2; ++i) { int R, C; stage_rc(tid * 16 + i * 8192, R, C); const int Rb = Epi::PERM ? ((R & ~31) + perm32(R & 31)) : R;
        voffA[i] = (unsigned)(R * K + C) * 2u; voffB[i] = (unsigned)(Rb * K + C) * 2u; }
    const size_t kstep = (size_t)(BK * 2);
    const size_t hstep = (size_t)HALF * K * 2;
    const size_t tstep = 2 * hstep;
    const unsigned ldsw = (unsigned)wid * 1024u;
    const int aoff = lds_byte(wr * 64 + fr, fq * 8), boff = lds_byte(wc * 32 + fr, fq * 8);
#define PG8_SA(b, h) (((b) * 2 + (h)) * HTB)
#define PG8_SB(b, h) ((4 + (b) * 2 + (h)) * HTB)
#define PG8_STAGE(bufoff, gbase, voff) do { _Pragma("unroll") for (int _i = 0; _i < 2; ++_i) \
        __builtin_amdgcn_global_load_lds((const unsigned*)((const char*)(gbase) + (voff)[_i]), (PG8_LAS unsigned*)(lds + (bufoff) + ldsw + _i * 8192), 16, 0, 0); } while (0)
#define PG8_LDA(dst, b, h) do { _Pragma("unroll") for (int m = 0; m < 4; ++m) _Pragma("unroll") for (int k = 0; k < 2; ++k) dst[m][k] = *(const PG8_LAS bf16x8*)(lds + PG8_SA(b, h) + aoff + m * 2048 + k * 1024); } while (0)
#define PG8_LDB(dst, b, h) do { _Pragma("unroll") for (int n = 0; n < 2; ++n) _Pragma("unroll") for (int k = 0; k < 2; ++k) dst[n][k] = *(const PG8_LAS bf16x8*)(lds + PG8_SB(b, h) + boff + n * 2048 + k * 1024); } while (0)
#define PG8_MMA(ai, bj, At, Bt) do { __builtin_amdgcn_s_setprio(1); _Pragma("unroll") for (int m = 0; m < 4; ++m) _Pragma("unroll") for (int n = 0; n < 2; ++n) _Pragma("unroll") for (int k = 0; k < 2; ++k) \
        acc[ai][bj][m][n] = __builtin_amdgcn_mfma_f32_16x16x32_bf16(Bt[n][k], At[m][k], acc[ai][bj][m][n], 0, 0, 0); __builtin_amdgcn_s_setprio(0); } while (0)
#define PG8_WAIT_V(n) asm volatile("s_waitcnt vmcnt(" #n ")" ::: "memory")
#define PG8_WAIT_L(n) asm volatile("s_waitcnt lgkmcnt(" #n ")" ::: "memory")
#define PG8_BAR __builtin_amdgcn_s_barrier()
#define PG8_SCHED __builtin_amdgcn_sched_barrier(0)
    Unit cur, nxt; int ui = 0;
    if (!S.next(0, cur)) return;
    f32x4 acc[2][2][4][2];
    float z_ = 0.f; asm volatile("" : "+v"(z_));
#pragma unroll
    for (int a = 0; a < 2; ++a)
#pragma unroll
        for (int b = 0; b < 2; ++b)
#pragma unroll
            for (int m = 0; m < 4; ++m)
#pragma unroll
                for (int n = 0; n < 2; ++n) acc[a][b][m][n] = (f32x4){z_, z_, z_, z_};
    bf16x8 At[4][2], B0[2][2], B1[2][2];
    const char* cA = (const char*)g.A + (size_t)cur.pm * tstep; const char* cB = (const char*)g.Bt + (size_t)cur.pn * tstep;
    S.a_ready(cur);
    if constexpr (SP2) {
        PG8_STAGE(PG8_SB(0, 0), cB, voffB); PG8_STAGE(PG8_SB(0, 1), cB + hstep, voffB); PG8_STAGE(PG8_SA(0, 0), cA, voffA); PG8_STAGE(PG8_SA(0, 1), cA + hstep, voffA);
        if (wr == 1) PG8_BAR;
        PG8_WAIT_V(2); PG8_BAR;
        PG8_STAGE(PG8_SB(1, 0), cB + kstep, voffB); PG8_STAGE(PG8_SA(1, 0), cA + kstep, voffA); PG8_STAGE(PG8_SB(1, 1), cB + hstep + kstep, voffB);
        PG8_WAIT_V(6); PG8_BAR;
    } else {
        PG8_STAGE(PG8_SB(0, 0), cB, voffB); PG8_STAGE(PG8_SA(0, 0), cA, voffA); PG8_STAGE(PG8_SB(0, 1), cB + hstep, voffB); PG8_STAGE(PG8_SA(0, 1), cA + hstep, voffA);
        if (wr == 1) PG8_BAR;
        PG8_WAIT_V(4); PG8_BAR;
        PG8_STAGE(PG8_SB(1, 0), cB + kstep, voffB); PG8_STAGE(PG8_SA(1, 0), cA + kstep, voffA); PG8_STAGE(PG8_SB(1, 1), cB + hstep + kstep, voffB);
        PG8_WAIT_V(6); PG8_BAR;
    }
    for (;;) {
        const bool has_next = S.next(ui + 1, nxt);
        const char* nA = has_next ? (const char*)g.A + (size_t)nxt.pm * tstep : cA; const char* nB = has_next ? (const char*)g.Bt + (size_t)nxt.pn * tstep : cB;
        for (int t = 0; t < nt; t += 2) {
            const bool last = (t == nt - 2);
            const char* a1 = cA + (size_t)(t + 1) * kstep;
            const char* a2 = last ? nA : cA + (size_t)(t + 2) * kstep; const char* b2 = last ? nB : cB + (size_t)(t + 2) * kstep;
            const char* a3 = a2 + kstep; const char* b3 = b2 + kstep;
            if (last && has_next) S.a_ready(nxt);
            if constexpr (SP2) {
            PG8_LDB(B0, 0, 0); PG8_LDB(B1, 0, 1); PG8_SCHED; PG8_LDA(At, 0, 0); PG8_STAGE(PG8_SA(1, 1), a1 + hstep, voffA);
            PG8_WAIT_V(8); PG8_WAIT_L(0); PG8_BAR; PG8_MMA(0, 0, At, B0); PG8_MMA(0, 1, At, B1); PG8_BAR; PG8_SCHED;
            PG8_LDA(At, 0, 1); PG8_STAGE(PG8_SB(0, 0), b2, voffB); PG8_STAGE(PG8_SB(0, 1), b2 + hstep, voffB); PG8_STAGE(PG8_SA(0, 0), a2, voffA);
            PG8_WAIT_V(8); PG8_WAIT_L(0); PG8_BAR; PG8_MMA(1, 0, At, B0); PG8_MMA(1, 1, At, B1); PG8_BAR; PG8_SCHED;
            PG8_LDB(B0, 1, 0); PG8_LDB(B1, 1, 1); PG8_SCHED; PG8_LDA(At, 1, 0); PG8_STAGE(PG8_SA(0, 1), a2 + hstep, voffA);
            PG8_WAIT_V(8); PG8_WAIT_L(0); PG8_BAR; PG8_MMA(0, 0, At, B0); PG8_MMA(0, 1, At, B1); PG8_BAR; PG8_SCHED;
            PG8_LDA(At, 1, 1); PG8_STAGE(PG8_SB(1, 0), b3, voffB); PG8_STAGE(PG8_SB(1, 1), b3 + hstep, voffB); PG8_STAGE(PG8_SA(1, 0), a3, voffA);
            PG8_WAIT_V(8); PG8_WAIT_L(0); PG8_BAR; PG8_MMA(1, 0, At, B0); PG8_MMA(1, 1, At, B1); PG8_BAR; PG8_SCHED;
            } else {
            PG8_LDB(B0, 0, 0); PG8_SCHED; PG8_LDA(At, 0, 0); PG8_STAGE(PG8_SA(1, 1), a1 + hstep, voffA);
            PG8_WAIT_L(8); PG8_BAR; PG8_WAIT_L(0); PG8_MMA(0, 0, At, B0); PG8_BAR; PG8_SCHED;
            PG8_LDB(B1, 0, 1); PG8_STAGE(PG8_SB(0, 0), b2, voffB);
            PG8_BAR; PG8_WAIT_L(0); PG8_MMA(0, 1, At, B1); PG8_BAR;
            PG8_LDA(At, 0, 1); PG8_STAGE(PG8_SA(0, 0), a2, voffA);
            PG8_BAR; PG8_WAIT_L(0); PG8_MMA(1, 0, At, B0); PG8_BAR; PG8_SCHED;
            PG8_STAGE(PG8_SB(0, 1), b2 + hstep, voffB);
            PG8_WAIT_V(6); PG8_BAR; PG8_MMA(1, 1, At, B1); PG8_BAR;
            PG8_LDB(B0, 1, 0); PG8_SCHED; PG8_LDA(At, 1, 0); PG8_STAGE(PG8_SA(0, 1), a2 + hstep, voffA);
            PG8_WAIT_L(8); PG8_BAR; PG8_WAIT_L(0); PG8_MMA(0, 0, At, B0); PG8_BAR; PG8_SCHED;
            PG8_LDB(B1, 1, 1); PG8_STAGE(PG8_SB(1, 0), b3, voffB);
            PG8_BAR; PG8_WAIT_L(0); PG8_MMA(0, 1, At, B1); PG8_BAR;
            PG8_LDA(At, 1, 1); PG8_STAGE(PG8_SA(1, 0), a3, voffA);
            PG8_BAR; PG8_WAIT_L(0); PG8_MMA(1, 0, At, B0); PG8_BAR; PG8_SCHED;
            PG8_STAGE(PG8_SB(1, 1), b3 + hstep, voffB);
            PG8_WAIT_V(6); PG8_BAR; PG8_MMA(1, 1, At, B1); PG8_BAR;
            }
        }
        if constexpr (ALIGN_EPI) { if (wr == 0) PG8_BAR; }
        if constexpr (!Epi::AFTER_DRAIN) { E(acc, cur, wr, wc, fr, fq); S.done(cur); }
        if (!has_next) break;
        z_ = 0.f; asm volatile("" : "+v"(z_));
#pragma unroll
        for (int a = 0; a < 2; ++a)
#pragma unroll
            for (int b = 0; b < 2; ++b)
#pragma unroll
                for (int m = 0; m < 4; ++m)
#pragma unroll
                    for (int n = 0; n < 2; ++n) acc[a][b][m][n] = (f32x4){z_, z_, z_, z_};
        cur = nxt; cA = nA; cB = nB; ++ui;
        if constexpr (ALIGN_EPI) { if (wr == 1) PG8_BAR; }
    }
    PG8_WAIT_V(0);
    if constexpr (!ALIGN_EPI) { if (wr == 0) PG8_BAR; }
    PG8_BAR;
    if constexpr (Epi::AFTER_DRAIN) { E.fused(acc, cur, wr, wc, fr, fq, lds, wid, lane); S.done(cur); }
#undef PG8_SA
#undef PG8_SB
#undef PG8_STAGE
#undef PG8_LDA
#undef PG8_LDB
#undef PG8_MMA
#undef PG8_WAIT_V
#undef PG8_WAIT_L
#undef PG8_BAR
#undef PG8_SCHED
}
}
namespace ms {
__device__ __forceinline__ unsigned ld(const unsigned* p) { return __hip_atomic_load(p, __ATOMIC_RELAXED, __HIP_MEMORY_SCOPE_AGENT); }
__device__ __forceinline__ void st(unsigned* p, unsigned v) { __hip_atomic_store(p, v, __ATOMIC_RELAXED, __HIP_MEMORY_SCOPE_AGENT); }
constexpr int W_ARR = 0, W_GF = 512, W_REL = 1024;
__device__ __forceinline__ void grid_sync(unsigned* bw, int tid, int bx, unsigned seam) {
    asm volatile("s_waitcnt vmcnt(0)" ::: "memory");
    __syncthreads();
    if (tid < 64) {
        if (tid == 0) { __builtin_amdgcn_fence(__ATOMIC_RELEASE, "agent"); asm volatile("s_waitcnt vmcnt(0)" ::: "memory"); st(&bw[W_ARR + bx], seam); }
        if ((bx & 31) == 0) {
            const int g = bx >> 5;
            for (unsigned sp = 0; sp < (1u << 22); ++sp) { const unsigned v = (tid < 32) ? ld(&bw[W_ARR + g * 32 + tid]) : seam; if (__all(v == seam)) break; __builtin_amdgcn_s_sleep(1); }
            if (tid == 0) st(&bw[W_GF + 32 * g], seam);
            if (bx == 0) {
                for (unsigned sp = 0; sp < (1u << 22); ++sp) { const unsigned v = (tid < 8) ? ld(&bw[W_GF + 32 * tid]) : seam; if (__all(v == seam)) break; __builtin_amdgcn_s_sleep(1); }
                if (tid == 0) st(&bw[W_REL], seam);
            }
        }
        for (unsigned sp = 0; sp < (1u << 22); ++sp) { const unsigned v = ld(&bw[W_REL]); if (__all(v == seam)) break; __builtin_amdgcn_s_sleep(1); }
        if (tid == 0) { __builtin_amdgcn_fence(__ATOMIC_ACQUIRE, "agent"); asm volatile("s_waitcnt vmcnt(0)" ::: "memory"); }
    }
    __syncthreads();
}
}

#ifndef PHMASK
#define PHMASK 0x3ff
#endif
#ifndef ONE_LAUNCH
#define ONE_LAUNCH 1
#endif
namespace mk {
using pg8::bf16_t; using pg8::f32x4; using pg8::bf16x8; using pg8::u32x4; using pg8::Unit; using pg8::cvt_pk_bf16;
#define LAS __attribute__((address_space(3)))
typedef float f32x16 __attribute__((ext_vector_type(16)));
typedef unsigned u32x2 __attribute__((ext_vector_type(2)));
typedef short s16x4 __attribute__((ext_vector_type(4)));
#define DI __device__ __forceinline__
#define MFMA32(a, b, c) __builtin_amdgcn_mfma_f32_32x32x16_bf16((a), (b), (c), 0, 0, 0)

constexpr int BATCH = 2, SEQ = 8192, DM = 1024, MTOK = BATCH * SEQ, DEPTH = 4, FF = 4096, NIN = 5888, NGATE = 3072;
constexpr float EPS = 1e-6f, LOG2E = 1.4426950408889634f;
constexpr int NTHR = 512, LDS_BYTES = 147456;
constexpr int NPH_LAYER = 10, NPHASES = 1 + NPH_LAYER * DEPTH;

constexpr size_t MiB = (size_t)1 << 20;
constexpr size_t WS_CTL = 0, WS_TAB = 2 * MiB, WS_W = 6 * MiB, WS_XB = 40 * MiB, WS_AR = 72 * MiB, WS_END = WS_AR + 249 * MiB;
constexpr size_t W_IN = WS_W, W_UQ = W_IN + (size_t)NIN * 1024 * 2, W_UKV = W_UQ + 768 * 256 * 2, W_OA = W_UKV + 1024 * 256 * 2, W_OB = W_OA + 1024 * 512 * 2,
                 W_OC = W_OB + 1024 * 512 * 2, W_OUT = W_OC + 1024 * 512 * 2, W_UP = W_OUT + 1024 * 1024 * 2, W_DN = W_UP + (size_t)4096 * 1024 * 2, W_ENDW = W_DN + (size_t)4096 * 1024 * 2;
static_assert(W_ENDW <= WS_XB, "weights fit");
constexpr size_t A_G = WS_AR, A_QSWA = WS_AR + 96 * MiB, A_QSB = WS_AR + 112 * MiB, A_KSB = WS_AR + 128 * MiB, A_VTSB = WS_AR + 144 * MiB, A_CQ = WS_AR + 160 * MiB,
                 A_CKV = WS_AR + 237 * MiB  , A_KPE = WS_AR + 172 * MiB, A_KSWA = WS_AR + 173 * MiB, A_VTSWA = WS_AR + 177 * MiB, A_QMLA = WS_AR + 181 * MiB,
                 A_KNOPE = WS_AR + 205 * MiB, A_VTMLA = WS_AR + 221 * MiB;
constexpr size_t A_MIXED = WS_AR + 128 * MiB, A_MIXEDB = WS_AR + 128 * MiB  , A_Y = WS_AR, A_U = WS_AR, A_Y2 = WS_AR + 128 * MiB, A_OMLA = WS_XB;
constexpr int SS_X = 0, SS_X1 = MTOK, SS_L0 = 2 * MTOK;
constexpr size_t WS_BAR = WS_CTL + MiB, BAR_BYTES = 16384;
constexpr size_t A_SSP = WS_AR + 245 * MiB;
constexpr int SP_CQ = 0, SP_CKV = 4 * MTOK, SP_Y = 8 * MTOK, SP_Y2 = 24 * MTOK;

__constant__ float ROPE_INV[32] = {1.000000000e+00f, 7.498942018e-01f, 5.623413324e-01f, 4.216965139e-01f, 3.162277639e-01f, 2.371373773e-01f, 1.778279394e-01f, 1.333521456e-01f, 1.000000015e-01f, 7.498942316e-02f, 5.623413250e-02f, 4.216964915e-02f, 3.162277490e-02f, 2.371373773e-02f, 1.778279431e-02f, 1.333521400e-02f, 9.999999776e-03f, 7.498942316e-03f, 5.623413250e-03f, 4.216964822e-03f, 3.162277630e-03f, 2.371373819e-03f, 1.778279431e-03f, 1.333521446e-03f, 1.000000047e-03f, 7.498941850e-04f, 5.623413017e-04f, 4.216965172e-04f, 3.162277571e-04f, 2.371373703e-04f, 1.778279402e-04f, 1.333521504e-04f};
struct Args { const float* in[19]; const int* pos; float* out; unsigned char* ws; int ph_lo, ph_hi; };
typedef const __attribute__((address_space(4))) Args* CArgsP;

DI float shx(float v, int mask, int lane) { return __int_as_float(__builtin_amdgcn_ds_bpermute((lane ^ mask) << 2, __float_as_int(v))); }
DI float wave_sum(float v, int lane) {
#pragma unroll
    for (int o = 1; o < 64; o <<= 1) v += shx(v, o, lane);
    return v;
}
DI float bf2f(unsigned short b) { return __uint_as_float((unsigned)b << 16); }
DI u32x4 pack8(const float* v) { u32x4 w; w.x = cvt_pk_bf16(v[0], v[1]); w.y = cvt_pk_bf16(v[2], v[3]); w.z = cvt_pk_bf16(v[4], v[5]); w.w = cvt_pk_bf16(v[6], v[7]); return w; }
DI u32x2 pack4(float a, float b, float c, float d) { u32x2 w; w.x = cvt_pk_bf16(a, b); w.y = cvt_pk_bf16(c, d); return w; }
DI float fast_rsq(float x) { return __builtin_amdgcn_rsqf(x); }

DI int perm64inv(int d) { return d < 32 ? 8 * (d >> 2) + (d & 3) : 8 * ((d - 32) >> 2) + 4 + (d & 3); }
DI int perm32inv(int d) { return d < 16 ? 8 * (d >> 2) + (d & 3) : 8 * ((d - 16) >> 2) + 4 + (d & 3); }
DI int rowmap(int kind, int n) {
    if (kind == 0) return n;
    if (kind == 1) {
        if (n < 384) return n;
        if (n < 416) return 384 + perm32inv(n - 384);
        if (n < 928) { const int t = n - 416; return 512 + (t & ~63) + perm64inv(t & 63); }
        if (n < 1056) { const int t = n - 928; return 1024 + (t & ~63) + perm64inv(t & 63); }
        return n + 96;
    }
    if (kind == 2) { const int h = n / 96, j = n % 96; return j < 64 ? h * 64 + j : 512 + h * 32 + perm32inv(j - 64); }
    { const int h = n >> 7, j = n & 127; return j < 64 ? h * 64 + j : 512 + h * 64 + (j - 64); }
}
DI void conv_item(const float* W, int K, int N, bf16_t* WT, const float* gk, int kind, LAS float* scr, int item, int lane, int ldw = 0) {
    if (ldw == 0) ldw = K;
    const int nblk = N / 32, kb = item / nblk, nb = item % nblk, k0 = 64 * kb, n0 = 32 * nb;
#pragma unroll 8
    for (int i = 0; i < 32; ++i) { const int kk = 2 * i + (lane >> 5); float v = W[(size_t)(k0 + kk) * N + n0 + (lane & 31)]; if (gk) v *= gk[k0 + kk]; scr[kk * 33 + (lane & 31)] = v; }
    asm volatile("s_waitcnt lgkmcnt(0)" ::: "memory");
    const int c = lane & 7;
#pragma unroll
    for (int j = 0; j < 4; ++j) { const int n = (lane >> 3) + 8 * j; const LAS float* s = scr + (8 * c) * 33 + n;
        u32x4 o; o.x = cvt_pk_bf16(s[0 * 33], s[1 * 33]); o.y = cvt_pk_bf16(s[2 * 33], s[3 * 33]); o.z = cvt_pk_bf16(s[4 * 33], s[5 * 33]); o.w = cvt_pk_bf16(s[6 * 33], s[7 * 33]);
        *(u32x4*)(WT + (size_t)rowmap(kind, n0 + n) * ldw + k0 + 8 * c) = o; }
    asm volatile("s_waitcnt lgkmcnt(0)" ::: "memory");
}
DI void conv_layer(CArgsP a, int l, LAS unsigned char* lds, int gw, int ngw, int wave, int lane) {
    LAS float* scr = (LAS float*)(lds + wave * 16384);
    unsigned char* ws = a->ws;
    constexpr int I_IN = 16 * 181, I_UQ = 4 * 24, I_UKV = 2 * 32, I_O = 8 * 32, I_OUT = 16 * 32, I_UP = 16 * 128, I_DN = 64 * 32;
    constexpr int NITEMS = I_IN + I_UQ + I_UKV + 3 * I_O + I_OUT + I_UP + I_DN;
    for (int it = gw; it < NITEMS; it += ngw) {
        int r = it;
        if (r < I_IN) { conv_item(a->in[3] + (size_t)l * 1024 * 5792, 1024, 5792, (bf16_t*)(ws + W_IN), a->in[2] + l * 1024, 1, scr, r, lane); continue; } r -= I_IN;
        if (r < I_UQ) { conv_item(a->in[7] + (size_t)l * 256 * 768, 256, 768, (bf16_t*)(ws + W_UQ), a->in[5] + l * 256, 2, scr, r, lane); continue; } r -= I_UQ;
        if (r < I_UKV) { conv_item(a->in[8] + (size_t)l * 128 * 1024, 128, 1024, (bf16_t*)(ws + W_UKV), a->in[6] + l * 128, 3, scr, r, lane, 256); continue; } r -= I_UKV;
        if (r < I_O) { conv_item(a->in[10] + (size_t)l * 512 * 1024, 512, 1024, (bf16_t*)(ws + W_OA), nullptr, 0, scr, r, lane); continue; } r -= I_O;
        if (r < I_O) { conv_item(a->in[11] + (size_t)l * 512 * 1024, 512, 1024, (bf16_t*)(ws + W_OB), nullptr, 0, scr, r, lane); continue; } r -= I_O;
        if (r < I_O) { conv_item(a->in[12] + (size_t)l * 512 * 1024, 512, 1024, (bf16_t*)(ws + W_OC), nullptr, 0, scr, r, lane); continue; } r -= I_O;
        if (r < I_OUT) { conv_item(a->in[13] + (size_t)l * 1024 * 1024, 1024, 1024, (bf16_t*)(ws + W_OUT), nullptr, 0, scr, r, lane); continue; } r -= I_OUT;
        if (r < I_UP) { conv_item(a->in[16] + (size_t)l * 1024 * 4096, 1024, 4096, (bf16_t*)(ws + W_UP), a->in[15] + l * 1024, 0, scr, r, lane); continue; } r -= I_UP;
        conv_item(a->in[17] + (size_t)l * 4096 * 1024, 4096, 1024, (bf16_t*)(ws + W_DN), nullptr, 0, scr, r, lane);
    }
}

DI void row_update(const float* xin, float* xout, const float* Y, const float* ssq_y, const float* g, bf16_t* XB, float* ssq_out, int r, int lane) {
    const f32x4* xr = (const f32x4*)(xin + (size_t)r * DM) + lane;
    float ss = 0.f;
    float rs = 0.f;
    if (Y) { float p_ = ssq_y[(unsigned)r * 16 + (lane & 15)]; p_ += shx(p_, 1, lane); p_ += shx(p_, 2, lane); p_ += shx(p_, 4, lane); p_ += shx(p_, 8, lane); rs = fast_rsq(p_ * (1.f / DM) + EPS); }
#pragma unroll
    for (int j = 0; j < 4; ++j) {
        f32x4 v = xr[64 * j];
        if (Y) { const u32x2 yw = ((const u32x2*)((const bf16_t*)Y + (size_t)r * DM) + lane)[64 * j]; const f32x4 y = (f32x4){__uint_as_float(yw.x << 16), __uint_as_float(yw.x & 0xffff0000u), __uint_as_float(yw.y << 16), __uint_as_float(yw.y & 0xffff0000u)};
            const f32x4 gg = ((const f32x4*)g + lane)[64 * j]; v = v + y * rs * gg; ((f32x4*)(xout + (size_t)r * DM) + lane)[64 * j] = v; }
        ss += (v.x * v.x + v.y * v.y) + (v.z * v.z + v.w * v.w);
        ((u32x2*)(XB + (size_t)r * DM) + lane)[64 * j] = pack4(v.x, v.y, v.z, v.w);
    }
    ss = wave_sum(ss, lane);
    if (lane == 0) ssq_out[r] = ss;
}

#define EPI_ROWS _Pragma("unroll") for (int ai = 0; ai < 2; ++ai) _Pragma("unroll") for (int m = 0; m < 4; ++m, ({ asm volatile("" ::: "memory"); }))
#define EPI_GETV(v, sc) float v[8]; { const f32x4 a0_ = acc[ai][bj][m][0], a1_ = acc[ai][bj][m][1]; v[0] = a0_[0] * (sc); v[1] = a0_[1] * (sc); v[2] = a0_[2] * (sc); v[3] = a0_[3] * (sc); v[4] = a1_[0] * (sc); v[5] = a1_[1] * (sc); v[6] = a1_[2] * (sc); v[7] = a1_[3] * (sc); }
DI void rope8(const float* v, const float* tc, const float* ts, int r, int i0, int stride, float* o1, float* o2) {
#pragma unroll
    for (int e = 0; e < 4; ++e) { const float c = tc[(unsigned)(r * 32 + (i0 + e) * stride)], s = ts[(unsigned)(r * 32 + (i0 + e) * stride)]; o1[e] = v[e] * c - v[4 + e] * s; o2[e] = v[4 + e] * c + v[e] * s; }
}
DI void vt_scatter(bf16_t* vt, int nh, int r, int h, int d0, const float* v) {
    const int b = r >> 13, s = r & (SEQ - 1);
    const unsigned off = (unsigned)(((b * nh + h) * 64 + d0) * SEQ + s);
#pragma unroll
    for (int j = 0; j < 8; j += 2) { const unsigned w = cvt_pk_bf16(v[j], v[j + 1]); vt[off + (unsigned)(j * SEQ)] = (bf16_t)(w & 0xffffu); vt[off + (unsigned)((j + 1) * SEQ)] = (bf16_t)(w >> 16); asm volatile("" ::: "memory"); }
    asm volatile("s_waitcnt vmcnt(0)" ::: "memory");
}
DI void ssq_row_put(float part, float* dst, int fr, int fq) {
    const int lane = fq * 16 + fr; part += shx(part, 16, lane); part += shx(part, 32, lane);
    if (fq == 0) *dst = part;
}

struct EpiIn {
    static constexpr bool PERM = true, AFTER_DRAIN = false;
    CArgsP a0; int l;
    DI void operator()(const f32x4 (&acc)[2][2][4][2], const Unit& u, int wr, int wc, int fr0, int fq0) const {
        asm volatile("s_waitcnt vmcnt(0)" ::: "memory");     unsigned ones_ = ~0u; asm volatile("" : "+s"(ones_)); const int lane_ = (int)__builtin_amdgcn_mbcnt_hi(ones_, __builtin_amdgcn_mbcnt_lo(ones_, 0u)); const int fr = lane_ & 15, fq = lane_ >> 4; (void)fr0; (void)fq0;
        CArgsP a = a0; asm volatile("" : "+s"(a));
        unsigned char* ws = a->ws; float* ctl = (float*)(ws + WS_CTL);
        const float* ssq_x = ctl + SS_X; float* ssq_cq = (float*)(ws + A_SSP) + SP_CQ; float* ssq_ckv = (float*)(ws + A_SSP) + SP_CKV;
        const float* bgate = a->in[4] + l * NGATE; const float* tc = (const float*)(ws + WS_TAB); const float* ts = tc + (size_t)MTOK * 32;
        bf16_t *cq = (bf16_t*)(ws + A_CQ), *ckv = (bf16_t*)(ws + A_CKV), *kpe = (bf16_t*)(ws + A_KPE), *qswa = (bf16_t*)(ws + A_QSWA), *kswa = (bf16_t*)(ws + A_KSWA), *vtswa = (bf16_t*)(ws + A_VTSWA),
               *qsb = (bf16_t*)(ws + A_QSB), *ksb = (bf16_t*)(ws + A_KSB), *vtsb = (bf16_t*)(ws + A_VTSB), *G = (bf16_t*)(ws + A_G);
        const int pn = u.pn;
        EPI_ROWS {
            const int r = u.pm * 256 + ai * 128 + wr * 64 + m * 16 + fr;
            const float rs = fast_rsq(ssq_x[r] * (1.f / DM) + EPS);
            if (pn == 0) {
                float part = 0.f;
#pragma unroll
                for (int bj = 0; bj < 2; ++bj) { EPI_GETV(v, rs);
#pragma unroll
                    for (int j = 0; j < 8; ++j) part += v[j] * v[j];
                    *(u32x4*)(cq + (unsigned)r * 256 + bj * 128 + wc * 32 + fq * 8) = pack8(v); }
                ssq_row_put(part, ssq_cq + (unsigned)r * 4 + wc, fr, fq);
            } else if (pn == 1) {
                float part = 0.f;
                { constexpr int bj = 0; EPI_GETV(v, rs);
#pragma unroll
                    for (int j = 0; j < 8; ++j) part += v[j] * v[j];
                    *(u32x4*)(ckv + (unsigned)r * 256 + wc * 32 + fq * 8) = pack8(v); *(u32x4*)(ckv + (unsigned)r * 256 + 128 + wc * 32 + fq * 8) = (u32x4){0u, 0u, 0u, 0u}; }
                ssq_row_put(part, ssq_ckv + (unsigned)r * 4 + wc, fr, fq);
                if (wc == 0) { constexpr int bj = 1; EPI_GETV(v, rs); float o1[4], o2[4]; rope8(v, tc, ts, r, 4 * fq, 2, o1, o2);
                    *(u32x2*)(kpe + (unsigned)r * 32 + 4 * fq) = pack4(o1[0], o1[1], o1[2], o1[3]); *(u32x2*)(kpe + (unsigned)r * 32 + 16 + 4 * fq) = pack4(o2[0], o2[1], o2[2], o2[3]); }
            } else if (pn <= 3) {
                const float sc = rs * (0.125f * LOG2E);
#pragma unroll
                for (int bj = 0; bj < 2; ++bj) { EPI_GETV(v, sc); const int head = (pn - 2) * 4 + bj * 2 + (wc >> 1), g = 4 * (wc & 1) + fq; float o1[4], o2[4]; rope8(v, tc, ts, r, 4 * g, 1, o1, o2);
                    bf16_t* p = qswa + (unsigned)r * 512 + head * 64 + 4 * g; *(u32x2*)p = pack4(o1[0], o1[1], o1[2], o1[3]); *(u32x2*)(p + 32) = pack4(o2[0], o2[1], o2[2], o2[3]); }
            } else if (pn == 4) {
                { constexpr int bj = 0; EPI_GETV(v, rs); const int kvh = wc >> 1, g = 4 * (wc & 1) + fq; float o1[4], o2[4]; rope8(v, tc, ts, r, 4 * g, 1, o1, o2);
                    bf16_t* p = kswa + (unsigned)r * 128 + kvh * 64 + 4 * g; *(u32x2*)p = pack4(o1[0], o1[1], o1[2], o1[3]); *(u32x2*)(p + 32) = pack4(o2[0], o2[1], o2[2], o2[3]); }
                { constexpr int bj = 1; EPI_GETV(v, rs); vt_scatter(vtswa, 2, r, wc >> 1, 32 * (wc & 1) + 8 * fq, v); }
            } else if (pn <= 6) {
                const float sc = rs * 0.125f;
#pragma unroll
                for (int bj = 0; bj < 2; ++bj) { EPI_GETV(v, sc); *(u32x4*)(qsb + (unsigned)r * 512 + (pn - 5) * 256 + bj * 128 + wc * 32 + fq * 8) = pack8(v); }
            } else if (pn <= 8) {
#pragma unroll
                for (int bj = 0; bj < 2; ++bj) { EPI_GETV(v, rs); *(u32x4*)(ksb + (unsigned)r * 512 + (pn - 7) * 256 + bj * 128 + wc * 32 + fq * 8) = pack8(v); }
            } else if (pn <= 10) {
#pragma unroll
                for (int bj = 0; bj < 2; ++bj) { EPI_GETV(v, rs); const int c = (pn - 9) * 256 + bj * 128 + wc * 32 + fq * 8; vt_scatter(vtsb, 8, r, c >> 6, c & 63, v); }
            } else {
#pragma unroll
                for (int bj = 0; bj < 2; ++bj) { EPI_GETV(v, rs); const int c = (pn - 11) * 256 + bj * 128 + wc * 32 + fq * 8;
                    const f32x4 b0 = *(const f32x4*)(bgate + c), b1 = *(const f32x4*)(bgate + c + 4); const float bb[8] = {b0[0], b0[1], b0[2], b0[3], b1[0], b1[1], b1[2], b1[3]};
#pragma unroll
                    for (int j = 0; j < 8; ++j) v[j] = __builtin_amdgcn_rcpf(1.f + __expf(-(v[j] + bb[j])));
                    *(u32x4*)(G + (unsigned)r * NGATE + c) = pack8(v); }
            }
        }
    }
};
struct EpiGate {
    static constexpr bool PERM = true, AFTER_DRAIN = false;
    CArgsP a0; int l;
    DI void operator()(const f32x4 (&acc)[2][2][4][2], const Unit& u, int wr, int wc, int fr0, int fq0) const {
        asm volatile("s_waitcnt vmcnt(0)" ::: "memory"); unsigned ones_ = ~0u; asm volatile("" : "+s"(ones_)); const int lane_ = (int)__builtin_amdgcn_mbcnt_hi(ones_, __builtin_amdgcn_mbcnt_lo(ones_, 0u)); const int fr = lane_ & 15, fq = lane_ >> 4; (void)fr0; (void)fq0;
        CArgsP a = a0; asm volatile("" : "+s"(a));
        unsigned char* ws = a->ws; const float* ssq_x = (const float*)(ws + WS_CTL) + SS_X; const float* bgate = a->in[4] + l * NGATE; bf16_t* G = (bf16_t*)(ws + A_G);
        EPI_ROWS {
            const int r = u.pm * 256 + ai * 128 + wr * 64 + m * 16 + fr;
            const float rs = fast_rsq(ssq_x[r] * (1.f / DM) + EPS);
#pragma unroll
            for (int bj = 0; bj < 2; ++bj) { EPI_GETV(v, rs); const int c = u.pn * 256 + bj * 128 + wc * 32 + fq * 8;
                const f32x4 b0 = *(const f32x4*)(bgate + c), b1 = *(const f32x4*)(bgate + c + 4); const float bb[8] = {b0[0], b0[1], b0[2], b0[3], b1[0], b1[1], b1[2], b1[3]};
#pragma unroll
                for (int j = 0; j < 8; ++j) v[j] = __builtin_amdgcn_rcpf(1.f + __expf(-(v[j] + bb[j])));
                *(u32x4*)(G + (unsigned)r * NGATE + c) = pack8(v); }
        }
    }
};
struct EpiUpQ {
    static constexpr bool PERM = true, AFTER_DRAIN = false;
    CArgsP a0; int l;
    DI void operator()(const f32x4 (&acc)[2][2][4][2], const Unit& u, int wr, int wc, int fr0, int fq0) const {
        asm volatile("s_waitcnt vmcnt(0)" ::: "memory");     unsigned ones_ = ~0u; asm volatile("" : "+s"(ones_)); const int lane_ = (int)__builtin_amdgcn_mbcnt_hi(ones_, __builtin_amdgcn_mbcnt_lo(ones_, 0u)); const int fr = lane_ & 15, fq = lane_ >> 4; (void)fr0; (void)fq0;
        CArgsP a = a0; asm volatile("" : "+s"(a));
        unsigned char* ws = a->ws; const float* ssq_cq = (const float*)(ws + A_SSP) + SP_CQ;
        const float* tc = (const float*)(ws + WS_TAB); const float* ts = tc + (size_t)MTOK * 32; bf16_t* qm = (bf16_t*)(ws + A_QMLA);
        const int pn = u.pn;
        EPI_ROWS {
            const int r = u.pm * 256 + ai * 128 + wr * 64 + m * 16 + fr; const int b = r >> 13, s = r & (SEQ - 1);
            const f32x4 pq_ = *(const f32x4*)(ssq_cq + (unsigned)r * 4); const float sc = fast_rsq(((pq_[0] + pq_[1]) + (pq_[2] + pq_[3])) * (1.f / 256) + EPS) * (0.10206207261596577f * LOG2E);
#pragma unroll
            for (int bj = 0; bj < 2; ++bj) { EPI_GETV(v, sc);
                if (pn < 2) { const int c = pn * 256 + bj * 128 + wc * 32 + fq * 8; *(u32x4*)(qm + (unsigned)(((b * 8 + (c >> 6)) * SEQ + s) * 96 + (c & 63))) = pack8(v); }
                else { const int h = bj * 4 + wc; float o1[4], o2[4]; rope8(v, tc, ts, r, 4 * fq, 2, o1, o2); bf16_t* p = qm + (unsigned)(((b * 8 + h) * SEQ + s) * 96 + 64 + 4 * fq);
                    *(u32x2*)p = pack4(o1[0], o1[1], o1[2], o1[3]); *(u32x2*)(p + 16) = pack4(o2[0], o2[1], o2[2], o2[3]); }
            }
        }
    }
};
struct EpiUpKV {
    static constexpr bool PERM = true, AFTER_DRAIN = false;
    CArgsP a0; int l;
    DI void operator()(const f32x4 (&acc)[2][2][4][2], const Unit& u, int wr, int wc, int fr0, int fq0) const {
        asm volatile("s_waitcnt vmcnt(0)" ::: "memory");     unsigned ones_ = ~0u; asm volatile("" : "+s"(ones_)); const int lane_ = (int)__builtin_amdgcn_mbcnt_hi(ones_, __builtin_amdgcn_mbcnt_lo(ones_, 0u)); const int fr = lane_ & 15, fq = lane_ >> 4; (void)fr0; (void)fq0;
        CArgsP a = a0; asm volatile("" : "+s"(a));
        unsigned char* ws = a->ws; const float* ssq_ckv = (const float*)(ws + A_SSP) + SP_CKV; bf16_t* knope = (bf16_t*)(ws + A_KNOPE); bf16_t* vt = (bf16_t*)(ws + A_VTMLA);
        const int pn = u.pn;
        EPI_ROWS {
            const int r = u.pm * 256 + ai * 128 + wr * 64 + m * 16 + fr;
            const f32x4 pk_ = *(const f32x4*)(ssq_ckv + (unsigned)r * 4); const float rs = fast_rsq(((pk_[0] + pk_[1]) + (pk_[2] + pk_[3])) * (1.f / 128) + EPS);
#pragma unroll
            for (int bj = 0; bj < 2; ++bj) { EPI_GETV(v, rs);
                if (pn < 2) *(u32x4*)(knope + (unsigned)r * 512 + pn * 256 + bj * 128 + wc * 32 + fq * 8) = pack8(v);
                else { const int c = (pn - 2) * 256 + bj * 128 + wc * 32 + fq * 8; vt_scatter(vt, 8, r, c >> 6, c & 63, v); }
            }
        }
    }
};
struct EpiBranch {
    static constexpr bool PERM = true, AFTER_DRAIN = false;
    CArgsP a0; int br;
    DI void operator()(const f32x4 (&acc)[2][2][4][2], const Unit& u, int wr, int wc, int fr0, int fq0) const {
        asm volatile("s_waitcnt vmcnt(0)" ::: "memory");     unsigned ones_ = ~0u; asm volatile("" : "+s"(ones_)); const int lane_ = (int)__builtin_amdgcn_mbcnt_hi(ones_, __builtin_amdgcn_mbcnt_lo(ones_, 0u)); const int fr = lane_ & 15, fq = lane_ >> 4; (void)fr0; (void)fq0;
        CArgsP a = a0; asm volatile("" : "+s"(a));
        bf16_t* R = (bf16_t*)(a->ws + A_MIXED) + (size_t)br * MTOK * DM;
        EPI_ROWS {
            const int r = u.pm * 256 + ai * 128 + wr * 64 + m * 16 + fr;
#pragma unroll
            for (int bj = 0; bj < 2; ++bj) { EPI_GETV(v, 1.f); *(u32x4*)(R + (unsigned)r * DM + u.pn * 256 + bj * 128 + wc * 32 + fq * 8) = pack8(v); }
        }
    }
};
struct EpiY {
    static constexpr bool PERM = true, AFTER_DRAIN = false;
    CArgsP a0; int l, second;
    DI void operator()(const f32x4 (&acc)[2][2][4][2], const Unit& u, int wr, int wc, int fr0, int fq0) const {
        asm volatile("s_waitcnt vmcnt(0)" ::: "memory");     unsigned ones_ = ~0u; asm volatile("" : "+s"(ones_)); const int lane_ = (int)__builtin_amdgcn_mbcnt_hi(ones_, __builtin_amdgcn_mbcnt_lo(ones_, 0u)); const int fr = lane_ & 15, fq = lane_ >> 4; (void)fr0; (void)fq0;
        CArgsP a = a0; asm volatile("" : "+s"(a));
        unsigned char* ws = a->ws; float* Y = (float*)(ws + (second ? A_Y2 : A_Y)); float* ssq = (float*)(ws + A_SSP) + (second ? SP_Y2 : SP_Y);
        EPI_ROWS {
            const int r = u.pm * 256 + ai * 128 + wr * 64 + m * 16 + fr; float part = 0.f;
#pragma unroll
            for (int bj = 0; bj < 2; ++bj) { const int c = u.pn * 256 + bj * 128 + wc * 32 + fq * 8; const f32x4 a0 = acc[ai][bj][m][0], a1 = acc[ai][bj][m][1];
                part += (a0[0] * a0[0] + a0[1] * a0[1]) + (a0[2] * a0[2] + a0[3] * a0[3]) + (a1[0] * a1[0] + a1[1] * a1[1]) + (a1[2] * a1[2] + a1[3] * a1[3]);
                { const float yv_[8] = {a0[0] * 1.f, a0[1] * 1.f, a0[2] * 1.f, a0[3] * 1.f, a1[0] * 1.f, a1[1] * 1.f, a1[2] * 1.f, a1[3] * 1.f}; *(u32x4*)((bf16_t*)Y + (unsigned)r * DM + c) = pack8(yv_); } }
            ssq_row_put(part, ssq + (unsigned)r * 16 + u.pn * 4 + wc, fr, fq);
        }
    }
};
struct EpiUp {
    static constexpr bool PERM = true, AFTER_DRAIN = false;
    CArgsP a0;
    DI void operator()(const f32x4 (&acc)[2][2][4][2], const Unit& u, int wr, int wc, int fr0, int fq0) const {
        asm volatile("s_waitcnt vmcnt(0)" ::: "memory");     unsigned ones_ = ~0u; asm volatile("" : "+s"(ones_)); const int lane_ = (int)__builtin_amdgcn_mbcnt_hi(ones_, __builtin_amdgcn_mbcnt_lo(ones_, 0u)); const int fr = lane_ & 15, fq = lane_ >> 4; (void)fr0; (void)fq0;
        CArgsP a = a0; asm volatile("" : "+s"(a));
        unsigned char* ws = a->ws; const float* ssq_x1 = (const float*)(ws + WS_CTL) + SS_X1; bf16_t* U = (bf16_t*)(ws + A_U);
        EPI_ROWS {
            const int r = u.pm * 256 + ai * 128 + wr * 64 + m * 16 + fr;
            const float rs = fast_rsq(ssq_x1[r] * (1.f / DM) + EPS);
#pragma unroll
            for (int bj = 0; bj < 2; ++bj) { EPI_GETV(v, rs);
#pragma unroll
                for (int j = 0; j < 8; ++j) { const float t = fmaxf(v[j], 0.f); v[j] = t * t; }
                *(u32x4*)(U + (unsigned)r * FF + u.pn * 256 + bj * 128 + wc * 32 + fq * 8) = pack8(v); }
        }
    }
};

constexpr int KROW = 208, VROW = 136, KS_BYTES = 64 * KROW, VS_BYTES = 64 * VROW, AT_FLAGS = 2 * KS_BYTES + 2 * VS_BYTES;
DI int crow(int reg, int h) { return (reg & 3) + 8 * (reg >> 2) + 4 * h; }
DI bf16x8 pack_frag(const f32x16& x, int s) {
    u32x4 p; p.x = cvt_pk_bf16(x[8 * s], x[8 * s + 1]); p.y = cvt_pk_bf16(x[8 * s + 2], x[8 * s + 3]); p.z = cvt_pk_bf16(x[8 * s + 4], x[8 * s + 5]); p.w = cvt_pk_bf16(x[8 * s + 6], x[8 * s + 7]);
    return __builtin_bit_cast(bf16x8, p);
}
DI void sb_group(f32x16& s, float& carry, int key_base, int q_abs, int h, int lane) {
    float L[16];
#pragma unroll
    for (int i = 0; i < 16; ++i) { const float z = s[i]; const float sp = fmaxf(z, 0.f) + __logf(1.f + __expf(-fabsf(z))); L[i] = (key_base + crow(i, h) < q_abs) ? -sp : 0.f; }
    float cs[4], pc[4];
#pragma unroll
    for (int c = 0; c < 4; ++c) { cs[c] = (L[4 * c] + L[4 * c + 1]) + (L[4 * c + 2] + L[4 * c + 3]); pc[c] = shx(cs[c], 32, lane); }
    float run = carry;
#pragma unroll
    for (int c = 3; c >= 0; --c) {
        float t = (h == 0) ? run + pc[c] : run;
#pragma unroll
        for (int e = 3; e >= 0; --e) { const int i = 4 * c + e; const bool before = key_base + crow(i, h) < q_abs; const float a = __expf(L[i] + s[i] + t); t += L[i]; s[i] = before ? a : 0.f; }
        run += cs[c] + pc[c];
    }
    carry = run;
}
template <int MODE>
DI void attn_unit(LAS unsigned char* lds, const bf16_t* Qp, int qpitch, const bf16_t* Kp, int kpitch, const bf16_t* Kpe, const bf16_t* Vt, bf16_t* Op, int qb, float sink2, int tid) {
    constexpr int NK = MODE == 0 ? 6 : 4;
    const int lane = tid & 63, wave = tid >> 6, r32 = lane & 31, h = lane >> 5;
    const int row0 = qb * 256 + wave * 32, q_abs = row0 + r32;
    bf16x8 qf[NK];
#pragma unroll
    for (int kk = 0; kk < NK; ++kk) qf[kk] = *(const bf16x8*)(Qp + (size_t)q_abs * qpitch + 16 * kk + 8 * h);
    const int jt_hi = 4 * qb + 3, jt_lo = (MODE == 1) ? (4 * qb - 2 > 0 ? 4 * qb - 2 : 0) : 0, nT = jt_hi - jt_lo + 1;
    f32x16 o0, o1;
#pragma unroll
    for (int i = 0; i < 16; ++i) { o0[i] = 0.f; o1[i] = 0.f; }
    float mrun = (MODE == 1) ? sink2 : -1e30f, lrun = (MODE == 1 && h == 0) ? 1.f : 0.f, carry = 0.f;
    bool wdone = false;
    LAS unsigned* flags = (LAS unsigned*)(lds + AT_FLAGS);
    const int kkey = tid >> 3, kch = tid & 7, pkey = tid >> 2, pch = tid & 3;
    u32x4 kreg, vreg, preg;
    auto issue = [&](int jt) {
        kreg = *(const u32x4*)(Kp + (size_t)(64 * jt + kkey) * kpitch + kch * 8);
        vreg = *(const u32x4*)(Vt + (size_t)kkey * SEQ + 64 * jt + kch * 8);
        if (MODE == 0 && tid < 256) preg = *(const u32x4*)(Kpe + (size_t)(64 * jt + pkey) * 32 + pch * 8);
    };
    auto commit = [&](int buf) {
        *(LAS u32x4*)(lds + buf * KS_BYTES + kkey * KROW + kch * 16) = kreg;
        LAS u32x2* vp = (LAS u32x2*)(lds + 2 * KS_BYTES + buf * VS_BYTES + kkey * VROW + kch * 16); vp[0] = (u32x2){vreg.x, vreg.y}; vp[1] = (u32x2){vreg.z, vreg.w};
        if (MODE == 0 && tid < 256) *(LAS u32x4*)(lds + buf * KS_BYTES + pkey * KROW + 128 + pch * 16) = preg;
    };
    __syncthreads();
    issue(MODE == 2 ? jt_hi : jt_lo); commit(0);
    __syncthreads();
    for (int it = 0; it < nT; ++it) {
        const int jt = (MODE == 2) ? jt_hi - it : jt_lo + it, buf = it & 1;
        const bool more = it + 1 < nT;
        if (more) issue(MODE == 2 ? jt - 1 : jt + 1);
        bool active = (64 * jt <= row0 + 31);
        if (MODE == 1) active = active && (64 * jt + 63 >= row0 - 127);
        if (MODE == 2) active = active && !wdone;
        if (active) {
            const LAS unsigned char* ks = lds + buf * KS_BYTES; const LAS unsigned char* vs = lds + 2 * KS_BYTES + buf * VS_BYTES;
            f32x16 s0, s1;
#pragma unroll
            for (int i = 0; i < 16; ++i) { s0[i] = 0.f; s1[i] = 0.f; }
#pragma unroll
            for (int kk = 0; kk < NK; ++kk) {
                const bf16x8 a0 = *(const LAS bf16x8*)(ks + r32 * KROW + (16 * kk + 8 * h) * 2);
                const bf16x8 a1 = *(const LAS bf16x8*)(ks + (32 + r32) * KROW + (16 * kk + 8 * h) * 2);
                s0 = MFMA32(a0, qf[kk], s0); s1 = MFMA32(a1, qf[kk], s1);
            }
            const int kb0 = 64 * jt;
            if (MODE == 2) {
                sb_group(s1, carry, kb0 + 32, q_abs, h, lane);
                sb_group(s0, carry, kb0, q_abs, h, lane);
            } else {
                const bool need_mask = (MODE == 1) || (kb0 + 63 > row0);
                if (need_mask) {
#pragma unroll
                    for (int i = 0; i < 16; ++i) { const int k0 = kb0 + crow(i, h), k1 = k0 + 32;
                        bool v0 = k0 <= q_abs, v1 = k1 <= q_abs;
                        if (MODE == 1) { v0 = v0 && (q_abs - k0 < 128); v1 = v1 && (q_abs - k1 < 128); }
                        s0[i] = v0 ? s0[i] : -1e30f; s1[i] = v1 ? s1[i] : -1e30f; }
                }
                float mx = -1e30f;
#pragma unroll
                for (int i = 0; i < 16; ++i) mx = fmaxf(mx, fmaxf(s0[i], s1[i]));
                mx = fmaxf(mx, shx(mx, 32, lane));
                const float mnew = fmaxf(mrun, mx), alpha = __builtin_amdgcn_exp2f(mrun - mnew);
                float ls = 0.f;
#pragma unroll
                for (int i = 0; i < 16; ++i) { s0[i] = __builtin_amdgcn_exp2f(s0[i] - mnew); s1[i] = __builtin_amdgcn_exp2f(s1[i] - mnew); ls += s0[i] + s1[i]; }
                lrun = lrun * alpha + ls; mrun = mnew;
#pragma unroll
                for (int i = 0; i < 16; ++i) { o0[i] *= alpha; o1[i] *= alpha; }
            }
#pragma unroll
            for (int g = 0; g < 2; ++g)
#pragma unroll
                for (int s = 0; s < 2; ++s) {
                    const bf16x8 pf = pack_frag(g == 0 ? s0 : s1, s);
                    const int kofs = (32 * g + 16 * s + 4 * h) * 2;
                    { const s16x4 lo = *(const LAS s16x4*)(vs + r32 * VROW + kofs), hi = *(const LAS s16x4*)(vs + r32 * VROW + kofs + 16);
                      o0 = MFMA32(__builtin_shufflevector(lo, hi, 0, 1, 2, 3, 4, 5, 6, 7), pf, o0); }
                    { const s16x4 lo = *(const LAS s16x4*)(vs + (32 + r32) * VROW + kofs), hi = *(const LAS s16x4*)(vs + (32 + r32) * VROW + kofs + 16);
                      o1 = MFMA32(__builtin_shufflevector(lo, hi, 0, 1, 2, 3, 4, 5, 6, 7), pf, o1); }
                }
            if (MODE == 2) wdone = __all(carry < -88.f);
        }
        if (more) commit(buf ^ 1);
        if (MODE == 2 && lane == 0) flags[(it & 1) * 8 + wave] = wdone ? 1u : 0u;
        __syncthreads();
        if (MODE == 2) { unsigned all = 1u;
#pragma unroll
            for (int w = 0; w < 8; ++w) all &= flags[(it & 1) * 8 + w];
            if (all) break; }
    }
    if (MODE != 2) { const float l = lrun + shx(lrun, 32, lane); const float inv = 1.f / l;
#pragma unroll
        for (int i = 0; i < 16; ++i) { o0[i] *= inv; o1[i] *= inv; } }
    bf16_t* orow = Op + (size_t)q_abs * 512;
#pragma unroll
    for (int c = 0; c < 4; ++c) {
        *(u32x2*)(orow + 8 * c + 4 * h) = pack4(o0[4 * c], o0[4 * c + 1], o0[4 * c + 2], o0[4 * c + 3]);
        *(u32x2*)(orow + 32 + 8 * c + 4 * h) = pack4(o1[4 * c], o1[4 * c + 1], o1[4 * c + 2], o1[4 * c + 3]);
    }
}

struct RoundOrder {
    pg8::StaticOrder S; int rnd;
    DI bool next(int i, Unit& u) const { return i == 0 ? S.next(rnd, u) : false; }
    DI void a_ready(const Unit&) const {}
    DI void done(const Unit&) const {}
};
template <int N, class Epi>
DI void run_gemm_n(LAS unsigned char* lds, int tid, int G, int bx, const bf16_t* A, const bf16_t* Bt, int K, const Epi& E) {
    pg8::Gemm g{A, Bt, MTOK, N, K};
    constexpr int nwg = (MTOK / 256) * (N / 256), NR = (nwg + 255) / 256;
    if constexpr (N == FF || N == NGATE || N == 2816) {
        pg8::StaticOrder S; S.init(MTOK, N, G, bx);
        pg8::gemm_phase<Epi, pg8::StaticOrder, true, true>(lds, g, S, E, tid);
    } else {
#pragma unroll
        for (int rnd = 0; rnd < NR; ++rnd) { RoundOrder R; R.S.init(MTOK, N, G, bx); R.rnd = rnd; pg8::gemm_phase<Epi, RoundOrder, false, true>(lds, g, R, E, tid); }
    }
}
#define run_gemm(lds, tid, G, bx, A, Bt, N, K, E) run_gemm_n<N>(lds, tid, G, bx, A, Bt, K, E)

template <int PH>
DI void do_phase(LAS unsigned char* lds, int wave_s) {
    constexpr int ph = PH;
    {
        CArgsP a = (CArgsP)__builtin_amdgcn_kernarg_segment_ptr(); asm volatile("" : "+s"(a));
        unsigned char* ws = a->ws;
        float* ctl = (float*)(ws + WS_CTL);
        const float* tc = (const float*)(ws + WS_TAB); const float* ts = tc + (size_t)MTOK * 32;
        bf16_t* XB = (bf16_t*)(ws + WS_XB);
        int G = gridDim.x, bx = blockIdx.x; unsigned ones = ~0u; asm volatile("" : "+s"(G), "+s"(bx), "+s"(ones));
        const int vcu = (G % 8 == 0) ? (bx % 8) * (G / 8) + bx / 8 : bx;
        int tid = wave_s * 64 + (int)__builtin_amdgcn_mbcnt_hi(ones, __builtin_amdgcn_mbcnt_lo(ones, 0u)); asm volatile("" : "+v"(tid));
        const int lane = tid & 63, wave = __builtin_amdgcn_readfirstlane(tid >> 6);
        const int gw = vcu * 8 + wave, ngw = G * 8;
        if (ph == 0) {
#if (PHMASK & 1)
            { u32x4* z = (u32x4*)((bf16_t*)(ws + W_IN) + (size_t)416 * 1024); for (int i = bx * NTHR + tid; i < 96 * 1024 * 2 / 16; i += G * NTHR) z[i] = (u32x4){0u, 0u, 0u, 0u}; }
            { unsigned char* z = ws + W_UKV; for (int i = bx * NTHR + tid; i < 1024 * 16; i += G * NTHR) *(u32x4*)(z + (size_t)(i >> 4) * 512 + 256 + (i & 15) * 16) = (u32x4){0u, 0u, 0u, 0u}; }
            for (int i = bx * NTHR + tid; i < (int)(BAR_BYTES / 4); i += G * NTHR) ((unsigned*)(ws + WS_BAR))[i] = 0u;
            for (int i = bx * NTHR + tid; i < MTOK * 32; i += G * NTHR) {
                const int r = i >> 5, k = i & 31;
                const float inv = ROPE_INV[k];
                const float ang = (float)a->pos[r] * inv;
                double rev = (double)ang * 0.15915494309189535; rev -= floor(rev);
                const float fr = (float)rev;
                ((float*)(ws + WS_TAB))[i] = __builtin_amdgcn_cosf(fr); ((float*)(ws + WS_TAB))[(size_t)MTOK * 32 + i] = __builtin_amdgcn_sinf(fr);
            }
            for (int r = gw; r < MTOK; r += ngw) row_update(a->in[0], nullptr, nullptr, nullptr, nullptr, XB, ctl + SS_X, r, lane);
            conv_layer(a, 0, lds, gw, ngw, wave, lane);
#endif
        } else {
            const int l = (ph - 1) / NPH_LAYER, sp = (ph - 1) % NPH_LAYER;
            const float* ssq_y = (const float*)(ws + A_SSP) + SP_Y; const float* ssq_y2 = (const float*)(ws + A_SSP) + SP_Y2;
            if (sp == 0) {
#if (PHMASK & 2)
                { EpiIn E{a, l}; run_gemm(lds, tid, G, bx, XB, (const bf16_t*)(ws + W_IN), 2816, 1024, E); }
                { EpiGate E{a, l}; run_gemm(lds, tid, G, bx, XB, (const bf16_t*)(ws + W_IN) + (size_t)2816 * 1024, NGATE, 1024, E); }
#endif
            } else if (sp == 1) {
#if (PHMASK & 4)
                { EpiUpQ E{a, l}; run_gemm(lds, tid, G, bx, (const bf16_t*)(ws + A_CQ), (const bf16_t*)(ws + W_UQ), 768, 256, E); }
                { EpiUpKV E{a, l}; run_gemm(lds, tid, G, bx, (const bf16_t*)(ws + A_CKV), (const bf16_t*)(ws + W_UKV), 1024, 256, E); }
#endif
            } else if (sp == 2) {
#if (PHMASK & 8)
                for (int w = vcu; w < 256; w += G) {
                    const int bh = w >> 4, sx = w & 15, b = bh >> 3, h = bh & 7;
                    const bf16_t* qm = (const bf16_t*)(ws + A_QMLA) + (size_t)bh * SEQ * 96;
                    const bf16_t* kn = (const bf16_t*)(ws + A_KNOPE) + (size_t)b * SEQ * 512 + h * 64;
                    const bf16_t* kp = (const bf16_t*)(ws + A_KPE) + (size_t)b * SEQ * 32;
                    const bf16_t* vm = (const bf16_t*)(ws + A_VTMLA) + (size_t)bh * 64 * SEQ;
                    bf16_t* om = (bf16_t*)(ws + A_OMLA) + (size_t)b * SEQ * 512 + h * 64;
                    attn_unit<0>(lds, qm, 96, kn, 512, kp, vm, om, 31 - sx, 0.f, tid);
                    attn_unit<0>(lds, qm, 96, kn, 512, kp, vm, om, sx, 0.f, tid);
                    bf16_t* qs = (bf16_t*)(ws + A_QSWA) + (size_t)b * SEQ * 512 + h * 64;
                    const bf16_t* ksw = (const bf16_t*)(ws + A_KSWA) + (size_t)b * SEQ * 128 + (h >> 2) * 64;
                    const bf16_t* vsw = (const bf16_t*)(ws + A_VTSWA) + (size_t)(b * 2 + (h >> 2)) * 64 * SEQ;
                    const float sink2 = a->in[9][l * 8 + h] * LOG2E;
                    attn_unit<1>(lds, qs, 512, ksw, 128, nullptr, vsw, qs, 2 * sx, sink2, tid);
                    attn_unit<1>(lds, qs, 512, ksw, 128, nullptr, vsw, qs, 2 * sx + 1, sink2, tid);
                    bf16_t* qb_ = (bf16_t*)(ws + A_QSB) + (size_t)b * SEQ * 512 + h * 64;
                    const bf16_t* kb_ = (const bf16_t*)(ws + A_KSB) + (size_t)b * SEQ * 512 + h * 64;
                    const bf16_t* vb_ = (const bf16_t*)(ws + A_VTSB) + (size_t)bh * 64 * SEQ;
                    attn_unit<2>(lds, qb_, 512, kb_, 512, nullptr, vb_, qb_, 2 * sx, 0.f, tid);
                    attn_unit<2>(lds, qb_, 512, kb_, 512, nullptr, vb_, qb_, 2 * sx + 1, 0.f, tid);
                }
#endif
            } else if (sp == 3) {
#if (PHMASK & 16)
                for (int br = 0; br < 3; ++br) {
                    EpiBranch E{a, br};
                    const bf16_t* A = br == 0 ? (const bf16_t*)(ws + A_OMLA) : br == 1 ? (const bf16_t*)(ws + A_QSWA) : (const bf16_t*)(ws + A_QSB);
                    run_gemm(lds, tid, G, bx, A, (const bf16_t*)(ws + W_OA) + (size_t)br * 1024 * 512, 1024, 512, E);
                }
                {
                    __builtin_amdgcn_fence(__ATOMIC_ACQUIRE, "agent");
                    pg8::StaticOrder S; S.init(MTOK, 1024, G, bx); Unit u;
                    if (S.next(0, u)) {
                        const bf16_t* Gp = (const bf16_t*)(ws + A_G); bf16_t* R = (bf16_t*)(ws + A_MIXED);
                        for (int i = tid; i < 256 * 32; i += NTHR) {
                            const int r = u.pm * 256 + (i >> 5), c = u.pn * 256 + (i & 31) * 8; const unsigned off = (unsigned)r * DM + c;
                            float acc8[8] = {0.f, 0.f, 0.f, 0.f, 0.f, 0.f, 0.f, 0.f};
#pragma unroll
                            for (int b3 = 0; b3 < 3; ++b3) {
                                const u32x4 gw = *(const u32x4*)(Gp + (unsigned)r * NGATE + b3 * 1024 + c), rw = *(const u32x4*)(R + (size_t)b3 * MTOK * DM + off);
                                acc8[0] += __uint_as_float(gw.x << 16) * __uint_as_float(rw.x << 16); acc8[1] += __uint_as_float(gw.x & 0xffff0000u) * __uint_as_float(rw.x & 0xffff0000u);
                                acc8[2] += __uint_as_float(gw.y << 16) * __uint_as_float(rw.y << 16); acc8[3] += __uint_as_float(gw.y & 0xffff0000u) * __uint_as_float(rw.y & 0xffff0000u);
                                acc8[4] += __uint_as_float(gw.z << 16) * __uint_as_float(rw.z << 16); acc8[5] += __uint_as_float(gw.z & 0xffff0000u) * __uint_as_float(rw.z & 0xffff0000u);
                                acc8[6] += __uint_as_float(gw.w << 16) * __uint_as_float(rw.w << 16); acc8[7] += __uint_as_float(gw.w & 0xffff0000u) * __uint_as_float(rw.w & 0xffff0000u);
                            }
                            *(u32x4*)(R + off) = pack8(acc8);
                        }
                    }
                }
#endif
            } else if (sp == 4) {
#if 0
                const bf16_t* Gp = (const bf16_t*)(ws + A_G); bf16_t* R = (bf16_t*)(ws + A_MIXED);
                for (int i = bx * NTHR + tid; i < MTOK * DM / 8; i += G * NTHR) {
                    const int r = i >> 7, c = (i & 127) * 8; const unsigned off = (unsigned)r * DM + c;
                    float acc8[8] = {0.f, 0.f, 0.f, 0.f, 0.f, 0.f, 0.f, 0.f};
#pragma unroll
                    for (int b3 = 0; b3 < 3; ++b3) {
                        const u32x4 gw = *(const u32x4*)(Gp + (unsigned)r * NGATE + b3 * 1024 + c), rw = *(const u32x4*)(R + (size_t)b3 * MTOK * DM + off);
                        acc8[0] += __uint_as_float(gw.x << 16) * __uint_as_float(rw.x << 16); acc8[1] += __uint_as_float(gw.x & 0xffff0000u) * __uint_as_float(rw.x & 0xffff0000u);
                        acc8[2] += __uint_as_float(gw.y << 16) * __uint_as_float(rw.y << 16); acc8[3] += __uint_as_float(gw.y & 0xffff0000u) * __uint_as_float(rw.y & 0xffff0000u);
                        acc8[4] += __uint_as_float(gw.z << 16) * __uint_as_float(rw.z << 16); acc8[5] += __uint_as_float(gw.z & 0xffff0000u) * __uint_as_float(rw.z & 0xffff0000u);
                        acc8[6] += __uint_as_float(gw.w << 16) * __uint_as_float(rw.w << 16); acc8[7] += __uint_as_float(gw.w & 0xffff0000u) * __uint_as_float(rw.w & 0xffff0000u);
                    }
                    *(u32x4*)(R + off) = pack8(acc8);
                }
#endif
            } else if (sp == 5 || sp == 8) {
#if (PHMASK & 32)
                EpiY E{a, l, sp == 5 ? 0 : 1};
                if (sp == 5) run_gemm(lds, tid, G, bx, (const bf16_t*)(ws + A_MIXEDB), (const bf16_t*)(ws + W_OUT), 1024, 1024, E);
                else run_gemm(lds, tid, G, bx, (const bf16_t*)(ws + A_U), (const bf16_t*)(ws + W_DN), 1024, 4096, E);
#endif
            } else if (sp == 6 || sp == 9) {
#if (PHMASK & 64)
                const float* xin = (sp == 6 && l == 0) ? a->in[0] : a->out;
                const float* Y = (const float*)(ws + (sp == 6 ? A_Y : A_Y2));
                const float* gpost = (sp == 6 ? a->in[14] : a->in[18]) + l * DM;
                for (int r = gw; r < MTOK; r += ngw) row_update(xin, a->out, Y, sp == 6 ? ssq_y : ssq_y2, gpost, XB, ctl + (sp == 6 ? SS_X1 : SS_X), r, lane);
                if (sp == 9 && l + 1 < DEPTH) conv_layer(a, l + 1, lds, gw, ngw, wave, lane);
#endif
            } else if (sp == 7) {
#if (PHMASK & 128)
                EpiUp E{a};
                run_gemm(lds, tid, G, bx, XB, (const bf16_t*)(ws + W_UP), FF, 1024, E);
#endif
            }
        }
    }
}

__global__ void __launch_bounds__(NTHR, 2) mk_fwd(Args a_) {
    extern __shared__ __attribute__((aligned(16))) unsigned char lds_raw[];
    LAS unsigned char* lds = (LAS unsigned char*)lds_raw;
    cg::grid_group grid = cg::this_grid();
    const int ph_lo = a_.ph_lo, ph_hi = a_.ph_hi;
    const int wave_s = __builtin_amdgcn_readfirstlane(threadIdx.x >> 6);
    static_assert(NPHASES == 41, "phase list below");
#define SEAM(P) do { if ((P) == 0 || gridDim.x != 256) grid.sync(); else { unsigned o_ = ~0u; int bx_ = blockIdx.x; asm volatile("" : "+s"(o_), "+s"(bx_)); const int t_ = wave_s * 64 + (int)__builtin_amdgcn_mbcnt_hi(o_, __builtin_amdgcn_mbcnt_lo(o_, 0u)); ms::grid_sync((unsigned*)(a_.ws + WS_BAR), t_, bx_, (unsigned)(P) + 1u); } } while (0)
#define RUN_PH(P) if (!((P) > 0 && ((P) - 1) % NPH_LAYER == 4) && ph_lo <= (P) && (P) < ph_hi) { do_phase<P>(lds, wave_s); if ((P) + 1 < ph_hi) SEAM(P); }
    RUN_PH(0)
    RUN_PH(1)
    RUN_PH(2)
    RUN_PH(3)
    RUN_PH(4)
    RUN_PH(5)
    RUN_PH(6)
    RUN_PH(7)
    RUN_PH(8)
    RUN_PH(9)
    RUN_PH(10)
    RUN_PH(11)
    RUN_PH(12)
    RUN_PH(13)
    RUN_PH(14)
    RUN_PH(15)
    RUN_PH(16)
    RUN_PH(17)
    RUN_PH(18)
    RUN_PH(19)
    RUN_PH(20)
    RUN_PH(21)
    RUN_PH(22)
    RUN_PH(23)
    RUN_PH(24)
    RUN_PH(25)
    RUN_PH(26)
    RUN_PH(27)
    RUN_PH(28)
    RUN_PH(29)
    RUN_PH(30)
    RUN_PH(31)
    RUN_PH(32)
    RUN_PH(33)
    RUN_PH(34)
    RUN_PH(35)
    RUN_PH(36)
    RUN_PH(37)
    RUN_PH(38)
    RUN_PH(39)
    RUN_PH(40)
#undef RUN_PH
#undef SEAM
}

#ifdef DBG_STOP
__global__ void dbg_dump(const unsigned short* ws16, float* out) {
    const size_t i = (size_t)blockIdx.x * blockDim.x + threadIdx.x;
    if (i >= (size_t)MTOK * DM) return;
    float acc = 0.f;
#ifdef DBG_OFF
#ifdef DBG_F32
    acc = ((const float*)ws16)[(size_t)(DBG_OFF) / 4 + i];
#else
    { const unsigned short w = ws16[(size_t)(DBG_OFF) / 2 + i]; acc = __uint_as_float((unsigned)w << 16); }
#endif
#else
    const size_t base = WS_XB / 2, total = (WS_END - WS_XB) / 2;
    for (size_t o = i; o < total; o += (size_t)MTOK * DM) { const unsigned short w = ws16[base + o]; if (((w >> 7) & 0xff) != 0xff) acc += __uint_as_float((unsigned)w << 16); }
#endif
    out[i] = acc;
}
#endif
}

extern "C" void kernel_launch(void* const* d_in, const int* in_sizes, int n_in, void* d_out, int out_size, void* d_ws, size_t ws_size, hipStream_t stream) {
    using namespace mk;
    static int grid = 0;
    if (grid == 0) {
        if (n_in != 19 || out_size != MTOK * DM || ws_size < WS_END) { fprintf(stderr, "kernel_launch: unexpected shapes (n_in %d, out %d, ws %zu < %zu)\n", n_in, out_size, ws_size, (size_t)WS_END); grid = -1; return; }
        int dev = 0, cus = 0, per_cu = 0;
        (void)hipGetDevice(&dev); (void)hipDeviceGetAttribute(&cus, hipDeviceAttributeMultiprocessorCount, dev);
        (void)hipFuncSetAttribute((const void*)mk_fwd, hipFuncAttributeMaxDynamicSharedMemorySize, LDS_BYTES);
        if (hipOccupancyMaxActiveBlocksPerMultiprocessor(&per_cu, (const void*)mk_fwd, NTHR, LDS_BYTES) != hipSuccess || per_cu < 1) { fprintf(stderr, "kernel_launch: occupancy query says %d\n", per_cu); per_cu = 1; }
        (void)hipGetLastError();
        grid = cus * per_cu;
        if (grid < 256) { fprintf(stderr, "kernel_launch: this kernel needs a 256-workgroup resident grid (got %d)\n", grid); grid = -1; return; }
        if (grid > 256) grid = 256;
    }
    if (grid < 0) return;
    Args a{};
    for (int i = 0; i < 19; ++i) a.in[i] = (const float*)d_in[i];
    a.pos = (const int*)d_in[1]; a.out = (float*)d_out; a.ws = (unsigned char*)d_ws;
#if ONE_LAUNCH
    a.ph_lo = 0; a.ph_hi = NPHASES;
    void* args[] = {&a};
    hipError_t e = hipLaunchCooperativeKernel((const void*)mk_fwd, dim3(grid), dim3(NTHR), args, LDS_BYTES, stream);
    if (e != hipSuccess) fprintf(stderr, "cooperative launch failed: %s (grid %d)\n", hipGetErrorString(e), grid);
#else
#ifdef DBG_STOP
    for (int ph = 0; ph <= DBG_STOP; ++ph) { a.ph_lo = ph; a.ph_hi = ph + 1; hipLaunchKernelGGL(mk_fwd, dim3(grid), dim3(NTHR), LDS_BYTES, stream, a); }
#ifndef DBG_NODUMP
    hipLaunchKernelGGL(dbg_dump, dim3(MTOK * DM / 256), dim3(256), 0, stream, (const unsigned short*)d_ws, (float*)d_out);
#endif
#else
    for (int ph = 0; ph < NPHASES; ++ph) { a.ph_lo = ph; a.ph_hi = ph + 1; hipLaunchKernelGGL(mk_fwd, dim3(grid), dim3(NTHR), LDS_BYTES, stream, a); }
#endif
#endif
}
```
